# Optimizing an MI355X kernel written in HIP

```python
import math
import jax, jax.numpy as jnp
from jax import lax
import numpy as np

D_MODEL = 1024
BATCH = 8
SEQ = 4096
DEPTH = 1

GDN_HEADS = 4
GDN_HEAD_DIM = 128
GDN_WIDTH = GDN_HEADS * GDN_HEAD_DIM
CONV_WIDTH = 4
CHUNK = 64
SWA_HEADS = 8
SWA_HEAD_DIM = 64
SWA_WIDTH = SWA_HEADS * SWA_HEAD_DIM
DILATED_PATTERNS = ((128, 1), (512, 4), (2048, 16))
NUM_BUCKETS = 32
MAX_DISTANCE = 2048
MIX_WIDTH = GDN_WIDTH + SWA_WIDTH
IN_SIZES = (GDN_WIDTH, GDN_WIDTH, GDN_WIDTH, GDN_WIDTH, GDN_HEADS, GDN_HEADS,
            SWA_WIDTH, SWA_WIDTH, SWA_WIDTH)
IN_COLS = sum(IN_SIZES)
D_FF = ((-(-8 * D_MODEL // 3)) + 255) // 256 * 256
RMS_EPS = 1e-6

kernel_name = 'hybrid_gdn_dilated_swa_block'


def rmsnorm(x, g):
    xf = x.astype(jnp.float32)
    y = xf * lax.rsqrt(jnp.mean(xf * xf, axis=-1, keepdims=True) + RMS_EPS)
    return (y * g.astype(jnp.float32)).astype(x.dtype)


def l2norm(x):
    return x * lax.rsqrt(jnp.sum(x * x, axis=-1, keepdims=True) + 1e-6)


def causal_depthwise_conv(x, w):
    K, C = w.shape
    return lax.conv_general_dilated(x, w[:, None, :].astype(x.dtype), (1,), ((K - 1, 0),),
                                    dimension_numbers=('NWC', 'WIO', 'NWC'),
                                    feature_group_count=C)


def chunk_gated_delta_rule(q, k, v, g, beta):
    Bn, S, H, Dk = q.shape
    Dv = v.shape[-1]
    N = S // CHUNK

    def chunks(t):
        t = t.reshape((Bn, N, CHUNK, H) + t.shape[3:])
        return jnp.moveaxis(jnp.moveaxis(t, 1, 0), 3, 2)

    qc, kc, vc = chunks(q), chunks(k), chunks(v)
    bc = chunks(beta)
    gc = jnp.cumsum(chunks(g), axis=-1)
    idx = jnp.arange(CHUNK)
    causal = idx[:, None] >= idx[None, :]
    strict = idx[:, None] > idx[None, :]
    decay = jnp.exp(jnp.where(causal, gc[..., :, None] - gc[..., None, :], -jnp.inf))
    kb = kc * bc[..., None]
    a = jnp.where(strict, jnp.einsum('nbhid,nbhjd->nbhij', kb, kc) * decay, 0.0)
    eye = jnp.eye(CHUNK, dtype=q.dtype)
    t_inv = lax.linalg.triangular_solve(eye + a, jnp.broadcast_to(eye, a.shape),
                                        left_side=True, lower=True)
    u = t_inv @ (vc * bc[..., None])
    w = t_inv @ (kb * jnp.exp(gc)[..., None])
    attn = jnp.einsum('nbhid,nbhjd->nbhij', qc, kc) * decay
    q_dec = qc * jnp.exp(gc)[..., None]
    k_dec = kc * jnp.exp(gc[..., -1:] - gc)[..., None]
    g_end = jnp.exp(gc[..., -1])

    def step(state, inp):
        u_i, w_i, attn_i, qd_i, kd_i, ge_i = inp
        v_new = u_i - jnp.einsum('bhck,bhkv->bhcv', w_i, state)
        o_i = (jnp.einsum('bhck,bhkv->bhcv', qd_i, state)
               + jnp.einsum('bhij,bhjv->bhiv', attn_i, v_new))
        state = state * ge_i[..., None, None] + jnp.einsum('bhck,bhcv->bhkv', kd_i, v_new)
        return state, o_i

    s0 = jnp.zeros((Bn, H, Dk, Dv), q.dtype)
    _, o = lax.scan(step, s0, (u, w, attn, q_dec, k_dec, g_end))
    return jnp.moveaxis(o, 0, 1).transpose(0, 1, 3, 2, 4).reshape(Bn, S, H, Dv)


def gated_deltanet(q, k, v, gate, beta_logit, a_logit, conv_w, a_log, dt_bias, onorm_g):
    f32 = jnp.float32
    Bn, S, _ = q.shape
    qkv = jax.nn.silu(causal_depthwise_conv(jnp.concatenate([q, k, v], axis=-1), conv_w)).astype(f32)
    q, k, v = jnp.split(qkv, 3, axis=-1)
    heads = lambda t: t.reshape(Bn, S, GDN_HEADS, GDN_HEAD_DIM)
    q = l2norm(heads(q)) * GDN_HEAD_DIM ** -0.5
    k = l2norm(heads(k))
    v = heads(v)
    beta = jax.nn.sigmoid(beta_logit.astype(f32))
    g = -jnp.exp(a_log.astype(f32)) * jax.nn.softplus(a_logit.astype(f32) + dt_bias.astype(f32))
    o = chunk_gated_delta_rule(q, k, v, g, beta)
    o = o * lax.rsqrt(jnp.mean(o * o, axis=-1, keepdims=True) + RMS_EPS) * onorm_g.astype(f32)
    o = o * jax.nn.silu(heads(gate).astype(f32))
    return o.reshape(Bn, S, GDN_WIDTH).astype(gate.dtype)


def t5_causal_bucket(dist):
    max_exact = NUM_BUCKETS // 2
    d = jnp.maximum(dist, 1).astype(jnp.float32)
    log_b = max_exact + (jnp.log(d / max_exact) / math.log(MAX_DISTANCE / max_exact)
                         * (NUM_BUCKETS - max_exact)).astype(jnp.int32)
    return jnp.where(dist < max_exact, dist, jnp.minimum(log_b, NUM_BUCKETS - 1))


def dilated_band(q, k, v, rel_bias, window, dilation):
    Bn, S, H, Dh = q.shape
    w = window // dilation
    L = S // dilation
    nb = -(-L // w)
    Lp = nb * w

    def to_sub(t):
        t = t.reshape(Bn, L, dilation, H, Dh).transpose(0, 3, 2, 1, 4)
        return jnp.pad(t, ((0, 0), (0, 0), (0, 0), (0, Lp - L), (0, 0)))

    blocks = lambda t: t.reshape(Bn, H, dilation, nb, w, Dh)

    def band(t):
        prev = jnp.pad(t, ((0, 0), (0, 0), (0, 0), (w, 0), (0, 0)))[:, :, :, :Lp]
        return jnp.concatenate([blocks(prev), blocks(t)], axis=-2)

    qb, kb, vb = blocks(to_sub(q)), band(to_sub(k)), band(to_sub(v))
    qi = jnp.arange(w)[:, None]
    kj = jnp.arange(2 * w)[None, :]
    rel = qi + w - kj
    blk = jnp.arange(nb)[:, None, None]
    valid = (rel >= 0) & (rel <= w) & (blk * w + kj - w >= 0)
    bias_steps = rel_bias[t5_causal_bucket(jnp.arange(w + 1) * dilation)]
    bias = jnp.moveaxis(bias_steps[jnp.clip(rel, 0, w)], -1, 0).astype(jnp.float32)
    logits = jnp.einsum('bhrnqd,bhrnkd->bhrnqk', qb, kb) * Dh ** -0.5 + bias[None, :, None, None]
    logits = jnp.where(valid, logits, -jnp.inf)
    m = jnp.max(logits, axis=-1)
    p = jnp.exp(logits - m[..., None])
    s = jnp.sum(p, axis=-1)
    num = jnp.einsum('bhrnqk,bhrnkd->bhrnqd', p, vb)

    def from_sub(t):
        rest = t.shape[5:]
        t = t.reshape((Bn, H, dilation, Lp) + rest)[:, :, :, :L]
        t = t.transpose((0, 3, 2, 1) + tuple(range(4, t.ndim)))
        return t.reshape((Bn, S, H) + rest)

    return from_sub(num), from_sub(m), from_sub(s)


def dilated_attention(q, k, v, rel_bias):
    Bn, S, _ = q.shape
    heads = lambda t: t.reshape(Bn, S, SWA_HEADS, SWA_HEAD_DIM).astype(jnp.float32)
    qh, kh, vh = heads(q), heads(k), heads(v)
    parts = [dilated_band(qh, kh, vh, rel_bias, win, dil) for win, dil in DILATED_PATTERNS]
    nums = jnp.stack([pt[0] for pt in parts])
    ms = jnp.stack([pt[1] for pt in parts])
    ss = jnp.stack([pt[2] for pt in parts])
    wts = jnp.exp(ms - jnp.max(ms, axis=0, keepdims=True))
    out = jnp.sum(wts[..., None] * nums, axis=0) / jnp.sum(wts * ss, axis=0)[..., None]
    return out.reshape(Bn, S, SWA_WIDTH).astype(q.dtype)


def setup_inputs(seed: int = 0) -> dict:
    key = jax.random.key(seed)
    ks = jax.random.split(key, 16)
    f32 = jnp.float32
    nrm = lambda k_, shape, scale: jax.random.normal(k_, shape, f32) * scale
    dt = jnp.exp(jax.random.uniform(ks[4], (DEPTH, GDN_HEADS), f32, math.log(1e-3), math.log(1e-1)))
    return {
        'x': nrm(ks[0], (BATCH, SEQ, D_MODEL), 1.0),
        'w_in': nrm(ks[1], (DEPTH, D_MODEL, IN_COLS), D_MODEL ** -0.5),
        'conv_w': nrm(ks[2], (DEPTH, CONV_WIDTH, 3 * GDN_WIDTH), CONV_WIDTH ** -0.5),
        'a_log': jnp.log(jax.random.uniform(ks[3], (DEPTH, GDN_HEADS), f32, 1.0, 16.0)),
        'dt_bias': dt + jnp.log(-jnp.expm1(-dt)),
        'onorm_g': 1.0 + nrm(ks[5], (DEPTH, GDN_HEAD_DIM), 0.1),
        'rel_bias': nrm(ks[6], (NUM_BUCKETS, SWA_HEADS), 0.2),
        'w_out': nrm(ks[7], (DEPTH, MIX_WIDTH, D_MODEL), MIX_WIDTH ** -0.5),
        'g_mix_pre': 1.0 + nrm(ks[8], (DEPTH, D_MODEL), 0.1),
        'g_mix_post': 1.0 + nrm(ks[9], (DEPTH, D_MODEL), 0.1),
        'w_gate': nrm(ks[10], (DEPTH, D_MODEL, D_FF), D_MODEL ** -0.5),
        'w_up': nrm(ks[11], (DEPTH, D_MODEL, D_FF), D_MODEL ** -0.5),
        'w_down': nrm(ks[12], (DEPTH, D_FF, D_MODEL), D_FF ** -0.5),
        'g_ffn_pre': 1.0 + nrm(ks[13], (DEPTH, D_MODEL), 0.1),
        'g_ffn_post': 1.0 + nrm(ks[14], (DEPTH, D_MODEL), 0.1),
    }


def reference(x, w_in, conv_w, a_log, dt_bias, onorm_g, rel_bias, w_out, g_mix_pre, g_mix_post,
              w_gate, w_up, w_down, g_ffn_pre, g_ffn_post):
    split_at = [int(c) for c in np.cumsum(IN_SIZES)[:-1]]
    for l in range(DEPTH):
        h = rmsnorm(x, g_mix_pre[l])
        proj = h @ w_in[l]
        qa, ka, va, gate_a, beta_a, alpha_a, qb, kb, vb = jnp.split(proj, split_at, axis=-1)
        out_a = gated_deltanet(qa, ka, va, gate_a, beta_a, alpha_a,
                               conv_w[l], a_log[l], dt_bias[l], onorm_g[l])
        out_b = dilated_attention(qb, kb, vb, rel_bias)
        mix = jnp.concatenate([out_a, out_b], axis=-1) @ w_out[l]
        x = x + rmsnorm(mix, g_mix_post[l])
        h = rmsnorm(x, g_ffn_pre[l])
        f = (jax.nn.silu(h @ w_gate[l]) * (h @ w_up[l])) @ w_down[l]
        x = x + rmsnorm(f, g_ffn_post[l])
    return x
```

```cpp
#include <hip/hip_runtime.h>
#include <cstdio>
#include <cstdint>
#include <cmath>

typedef unsigned short bf16_t;
__device__ __forceinline__ bf16_t f2bf(float f) { unsigned u = __builtin_bit_cast(unsigned, f); return (bf16_t)((u + 0x7fffu + ((u >> 16) & 1u)) >> 16); }
__device__ __forceinline__ float bf2f(bf16_t b) { return __builtin_bit_cast(float, (unsigned)b << 16); }

constexpr int BATCH = 8, SEQ = 4096, D = 1024, M = BATCH * SEQ;
constexpr int NC_IN = 3592;
constexpr int C_QA = 0, C_KA = 512, C_VA = 1024, C_GA = 1536, C_BETA = 2048, C_QB = 2056, C_KB = 2568, C_VB = 3080;
constexpr int PW = 3584;
constexpr int P_QA = 0, P_KA = 512, P_VA = 1024, P_GA = 1536, P_QB = 2048, P_KB = 2560, P_VB = 3072;
constexpr int DFF = 2816;
constexpr float EPS = 1e-6f;

__constant__ int c_bkt[3][129] = {
 {0, 1, 2, 3, 4, 5, 6, 7, 8, 9, 10, 11, 12, 13, 14, 15, 16, 16, 16, 16, 16, 16, 17, 17, 17, 17, 17, 17, 17, 17, 18, 18, 18, 18, 18, 18, 18, 18, 18, 18, 19, 19, 19, 19, 19, 19, 19, 19, 19, 19, 19, 19, 19, 19, 20, 20, 20, 20, 20, 20, 20, 20, 20, 20, 20, 20, 20, 20, 20, 20, 20, 20, 20, 21, 21, 21, 21, 21, 21, 21, 21, 21, 21, 21, 21, 21, 21, 21, 21, 21, 21, 21, 21, 21, 21, 21, 21, 21, 21, 22, 22, 22, 22, 22, 22, 22, 22, 22, 22, 22, 22, 22, 22, 22, 22, 22, 22, 22, 22, 22, 22, 22, 22, 22, 22, 22, 22, 22, 22},
 {0, 4, 8, 12, 16, 16, 17, 17, 18, 18, 19, 19, 19, 19, 20, 20, 20, 20, 20, 21, 21, 21, 21, 21, 21, 22, 22, 22, 22, 22, 22, 22, 22, 22, 23, 23, 23, 23, 23, 23, 23, 23, 23, 23, 23, 23, 24, 24, 24, 24, 24, 24, 24, 24, 24, 24, 24, 24, 24, 24, 24, 24, 25, 25, 25, 25, 25, 25, 25, 25, 25, 25, 25, 25, 25, 25, 25, 25, 25, 25, 25, 25, 25, 26, 26, 26, 26, 26, 26, 26, 26, 26, 26, 26, 26, 26, 26, 26, 26, 26, 26, 26, 26, 26, 26, 26, 26, 26, 26, 26, 26, 26, 26, 27, 27, 27, 27, 27, 27, 27, 27, 27, 27, 27, 27, 27, 27, 27, 27},
 {0, 16, 18, 19, 20, 21, 21, 22, 22, 23, 23, 23, 24, 24, 24, 24, 25, 25, 25, 25, 25, 26, 26, 26, 26, 26, 26, 26, 26, 27, 27, 27, 27, 27, 27, 27, 27, 27, 27, 28, 28, 28, 28, 28, 28, 28, 28, 28, 28, 28, 28, 28, 29, 29, 29, 29, 29, 29, 29, 29, 29, 29, 29, 29, 29, 29, 29, 29, 29, 29, 30, 30, 30, 30, 30, 30, 30, 30, 30, 30, 30, 30, 30, 30, 30, 30, 30, 30, 30, 30, 30, 30, 30, 30, 30, 31, 31, 31, 31, 31, 31, 31, 31, 31, 31, 31, 31, 31, 31, 31, 31, 31, 31, 31, 31, 31, 31, 31, 31, 31, 31, 31, 31, 31, 31, 31, 31, 31, 31}};

__device__ __forceinline__ float wave_sum(float v) {
#pragma unroll
    for (int o = 1; o < 64; o <<= 1) v += __shfl_xor(v, o);
    return v;
}
__device__ __forceinline__ float siluf(float x) { return x / (1.f + __expf(-x)); }

__global__ void __launch_bounds__(256) k_rmsnorm_bf16(const float* __restrict__ x, const float* __restrict__ g, bf16_t* __restrict__ out) {
    const int row = blockIdx.x * 4 + (threadIdx.x >> 6), lane = threadIdx.x & 63;
    const float* xr = x + (size_t)row * D;
    float v[16]; float s = 0.f;
#pragma unroll
    for (int j = 0; j < 16; ++j) { v[j] = xr[lane + 64 * j]; s += v[j] * v[j]; }
    s = wave_sum(s);
    const float r = rsqrtf(s * (1.f / D) + EPS);
#pragma unroll
    for (int j = 0; j < 16; ++j) out[(size_t)row * D + lane + 64 * j] = f2bf(v[j] * r * g[lane + 64 * j]);
}

template <int MODE>
__global__ void __launch_bounds__(256) k_gemm(const bf16_t* __restrict__ A, int lda, const float* __restrict__ Bm, int ldb, int Mr, int N, int K,
                                              bf16_t* Cb, float* Cf, int ldc) {
    __shared__ float As[16][64 + 4];
    __shared__ float Bs[16][64 + 4];
    const int tx = threadIdx.x & 15, ty = threadIdx.x >> 4;
    const int m0 = blockIdx.y * 64, n0 = blockIdx.x * 64;
    float acc[4][4];
#pragma unroll
    for (int i = 0; i < 4; ++i)
#pragma unroll
        for (int j = 0; j < 4; ++j) acc[i][j] = 0.f;
    for (int k0 = 0; k0 < K; k0 += 16) {
#pragma unroll
        for (int i = 0; i < 4; ++i) { const int e = threadIdx.x + 256 * i, r = e >> 4, kk = e & 15; As[kk][r] = bf2f(A[(size_t)(m0 + r) * lda + k0 + kk]); }
#pragma unroll
        for (int i = 0; i < 4; ++i) { const int e = threadIdx.x + 256 * i, kk = e >> 6, c = e & 63; Bs[kk][c] = (n0 + c < N) ? Bm[(size_t)(k0 + kk) * ldb + n0 + c] : 0.f; }
        __syncthreads();
#pragma unroll
        for (int kk = 0; kk < 16; ++kk) {
            float a[4], b[4];
#pragma unroll
            for (int i = 0; i < 4; ++i) { a[i] = As[kk][ty * 4 + i]; b[i] = Bs[kk][tx * 4 + i]; }
#pragma unroll
            for (int i = 0; i < 4; ++i)
#pragma unroll
                for (int j = 0; j < 4; ++j) acc[i][j] += a[i] * b[j];
        }
        __syncthreads();
    }
#pragma unroll
    for (int i = 0; i < 4; ++i)
#pragma unroll
        for (int j = 0; j < 4; ++j) {
            const int r = m0 + ty * 4 + i, c = n0 + tx * 4 + j;
            if (c < N) {
                if (MODE == 0) Cb[(size_t)r * ldc + c] = f2bf(acc[i][j]);
                else if (MODE == 1) Cf[(size_t)r * ldc + c] = acc[i][j];
                else { const float gte = bf2f(Cb[(size_t)r * ldc + c]); Cb[(size_t)r * ldc + c] = f2bf(siluf(gte) * acc[i][j]); }
            }
        }
}

__global__ void __launch_bounds__(128) k_gdn_prep(const bf16_t* __restrict__ proj, const float* __restrict__ ba, const float* __restrict__ conv_w,
                                                 const float* __restrict__ a_log, const float* __restrict__ dt_bias,
                                                 bf16_t* __restrict__ qh, bf16_t* __restrict__ kh, bf16_t* __restrict__ vh, float* __restrict__ bg) {
    const int m = blockIdx.x >> 2, h = blockIdx.x & 3, c = threadIdx.x, t = m % SEQ;
    __shared__ float red[2][2];
    float val[3];
#pragma unroll
    for (int s = 0; s < 3; ++s) {
        const int ch = s * 512 + h * 128 + c;
        float a = 0.f;
#pragma unroll
        for (int i = 0; i < 4; ++i) { const int tt = t - 3 + i; if (tt >= 0) a += conv_w[i * 1536 + ch] * bf2f(proj[(size_t)(m - 3 + i) * PW + ch]); }
        val[s] = siluf(a);
    }
    float sq = wave_sum(val[0] * val[0]), sk = wave_sum(val[1] * val[1]);
    const int w = threadIdx.x >> 6;
    if ((threadIdx.x & 63) == 0) { red[0][w] = sq; red[1][w] = sk; }
    __syncthreads();
    sq = red[0][0] + red[0][1]; sk = red[1][0] + red[1][1];
    const float qn = val[0] * rsqrtf(sq + 1e-6f) * 0.08838834764831845f;
    const float kn = val[1] * rsqrtf(sk + 1e-6f);
    qh[(size_t)m * 512 + h * 128 + c] = f2bf(qn);
    kh[(size_t)m * 512 + h * 128 + c] = f2bf(kn);
    vh[(size_t)m * 512 + h * 128 + c] = f2bf(val[2]);
    if (c == 0) {
        const float bl = ba[(size_t)m * 8 + h], al = ba[(size_t)m * 8 + 4 + h];
        const float beta = 1.f / (1.f + expf(-bl));
        const float xx = al + dt_bias[h];
        const float sp = fmaxf(xx, 0.f) + log1pf(expf(-fabsf(xx)));
        bg[(size_t)m * 8 + h] = beta;
        bg[(size_t)m * 8 + 4 + h] = -expf(a_log[h]) * sp;
    }
}

__global__ void __launch_bounds__(128) k_gdn_seq(const bf16_t* __restrict__ qh, const bf16_t* __restrict__ kh, const bf16_t* __restrict__ vh,
                                                const float* __restrict__ bg, float* __restrict__ oraw) {
    const int b = blockIdx.x >> 2, h = blockIdx.x & 3, dv = threadIdx.x;
    __shared__ float kq[2][2][128];
    float Sx[128];
#pragma unroll
    for (int i = 0; i < 128; ++i) Sx[i] = 0.f;
    for (int t = 0; t < SEQ; ++t) {
        const size_t m = (size_t)b * SEQ + t;
        const int p = t & 1;
        kq[p][0][dv] = bf2f(kh[m * 512 + h * 128 + dv]);
        kq[p][1][dv] = bf2f(qh[m * 512 + h * 128 + dv]);
        const float v = bf2f(vh[m * 512 + h * 128 + dv]);
        const float beta = bg[m * 8 + h], eg = expf(bg[m * 8 + 4 + h]);
        __syncthreads();
        float ks = 0.f;
#pragma unroll
        for (int i = 0; i < 128; ++i) ks += kq[p][0][i] * Sx[i];
        const float dlt = beta * (v - eg * ks);
        float o = 0.f;
#pragma unroll
        for (int i = 0; i < 128; ++i) { Sx[i] = eg * Sx[i] + kq[p][0][i] * dlt; o += kq[p][1][i] * Sx[i]; }
        oraw[m * 512 + h * 128 + dv] = o;
    }
}

__global__ void __launch_bounds__(128) k_gdn_out(const float* __restrict__ oraw, const bf16_t* __restrict__ proj, const float* __restrict__ onorm_g, bf16_t* __restrict__ mixo) {
    const int m = blockIdx.x >> 2, h = blockIdx.x & 3, c = threadIdx.x;
    __shared__ float red[2];
    const float o = oraw[(size_t)m * 512 + h * 128 + c];
    float s = wave_sum(o * o);
    if ((threadIdx.x & 63) == 0) red[threadIdx.x >> 6] = s;
    __syncthreads();
    s = red[0] + red[1];
    const float gt = bf2f(proj[(size_t)m * PW + P_GA + h * 128 + c]);
    mixo[(size_t)m * D + h * 128 + c] = f2bf(o * rsqrtf(s * (1.f / 128.f) + EPS) * onorm_g[c] * siluf(gt));
}

__global__ void __launch_bounds__(64) k_swa(const bf16_t* __restrict__ proj, const float* __restrict__ rel_bias, bf16_t* __restrict__ mixo) {
    const int m = blockIdx.x >> 3, h = blockIdx.x & 7, lane = threadIdx.x, t = m % SEQ;
    __shared__ float sc[3][132];
    __shared__ float qs[64];
    qs[lane] = bf2f(proj[(size_t)m * PW + P_QB + h * 64 + lane]);
    __syncthreads();
    float mx = -INFINITY;
    for (int p = 0; p < 3; ++p) {
        const int dil = p == 0 ? 1 : (p == 1 ? 4 : 16);
        for (int j = lane; j < 129; j += 64) {
            const int tk = t - j * dil;
            float s = -INFINITY;
            if (tk >= 0) {
                const bf16_t* kr = proj + (size_t)(m - j * dil) * PW + P_KB + h * 64;
                float a = 0.f;
                for (int d = 0; d < 64; ++d) a += qs[d] * bf2f(kr[d]);
                s = a * 0.125f + rel_bias[c_bkt[p][j] * 8 + h];
            }
            sc[p][j] = s; mx = fmaxf(mx, s);
        }
    }
#pragma unroll
    for (int o = 1; o < 64; o <<= 1) mx = fmaxf(mx, __shfl_xor(mx, o));
    __syncthreads();
    float sum = 0.f;
    for (int p = 0; p < 3; ++p)
        for (int j = lane; j < 129; j += 64) { const float e = (sc[p][j] == -INFINITY) ? 0.f : __expf(sc[p][j] - mx); sc[p][j] = e; sum += e; }
    sum = wave_sum(sum);
    __syncthreads();
    float acc = 0.f;
    for (int p = 0; p < 3; ++p) {
        const int dil = p == 0 ? 1 : (p == 1 ? 4 : 16);
        for (int j = 0; j < 129; ++j) {
            const int tk = t - j * dil; if (tk < 0) break;
            acc += sc[p][j] * bf2f(proj[(size_t)(m - j * dil) * PW + P_VB + h * 64 + lane]);
        }
    }
    mixo[(size_t)m * D + 512 + h * 64 + lane] = f2bf(acc / sum);
}

__global__ void __launch_bounds__(256) k_norm_res(const float* __restrict__ y, const float* __restrict__ g1, const float* base, float* out,
                                                 const float* __restrict__ g2, bf16_t* __restrict__ hn) {
    const int row = blockIdx.x * 4 + (threadIdx.x >> 6), lane = threadIdx.x & 63;
    const float* yr = y + (size_t)row * D;
    float v[16]; float s = 0.f;
#pragma unroll
    for (int j = 0; j < 16; ++j) { v[j] = yr[lane + 64 * j]; s += v[j] * v[j]; }
    s = wave_sum(s);
    const float r = rsqrtf(s * (1.f / D) + EPS);
    float s2 = 0.f;
#pragma unroll
    for (int j = 0; j < 16; ++j) { v[j] = base[(size_t)row * D + lane + 64 * j] + v[j] * r * g1[lane + 64 * j]; s2 += v[j] * v[j]; out[(size_t)row * D + lane + 64 * j] = v[j]; }
    if (hn) {
        s2 = wave_sum(s2);
        const float r2 = rsqrtf(s2 * (1.f / D) + EPS);
#pragma unroll
        for (int j = 0; j < 16; ++j) hn[(size_t)row * D + lane + 64 * j] = f2bf(v[j] * r2 * g2[lane + 64 * j]);
    }
}

extern "C" void kernel_launch(void* const* d_in, const int* in_sizes, int n_in, void* d_out, int out_size, void* d_ws, size_t ws_size, hipStream_t stream) {
    const float* x = (const float*)d_in[0];
    const float* w_in = (const float*)d_in[1];
    const float* conv_w = (const float*)d_in[2];
    const float* a_log = (const float*)d_in[3];
    const float* dt_bias = (const float*)d_in[4];
    const float* onorm_g = (const float*)d_in[5];
    const float* rel_bias = (const float*)d_in[6];
    const float* w_out = (const float*)d_in[7];
    const float* g_mix_pre = (const float*)d_in[8];
    const float* g_mix_post = (const float*)d_in[9];
    const float* w_gate = (const float*)d_in[10];
    const float* w_up = (const float*)d_in[11];
    const float* w_down = (const float*)d_in[12];
    const float* g_ffn_pre = (const float*)d_in[13];
    const float* g_ffn_post = (const float*)d_in[14];
    float* out = (float*)d_out;
    const size_t MiB = 1u << 20;
    if (ws_size < 452 * MiB) { fprintf(stderr, "kernel_launch: workspace too small: %zu\n", ws_size); return; }
    unsigned char* ws = (unsigned char*)d_ws;
    bf16_t* H1 = (bf16_t*)(ws + 0);
    bf16_t* PROJ = (bf16_t*)(ws + 64 * MiB);
    float* BA = (float*)(ws + 288 * MiB);
    float* BG = (float*)(ws + 289 * MiB);
    bf16_t* QH = (bf16_t*)(ws + 290 * MiB);
    bf16_t* KH = (bf16_t*)(ws + 322 * MiB);
    bf16_t* VH = (bf16_t*)(ws + 354 * MiB);
    float* ORAW = (float*)(ws + 386 * MiB);
    bf16_t* MIXO = H1;
    float* Y = (float*)(ws + 290 * MiB);
    bf16_t* H2 = H1;
    bf16_t* HID = PROJ;

    k_rmsnorm_bf16<<<M / 4, 256, 0, stream>>>(x, g_mix_pre, H1);
    k_gemm<0><<<dim3(2048 / 64, M / 64), 256, 0, stream>>>(H1, D, w_in + 0, NC_IN, M, 2048, D, PROJ + 0, nullptr, PW);
    k_gemm<1><<<dim3(1, M / 64), 256, 0, stream>>>(H1, D, w_in + C_BETA, NC_IN, M, 8, D, nullptr, BA, 8);
    k_gemm<0><<<dim3(1536 / 64, M / 64), 256, 0, stream>>>(H1, D, w_in + C_QB, NC_IN, M, 1536, D, PROJ + 2048, nullptr, PW);
    k_gdn_prep<<<M * 4, 128, 0, stream>>>(PROJ, BA, conv_w, a_log, dt_bias, QH, KH, VH, BG);
    k_gdn_seq<<<32, 128, 0, stream>>>(QH, KH, VH, BG, ORAW);
    k_gdn_out<<<M * 4, 128, 0, stream>>>(ORAW, PROJ, onorm_g, MIXO);
    k_swa<<<M * 8, 64, 0, stream>>>(PROJ, rel_bias, MIXO);
    k_gemm<1><<<dim3(D / 64, M / 64), 256, 0, stream>>>(MIXO, D, w_out, D, M, D, D, nullptr, Y, D);
    k_norm_res<<<M / 4, 256, 0, stream>>>(Y, g_mix_post, x, out, g_ffn_pre, H2);
    k_gemm<0><<<dim3(DFF / 64, M / 64), 256, 0, stream>>>(H2, D, w_gate, DFF, M, DFF, D, HID, nullptr, DFF);
    k_gemm<2><<<dim3(DFF / 64, M / 64), 256, 0, stream>>>(H2, D, w_up, DFF, M, DFF, D, HID, nullptr, DFF);
    k_gemm<1><<<dim3(D / 64, M / 64), 256, 0, stream>>>(HID, DFF, w_down, D, M, D, DFF, nullptr, Y, D);
    k_norm_res<<<M / 4, 256, 0, stream>>>(Y, g_ffn_post, out, out, nullptr, nullptr);
}
```

```cpp
#include <hip/hip_runtime.h>
#include <cstdio>
#include <cstdint>
#include <cmath>
namespace pg8 {
#define PG8_LAS __attribute__((address_space(3)))
typedef unsigned short bf16_t;
typedef short bf16x8 __attribute__((ext_vector_type(8)));
typedef float f32x4 __attribute__((ext_vector_type(4)));
typedef unsigned u32x4 __attribute__((ext_vector_type(4)));
constexpr int BM = 256, BK = 64, HALF = 128, HTB = HALF * BK * 2  , STAGE_BYTES = 8 * HTB, NXCD = 8, WGM = 8;

__host__ __device__ __forceinline__ int lds_byte(int r, int c) { const int st = (r >> 4) * 2 + (c >> 5), rr = r & 15, cc = c & 31, ob = rr * 64 + cc * 2; return st * 1024 + (ob ^ (((ob >> 9) & 1) << 5)); }
__host__ __device__ __forceinline__ void stage_rc(int b, int& R, int& C) { const int st = b / 1024, sb = b % 1024, swz = sb ^ (((sb >> 9) & 1) << 5); R = (st >> 1) * 16 + swz / 64; C = (st & 1) * 32 + (swz % 64) / 2; }
__host__ __device__ __forceinline__ int perm32(int rho) { const int n = rho >> 4, i = rho & 15; return 8 * (i >> 2) + 4 * n + (i & 3); }

struct Unit { int pm, pn; };
struct Gemm { const bf16_t* A; const bf16_t* Bt; int M, N, K; };

struct StaticOrder {
    int nM, nN, nwg, G, c;
    __host__ __device__ void init(int M, int N, int G_, int c_) { nM = M / BM; nN = N / BM; nwg = nM * nN; G = G_; c = c_; }
    __host__ __device__ bool next(int i, Unit& u) const {
        const long L = (long)i * G + c; if (L >= nwg) return false;
        int wgid = (int)L; { const int q = nwg / NXCD, r = nwg % NXCD, xcd = wgid % NXCD, off = wgid / NXCD; wgid = (xcd < r ? xcd * (q + 1) : r * (q + 1) + (xcd - r) * q) + off; }
        const int nig = WGM * nN, gid = wgid / nig, fm = gid * WGM, gsz = (nM - fm) < WGM ? (nM - fm) : WGM;
        u.pm = fm + ((wgid % nig) % gsz); u.pn = (wgid % nig) / gsz; return true;
    }
    __device__ __forceinline__ void a_ready(const Unit&) const {}
    __device__ __forceinline__ void done(const Unit&) const {}
};

__device__ __forceinline__ unsigned cvt_pk_bf16(float lo, float hi) { unsigned r; asm volatile("v_cvt_pk_bf16_f32 %0, %1, %2" : "=v"(r) : "v"(lo), "v"(hi)); return r; }
typedef float f32x2 __attribute__((ext_vector_type(2)));
__device__ __forceinline__ f32x2 gelu_pk(f32x2 v) {
    const f32x2 av = __builtin_elementwise_abs(v), d = av * 0.2316418882f + 1.0f;
    f32x2 t; t.x = __builtin_amdgcn_rcpf(d.x); t.y = __builtin_amdgcn_rcpf(d.y);
    f32x2 q = t * 0.5307027145f + (-0.7265760135f); q = q * t + 0.7107068705f; q = q * t + (-0.142248368f); q = q * t + 0.127414796f; q = q * t;
    const f32x2 s = (v * v) * (-0.72134752044f);
    f32x2 e; e.x = __builtin_amdgcn_exp2f(s.x); e.y = __builtin_amdgcn_exp2f(s.y);
    const f32x2 m = v * (q * e), r = v - m;
    f32x2 o; o.x = v.x < 0.f ? m.x : r.x; o.y = v.y < 0.f ? m.y : r.y; return o;
}

template <int ACT  > struct EpiBf16 {
    static constexpr bool PERM = true, AFTER_DRAIN = false; static_assert(ACT == 0 || ACT == 1, "EpiBf16: ACT is 0 (none) or 1 (gelu_pk)");
    bf16_t* O; int ldc; const float* bias; int split_cols; size_t split_stride; float scale0;
    __device__ __forceinline__ void operator()(const f32x4 (&acc)[2][2][4][2], const Unit& u, int wr, int wc, int fr, int fq) const {
        const int row0 = u.pm * BM + wr * 64 + fr; int colt = u.pn * BM; bf16_t* base = O;
        float sc = 1.f; if (split_cols) { const int t = colt / split_cols; base += (size_t)t * split_stride; colt -= t * split_cols; if (t == 0) sc = scale0; }
        const int col0 = colt + wc * 32 + 8 * fq, bcol0 = u.pn * BM + wc * 32 + 8 * fq;
        f32x4 bv[2][2];
#pragma unroll
        for (int bj = 0; bj < 2; ++bj)
#pragma unroll
            for (int n = 0; n < 2; ++n) bv[bj][n] = bias ? *(const f32x4*)(bias + bcol0 + bj * HALF + 4 * n) : (f32x4){0.f, 0.f, 0.f, 0.f};
#pragma unroll
        for (int ai = 0; ai < 2; ++ai)
#pragma unroll
            for (int m = 0; m < 4; ++m) { bf16_t* rowp = base + (size_t)(row0 + ai * HALF + m * 16) * ldc + col0;
#pragma unroll
                for (int bj = 0; bj < 2; ++bj) { f32x4 v0 = acc[ai][bj][m][0] + bv[bj][0], v1 = acc[ai][bj][m][1] + bv[bj][1];
                    if (ACT == 1) { f32x2 a = gelu_pk((f32x2){v0[0], v0[1]}), b = gelu_pk((f32x2){v0[2], v0[3]}), c = gelu_pk((f32x2){v1[0], v1[1]}), d = gelu_pk((f32x2){v1[2], v1[3]});
                        v0 = (f32x4){a.x, a.y, b.x, b.y}; v1 = (f32x4){c.x, c.y, d.x, d.y}; }
                    v0 = v0 * sc; v1 = v1 * sc; u32x4 w; w.x = cvt_pk_bf16(v0[0], v0[1]); w.y = cvt_pk_bf16(v0[2], v0[3]); w.z = cvt_pk_bf16(v1[0], v1[1]); w.w = cvt_pk_bf16(v1[2], v1[3]);
                    *(u32x4*)(rowp + bj * HALF) = w; } }
    }
};

struct PanelStats {
    unsigned* xbuf;
    unsigned* cnt;
    unsigned* tmo;
    int ntn; float eps;
    unsigned code;
    __device__ __forceinline__ bool run(const f32x4 (&v)[2][2][4][2], const Unit& u, int wr, int wc, int fr, int fq, PG8_LAS unsigned char* lds, int wid, int lane) const {
        typedef float f32x2v __attribute__((ext_vector_type(2)));
        PG8_LAS f32x2v* P = (PG8_LAS f32x2v*)lds;
        PG8_LAS f32x2v* S = (PG8_LAS f32x2v*)(lds + 8192);
        PG8_LAS unsigned* flag = (PG8_LAS unsigned*)(lds + 8192 + 2048);
#pragma unroll
        for (int ai = 0; ai < 2; ++ai)
#pragma unroll
            for (int m = 0; m < 4; ++m) {
                float s = 0.f;
#pragma unroll
                for (int bj = 0; bj < 2; ++bj)
#pragma unroll
                    for (int n = 0; n < 2; ++n) { const f32x4 x = v[ai][bj][m][n]; s += (x[0] + x[1]) + (x[2] + x[3]); }
                s += __shfl_xor(s, 16); s += __shfl_xor(s, 32);
                const float mw = s * (1.0f / 64.0f); float q = 0.f;
#pragma unroll
                for (int bj = 0; bj < 2; ++bj)
#pragma unroll
                    for (int n = 0; n < 2; ++n) { const f32x4 d = v[ai][bj][m][n] - mw; q += (d[0] * d[0] + d[1] * d[1]) + (d[2] * d[2] + d[3] * d[3]); }
                q += __shfl_xor(q, 16); q += __shfl_xor(q, 32);
                if (fq == 0) P[(ai * HALF + wr * 64 + m * 16 + fr) * 4 + wc] = (f32x2v){mw, q};
            }
        asm volatile("s_waitcnt lgkmcnt(0)" ::: "memory"); __builtin_amdgcn_s_barrier(); asm volatile("" ::: "memory");
#if defined(BROKEN_EXCHANGE_NO_WAIT)
#warning BROKEN CONTROL BUILD: the row-statistics exchange does not wait; results are wrong by design
        if (blockIdx.x >= 64) { const long long t0_ = clock64(); while (clock64() - t0_ < 60000) __builtin_amdgcn_s_sleep(8); }
#endif
        const int row = wid * 32 + (lane & 31);
        if (lane < 32) {
            const f32x2v a = P[row * 4 + 0], b = P[row * 4 + 1], c = P[row * 4 + 2], d = P[row * 4 + 3];
            const float mt = (a.x + b.x + c.x + d.x) * 0.25f;
            const float da = a.x - mt, db = b.x - mt, dc = c.x - mt, dd = d.x - mt;
            const float m2 = (a.y + b.y) + (c.y + d.y) + 64.0f * ((da * da + db * db) + (dc * dc + dd * dd));
            unsigned long long* slot = (unsigned long long*)xbuf + ((size_t)(u.pm * BM + row) * 4 + u.pn);
            __hip_atomic_store(slot, ((unsigned long long)__float_as_uint(m2) << 32) | __float_as_uint(mt), __ATOMIC_RELAXED, __HIP_MEMORY_SCOPE_AGENT);
        }
        asm volatile("s_waitcnt vmcnt(0)" ::: "memory");
        if (lane == 0) __hip_atomic_fetch_add(cnt + 64 * u.pm, 1u, __ATOMIC_RELAXED, __HIP_MEMORY_SCOPE_AGENT);
        if (wid == 0) {
            bool dead = false; const unsigned long long t0 = __builtin_amdgcn_s_memrealtime(); const unsigned want = 8u * (unsigned)ntn;
            for (;;) {
#if defined(BROKEN_EXCHANGE_NO_WAIT)
                break;
#endif
                if ((unsigned)__builtin_amdgcn_readfirstlane(__hip_atomic_load(cnt + 64 * u.pm, __ATOMIC_RELAXED, __HIP_MEMORY_SCOPE_AGENT)) >= want) break;
                if (__builtin_amdgcn_s_memrealtime() - t0 > 2000000ull) {
                    if (lane == 0) { unsigned expect = 0u; __hip_atomic_compare_exchange_strong(tmo + 1, &expect, code | (unsigned)(u.pm & 0xff), __ATOMIC_RELAXED, __ATOMIC_RELAXED, __HIP_MEMORY_SCOPE_AGENT);
                                     __hip_atomic_store(tmo, 1u, __ATOMIC_RELAXED, __HIP_MEMORY_SCOPE_AGENT); }
                    dead = true; break; }
                __builtin_amdgcn_s_sleep(2);
            }
            __builtin_amdgcn_fence(__ATOMIC_ACQUIRE, "agent");
            if (lane == 0) flag[0] = dead ? 1u : 0u;
        }
        asm volatile("s_waitcnt vmcnt(0) lgkmcnt(0)" ::: "memory"); __builtin_amdgcn_s_barrier(); asm volatile("" ::: "memory");
        const bool bad = flag[0] != 0u;
        if (lane < 32) {
            const unsigned long long* slot = (const unsigned long long*)xbuf + (size_t)(u.pm * BM + row) * 4; float mt[4], m2[4]; float ms = 0.f;
#pragma unroll
            for (int t = 0; t < 4; ++t) { if (t < ntn) { const unsigned long long w = __hip_atomic_load(slot + t, __ATOMIC_RELAXED, __HIP_MEMORY_SCOPE_AGENT); mt[t] = __uint_as_float((unsigned)w); m2[t] = __uint_as_float((unsigned)(w >> 32)); } else { mt[t] = 0.f; m2[t] = 0.f; } ms += mt[t]; }
            const float mean = ms / (float)ntn; float q = 0.f;
#pragma unroll
            for (int t = 0; t < 4; ++t) if (t < ntn) { const float dm = mt[t] - mean; q += m2[t] + 256.0f * dm * dm; }
            S[row] = (f32x2v){mean, 1.0f / sqrtf(q / (256.0f * (float)ntn) + eps)};
        }
        asm volatile("s_waitcnt lgkmcnt(0)" ::: "memory"); __builtin_amdgcn_s_barrier(); asm volatile("" ::: "memory");
        return bad;
    }
};
struct EpiLnRes {
    static constexpr bool PERM = false, AFTER_DRAIN = true;
    const float* base; float* out; int ldc; const float* bias; PanelStats st; unsigned poison;
    __device__ __forceinline__ void fused(f32x4 (&acc)[2][2][4][2], const Unit& u, int wr, int wc, int fr, int fq, PG8_LAS unsigned char* lds, int wid, int lane) const {
        typedef float f32x2v __attribute__((ext_vector_type(2)));
        const PG8_LAS f32x2v* S = (const PG8_LAS f32x2v*)(lds + 8192);
        const int col0 = u.pn * BM + wc * 32 + 4 * fq;
#pragma unroll
        for (int bj = 0; bj < 2; ++bj)
#pragma unroll
            for (int n = 0; n < 2; ++n) { const f32x4 bv = bias ? *(const f32x4*)(bias + col0 + bj * HALF + n * 16) : (f32x4){0.f, 0.f, 0.f, 0.f};
#pragma unroll
                for (int ai = 0; ai < 2; ++ai)
#pragma unroll
                    for (int m = 0; m < 4; ++m) acc[ai][bj][m][n] += bv; }
        f32x4 pre[4][2][2];
#pragma unroll
        for (int m = 0; m < 4; ++m) { const size_t off = (size_t)(u.pm * BM + wr * 64 + m * 16 + fr) * ldc + col0;
#pragma unroll
            for (int bj = 0; bj < 2; ++bj)
#pragma unroll
                for (int n = 0; n < 2; ++n) pre[m][bj][n] = *(const f32x4*)(base + off + bj * HALF + n * 16); }
        const bool bad = st.run(acc, u, wr, wc, fr, fq, lds, wid, lane) || poison != 0u;
        const float qnan = __builtin_nanf("");
#pragma unroll
        for (int ai = 0; ai < 2; ++ai)
#pragma unroll
            for (int m = 0; m < 4; ++m) { const int r = ai * HALF + wr * 64 + m * 16 + fr; const f32x2v sr = S[r]; const size_t off = (size_t)(u.pm * BM + r) * ldc + col0;
#pragma unroll
                for (int bj = 0; bj < 2; ++bj)
#pragma unroll
                    for (int n = 0; n < 2; ++n) { const f32x4 bs = ai == 0 ? pre[m][bj][n] : *(const f32x4*)(base + off + bj * HALF + n * 16); f32x4 o = bs + (acc[ai][bj][m][n] - sr.x) * sr.y;
                        if (bad) o = (f32x4){qnan, qnan, qnan, qnan}; *(f32x4*)(out + off + bj * HALF + n * 16) = o; }
                if (m & 1) asm volatile("" ::: "memory"); }
    }
};
struct EpiLnResLn {
    static constexpr bool PERM = false, AFTER_DRAIN = true;
    const float* base; float* out; bf16_t* xn; int ldc; const float* bias; PanelStats st1, st2; unsigned poison;
    __device__ __forceinline__ void fused(f32x4 (&acc)[2][2][4][2], const Unit& u, int wr, int wc, int fr, int fq, PG8_LAS unsigned char* lds, int wid, int lane) const {
        typedef float f32x2v __attribute__((ext_vector_type(2))); typedef unsigned u32x2v __attribute__((ext_vector_type(2)));
        const PG8_LAS f32x2v* S = (const PG8_LAS f32x2v*)(lds + 8192);
        const int col0 = u.pn * BM + wc * 32 + 4 * fq;
#pragma unroll
        for (int bj = 0; bj < 2; ++bj)
#pragma unroll
            for (int n = 0; n < 2; ++n) { const f32x4 bv = bias ? *(const f32x4*)(bias + col0 + bj * HALF + n * 16) : (f32x4){0.f, 0.f, 0.f, 0.f};
#pragma unroll
                for (int ai = 0; ai < 2; ++ai)
#pragma unroll
                    for (int m = 0; m < 4; ++m) acc[ai][bj][m][n] += bv; }
        bool bad = st1.run(acc, u, wr, wc, fr, fq, lds, wid, lane) || poison != 0u;
        const float qnan = __builtin_nanf("");
#pragma unroll
        for (int ai = 0; ai < 2; ++ai)
#pragma unroll
            for (int m = 0; m < 4; ++m) { const int r = ai * HALF + wr * 64 + m * 16 + fr; const f32x2v sr = S[r]; const size_t off = (size_t)(u.pm * BM + r) * ldc + col0;
#pragma unroll
                for (int bj = 0; bj < 2; ++bj)
#pragma unroll
                    for (int n = 0; n < 2; ++n) { const f32x4 bs = *(const f32x4*)(base + off + bj * HALF + n * 16); acc[ai][bj][m][n] = bs + (acc[ai][bj][m][n] - sr.x) * sr.y; }
                asm volatile("" : "+v"(acc[ai][0][m][0]), "+v"(acc[ai][0][m][1]), "+v"(acc[ai][1][m][0]), "+v"(acc[ai][1][m][1]));
                if (m & 1) asm volatile("" ::: "memory"); }
        const bool bad1 = bad;
        bad = st2.run(acc, u, wr, wc, fr, fq, lds, wid, lane) || bad;
#pragma unroll
        for (int ai = 0; ai < 2; ++ai)
#pragma unroll
            for (int m = 0; m < 4; ++m) { const int r = ai * HALF + wr * 64 + m * 16 + fr; const f32x2v sr = S[r]; const size_t off = (size_t)(u.pm * BM + r) * ldc + col0;
#pragma unroll
                for (int bj = 0; bj < 2; ++bj)
#pragma unroll
                    for (int n = 0; n < 2; ++n) { const f32x4 x1 = acc[ai][bj][m][n]; *(f32x4*)(out + off + bj * HALF + n * 16) = bad1 ? (f32x4){qnan, qnan, qnan, qnan} : x1;
                        const f32x4 o = (x1 - sr.x) * sr.y; u32x2v w; w.x = cvt_pk_bf16(o[0], o[1]); w.y = cvt_pk_bf16(o[2], o[3]);
                        if (bad) { w.x = 0x7fc07fc0u; w.y = 0x7fc07fc0u; } *(u32x2v*)(xn + off + bj * HALF + n * 16) = w; }
                asm volatile("" ::: "memory"); }
    }
};

template <class Epi, class Sched, bool ALIGN_EPI = false, bool SP2 = false>
__device__ __forceinline__ void gemm_phase(PG8_LAS unsigned char* lds, const Gemm g, const Sched& S, const Epi& E) {
    const int tid = threadIdx.x, wid = __builtin_amdgcn_readfirstlane(tid >> 6), lane = tid & 63, wr = wid >> 2, wc = wid & 3, fr = lane & 15, fq = lane >> 4;
    const int K = g.K, nt = K / BK;
    unsigned voffA[2], voffB[2];
#pragma unroll
    for (int i = 0; i < 2; ++i) { int R, C; stage_rc(tid * 16 + i * 8192, R, C); const int Rb = Epi::PERM ? ((R & ~31) + perm32(R & 31)) : R;
        voffA[i] = (unsigned)(R * K + C) * 2u; voffB[i] = (unsigned)(Rb * K + C) * 2u; }
    const size_t kstep = (size_t)(BK * 2);
    const size_t hstep = (size_t)HALF * K * 2;
    const size_t tstep = 2 * hstep;
    const unsigned ldsw = (unsigned)wid * 1024u;
    const int aoff = lds_byte(wr * 64 + fr, fq * 8), boff = lds_byte(wc * 32 + fr, fq * 8);
#define PG8_SA(b, h) (((b) * 2 + (h)) * HTB)
#define PG8_SB(b, h) ((4 + (b) * 2 + (h)) * HTB)
#define PG8_STAGE(bufoff, gbase, voff) do { _Pragma("unroll") for (int _i = 0; _i < 2; ++_i) \
        __builtin_amdgcn_global_load_lds((const unsigned*)((const char*)(gbase) + (voff)[_i]), (PG8_LAS unsigned*)(lds + (bufoff) + ldsw + _i * 8192), 16, 0, 0); } while (0)
#define PG8_LDA(dst, b, h) do { _Pragma("unroll") for (int m = 0; m < 4; ++m) _Pragma("unroll") for (int k = 0; k < 2; ++k) dst[m][k] = *(const PG8_LAS bf16x8*)(lds + PG8_SA(b, h) + aoff + m * 2048 + k * 1024); } while (0)
#define PG8_LDB(dst, b, h) do { _Pragma("unroll") for (int n = 0; n < 2; ++n) _Pragma("unroll") for (int k = 0; k < 2; ++k) dst[n][k] = *(const PG8_LAS bf16x8*)(lds + PG8_SB(b, h) + boff + n * 2048 + k * 1024); } while (0)
#define PG8_MMA(ai, bj, At, Bt) do { __builtin_amdgcn_s_setprio(1); _Pragma("unroll") for (int m = 0; m < 4; ++m) _Pragma("unroll") for (int n = 0; n < 2; ++n) _Pragma("unroll") for (int k = 0; k < 2; ++k) \
        acc[ai][bj][m][n] = __builtin_amdgcn_mfma_f32_16x16x32_bf16(Bt[n][k], At[m][k], acc[ai][bj][m][n], 0, 0, 0); __builtin_amdgcn_s_setprio(0); } while (0)
#define PG8_WAIT_V(n) asm volatile("s_waitcnt vmcnt(" #n ")" ::: "memory")
#define PG8_WAIT_L(n) asm volatile("s_waitcnt lgkmcnt(" #n ")" ::: "memory")
#define PG8_BAR __builtin_amdgcn_s_barrier()
#define PG8_SCHED __builtin_amdgcn_sched_barrier(0)
    Unit cur, nxt; int ui = 0;
    if (!S.next(0, cur)) return;
    f32x4 acc[2][2][4][2];
#pragma unroll
    for (int a = 0; a < 2; ++a)
#pragma unroll
        for (int b = 0; b < 2; ++b)
#pragma unroll
            for (int m = 0; m < 4; ++m)
#pragma unroll
                for (int n = 0; n < 2; ++n) acc[a][b][m][n] = (f32x4){0.f, 0.f, 0.f, 0.f};
    bf16x8 At[4][2], B0[2][2], B1[2][2];
    const char* cA = (const char*)g.A + (size_t)cur.pm * tstep; const char* cB = (const char*)g.Bt + (size_t)cur.pn * tstep;
    S.a_ready(cur);
    if constexpr (SP2) {
        PG8_STAGE(PG8_SB(0, 0), cB, voffB); PG8_STAGE(PG8_SB(0, 1), cB + hstep, voffB); PG8_STAGE(PG8_SA(0, 0), cA, voffA); PG8_STAGE(PG8_SA(0, 1), cA + hstep, voffA);
        if (wr == 1) PG8_BAR;
        PG8_WAIT_V(2); PG8_BAR;
        PG8_STAGE(PG8_SB(1, 0), cB + kstep, voffB); PG8_STAGE(PG8_SA(1, 0), cA + kstep, voffA); PG8_STAGE(PG8_SB(1, 1), cB + hstep + kstep, voffB);
        PG8_WAIT_V(6); PG8_BAR;
    } else {
        PG8_STAGE(PG8_SB(0, 0), cB, voffB); PG8_STAGE(PG8_SA(0, 0), cA, voffA); PG8_STAGE(PG8_SB(0, 1), cB + hstep, voffB); PG8_STAGE(PG8_SA(0, 1), cA + hstep, voffA);
        if (wr == 1) PG8_BAR;
        PG8_WAIT_V(4); PG8_BAR;
        PG8_STAGE(PG8_SB(1, 0), cB + kstep, voffB); PG8_STAGE(PG8_SA(1, 0), cA + kstep, voffA); PG8_STAGE(PG8_SB(1, 1), cB + hstep + kstep, voffB);
        PG8_WAIT_V(6); PG8_BAR;
    }
    for (;;) {
        const bool has_next = S.next(ui + 1, nxt);
        const char* nA = has_next ? (const char*)g.A + (size_t)nxt.pm * tstep : cA; const char* nB = has_next ? (const char*)g.Bt + (size_t)nxt.pn * tstep : cB;
        for (int t = 0; t < nt; t += 2) {
            const bool last = (t == nt - 2);
            const char* a1 = cA + (size_t)(t + 1) * kstep;
            const char* a2 = last ? nA : cA + (size_t)(t + 2) * kstep; const char* b2 = last ? nB : cB + (size_t)(t + 2) * kstep;
            const char* a3 = a2 + kstep; const char* b3 = b2 + kstep;
            if (last && has_next) S.a_ready(nxt);
            if constexpr (SP2) {
            PG8_LDB(B0, 0, 0); PG8_LDB(B1, 0, 1); PG8_SCHED; PG8_LDA(At, 0, 0); PG8_STAGE(PG8_SA(1, 1), a1 + hstep, voffA);
            PG8_WAIT_V(8); PG8_WAIT_L(0); PG8_BAR; PG8_MMA(0, 0, At, B0); PG8_MMA(0, 1, At, B1); PG8_BAR; PG8_SCHED;
            PG8_LDA(At, 0, 1); PG8_STAGE(PG8_SB(0, 0), b2, voffB); PG8_STAGE(PG8_SB(0, 1), b2 + hstep, voffB); PG8_STAGE(PG8_SA(0, 0), a2, voffA);
            PG8_WAIT_V(8); PG8_WAIT_L(0); PG8_BAR; PG8_MMA(1, 0, At, B0); PG8_MMA(1, 1, At, B1); PG8_BAR; PG8_SCHED;
            PG8_LDB(B0, 1, 0); PG8_LDB(B1, 1, 1); PG8_SCHED; PG8_LDA(At, 1, 0); PG8_STAGE(PG8_SA(0, 1), a2 + hstep, voffA);
            PG8_WAIT_V(8); PG8_WAIT_L(0); PG8_BAR; PG8_MMA(0, 0, At, B0); PG8_MMA(0, 1, At, B1); PG8_BAR; PG8_SCHED;
            PG8_LDA(At, 1, 1); PG8_STAGE(PG8_SB(1, 0), b3, voffB); PG8_STAGE(PG8_SB(1, 1), b3 + hstep, voffB); PG8_STAGE(PG8_SA(1, 0), a3, voffA);
            PG8_WAIT_V(8); PG8_WAIT_L(0); PG8_BAR; PG8_MMA(1, 0, At, B0); PG8_MMA(1, 1, At, B1); PG8_BAR; PG8_SCHED;
            } else {
            PG8_LDB(B0, 0, 0); PG8_SCHED; PG8_LDA(At, 0, 0); PG8_STAGE(PG8_SA(1, 1), a1 + hstep, voffA);
            PG8_WAIT_L(8); PG8_BAR; PG8_WAIT_L(0); PG8_MMA(0, 0, At, B0); PG8_BAR; PG8_SCHED;
            PG8_LDB(B1, 0, 1); PG8_STAGE(PG8_SB(0, 0), b2, voffB);
            PG8_BAR; PG8_WAIT_L(0); PG8_MMA(0, 1, At, B1); PG8_BAR;
            PG8_LDA(At, 0, 1); PG8_STAGE(PG8_SA(0, 0), a2, voffA);
            PG8_BAR; PG8_WAIT_L(0); PG8_MMA(1, 0, At, B0); PG8_BAR; PG8_SCHED;
            PG8_STAGE(PG8_SB(0, 1), b2 + hstep, voffB);
            PG8_WAIT_V(6); PG8_BAR; PG8_MMA(1, 1, At, B1); PG8_BAR;
            PG8_LDB(B0, 1, 0); PG8_SCHED; PG8_LDA(At, 1, 0); PG8_STAGE(PG8_SA(0, 1), a2 + hstep, voffA);
            PG8_WAIT_L(8); PG8_BAR; PG8_WAIT_L(0); PG8_MMA(0, 0, At, B0); PG8_BAR; PG8_SCHED;
            PG8_LDB(B1, 1, 1); PG8_STAGE(PG8_SB(1, 0), b3, voffB);
            PG8_BAR; PG8_WAIT_L(0); PG8_MMA(0, 1, At, B1); PG8_BAR;
            PG8_LDA(At, 1, 1); PG8_STAGE(PG8_SA(1, 0), a3, voffA);
            PG8_BAR; PG8_WAIT_L(0); PG8_MMA(1, 0, At, B0); PG8_BAR; PG8_SCHED;
            PG8_STAGE(PG8_SB(1, 1), b3 + hstep, voffB);
            PG8_WAIT_V(6); PG8_BAR; PG8_MMA(1, 1, At, B1); PG8_BAR;
            }
        }
        if constexpr (ALIGN_EPI) { if (wr == 0) PG8_BAR; }
        if constexpr (!Epi::AFTER_DRAIN) { E(acc, cur, wr, wc, fr, fq); S.done(cur); }
        if (!has_next) break;
#pragma unroll
        for (int a = 0; a < 2; ++a)
#pragma unroll
            for (int b = 0; b < 2; ++b)
#pragma unroll
                for (int m = 0; m < 4; ++m)
#pragma unroll
                    for (int n = 0; n < 2; ++n) acc[a][b][m][n] = (f32x4){0.f, 0.f, 0.f, 0.f};
        cur = nxt; cA = nA; cB = nB; ++ui;
        if constexpr (ALIGN_EPI) { if (wr == 1) PG8_BAR; }
    }
    PG8_WAIT_V(0);
    if constexpr (!ALIGN_EPI) { if (wr == 0) PG8_BAR; }
    PG8_BAR;
    if constexpr (Epi::AFTER_DRAIN) { E.fused(acc, cur, wr, wc, fr, fq, lds, wid, lane); S.done(cur); }
#undef PG8_SA
#undef PG8_SB
#undef PG8_STAGE
#undef PG8_LDA
#undef PG8_LDB
#undef PG8_MMA
#undef PG8_WAIT_V
#undef PG8_WAIT_L
#undef PG8_BAR
#undef PG8_SCHED
}
}

#ifndef PG8_SP2
#define PG8_SP2 true
#endif
#ifndef PG8_ALIGN
#define PG8_ALIGN true
#endif
namespace pg8 {
__device__ __forceinline__ float silu_f(float x) { return x * __builtin_amdgcn_rcpf(1.0f + __expf(-x)); }
struct EpiSwiGLU {
    static constexpr bool PERM = true, AFTER_DRAIN = false;
    bf16_t* O; int ldc;
    __device__ __forceinline__ void operator()(const f32x4 (&acc)[2][2][4][2], const Unit& u, int wr, int wc, int fr, int fq) const {
        const int row0 = u.pm * BM + wr * 64 + fr, col0 = u.pn * HALF + wc * 32 + 8 * fq;
#pragma unroll
        for (int ai = 0; ai < 2; ++ai)
#pragma unroll
            for (int m = 0; m < 4; ++m) {
                bf16_t* rowp = O + (size_t)(row0 + ai * HALF + m * 16) * ldc + col0;
                const f32x4 g0 = acc[ai][0][m][0], g1 = acc[ai][0][m][1], u0 = acc[ai][1][m][0], u1 = acc[ai][1][m][1];
                u32x4 w;
                w.x = cvt_pk_bf16(silu_f(g0[0]) * u0[0], silu_f(g0[1]) * u0[1]); w.y = cvt_pk_bf16(silu_f(g0[2]) * u0[2], silu_f(g0[3]) * u0[3]);
                w.z = cvt_pk_bf16(silu_f(g1[0]) * u1[0], silu_f(g1[1]) * u1[1]); w.w = cvt_pk_bf16(silu_f(g1[2]) * u1[2], silu_f(g1[3]) * u1[3]);
                *(u32x4*)rowp = w;
            }
    }
};
struct EpiF32 {
    static constexpr bool PERM = false, AFTER_DRAIN = false;
    float* O; int ldc;
    __device__ __forceinline__ void operator()(const f32x4 (&acc)[2][2][4][2], const Unit& u, int wr, int wc, int fr, int fq) const {
        const int row0 = u.pm * BM + wr * 64 + fr, col0 = u.pn * BM + wc * 32 + 4 * fq;
#pragma unroll
        for (int ai = 0; ai < 2; ++ai)
#pragma unroll
            for (int m = 0; m < 4; ++m) {
                float* rowp = O + (size_t)(row0 + ai * HALF + m * 16) * ldc + col0;
#pragma unroll
                for (int bj = 0; bj < 2; ++bj)
#pragma unroll
                    for (int n = 0; n < 2; ++n) *(f32x4*)(rowp + bj * HALF + n * 16) = acc[ai][bj][m][n];
            }
    }
};
}
#define GAS __attribute__((address_space(1)))
#define LAS __attribute__((address_space(3)))
typedef unsigned short bf16;
typedef unsigned v4u __attribute__((ext_vector_type(4)));
typedef float f32x4 __attribute__((ext_vector_type(4)));
typedef short bf16x8 __attribute__((ext_vector_type(8)));
typedef GAS unsigned gu32;
typedef GAS unsigned long long gu64;
#define RLX_AGENT __ATOMIC_RELAXED, __HIP_MEMORY_SCOPE_AGENT
#define LDS_WAIT() asm volatile("s_waitcnt lgkmcnt(0)" ::: "memory")
#define VM_WAIT() asm volatile("s_waitcnt vmcnt(0)" ::: "memory")
__device__ __forceinline__ unsigned long long rt() { return __builtin_amdgcn_s_memrealtime(); }
__device__ __forceinline__ unsigned f2bf(float f) { unsigned u = __builtin_bit_cast(unsigned, f); return (u + 0x7fffu + ((u >> 16) & 1u)) >> 16; }
__device__ __forceinline__ unsigned pk2(float lo, float hi) { return f2bf(lo) | (f2bf(hi) << 16); }

#define XB_TMO      128
#define XB_XCNT(j)  (256  + 64 * (j))
#define XB_XSUB(j)  (1280 + 64 * (j))
#define XB_XGEN(j)  (2304 + 64 * (j))
#define XB_TOP      3328
#define XB_TOPGEN   3392
#define XCD_BAR_WORDS 3456
#define XB_SPIN_CAP (1u << 18)

__device__ __forceinline__ unsigned xb_ld(unsigned* p)              { return __hip_atomic_load(p, __ATOMIC_RELAXED, __HIP_MEMORY_SCOPE_AGENT); }
__device__ __forceinline__ unsigned xb_add(unsigned* p, unsigned v) { return __hip_atomic_fetch_add(p, v, __ATOMIC_RELAXED, __HIP_MEMORY_SCOPE_AGENT); }
__device__ __forceinline__ unsigned xb_xcc_id() { return (unsigned)__builtin_amdgcn_s_getreg((3 << 11) | 20) & 0xFu; }
#define XB_SPIN(cond, bar) do { unsigned _sp = 0; while (cond) { __builtin_amdgcn_s_sleep(1); \
    if ((++_sp & 255u) == 0u) { if (xb_ld(&(bar)[XB_TMO])) break; if (_sp > XB_SPIN_CAP) { atomicAdd(&(bar)[XB_TMO], 1u); break; } } } } while (0)

struct XcdBarrier {
    unsigned* bar; unsigned x;
    volatile LAS unsigned* st;
};

__device__ __forceinline__ XcdBarrier xcd_barrier_post(unsigned* bar, volatile LAS unsigned* st) {
    XcdBarrier b; b.bar = bar; b.x = xb_xcc_id(); b.st = st;
    if (threadIdx.x == 0) (void)xb_add(&bar[XB_XCNT(b.x)], 1u);
    return b;
}
__device__ __forceinline__ void xcd_barrier_complete(unsigned* bar, unsigned x, unsigned& nloc, unsigned& nx) {
    const unsigned G = gridDim.x * gridDim.y * gridDim.z;
    unsigned sum, cnt, mine, sp = 0u;
    for (;;) {
        sum = 0u; cnt = 0u; mine = 0u;
#pragma unroll
        for (unsigned j = 0; j < 16; ++j) { const unsigned c = xb_ld(&bar[XB_XCNT(j)]); sum += c; cnt += (c > 0u) ? 1u : 0u; mine = (j == x) ? c : mine; }
        if (sum == G) break;
        __builtin_amdgcn_s_sleep(1);
        if ((++sp & 255u) == 0u) { if (xb_ld(&bar[XB_TMO])) break; if (sp > XB_SPIN_CAP) { atomicAdd(&bar[XB_TMO], 1u); break; } }
    }
    nloc = mine > 0u ? mine : 1u; nx = cnt > 0u ? cnt : 1u;
}

__device__ __forceinline__ void xcd_barrier(const XcdBarrier& b) {
    asm volatile("s_waitcnt vmcnt(0)" ::: "memory");
    __syncthreads();
    if (threadIdx.x == 0) {
        unsigned* bar = b.bar;
        __builtin_amdgcn_s_waitcnt(0);
        unsigned nloc = b.st[0], nx = b.st[1];
        if (nloc == 0u) { xcd_barrier_complete(bar, b.x, nloc, nx); b.st[0] = nloc; b.st[1] = nx; }
        const unsigned old = xb_add(&bar[XB_XSUB(b.x)], 1u);
        const unsigned gen = old / nloc;
        if (old + 1u == (gen + 1u) * nloc) {
            __builtin_amdgcn_fence(__ATOMIC_RELEASE, "agent");
            asm volatile("s_waitcnt vmcnt(0)" ::: "memory");
            const unsigned og = xb_add(&bar[XB_TOP], 1u);
            const unsigned tg = og / nx;
            if (og + 1u == (tg + 1u) * nx) xb_add(&bar[XB_TOPGEN], 1u);
            else XB_SPIN(xb_ld(&bar[XB_TOPGEN]) == tg, bar);
            __builtin_amdgcn_fence(__ATOMIC_ACQUIRE, "agent");
            xb_add(&bar[XB_XGEN(b.x)], 1u);
            asm volatile("s_waitcnt vmcnt(0)" ::: "memory");
        } else {
            XB_SPIN(xb_ld(&bar[XB_XGEN(b.x)]) == gen, bar);
            __builtin_amdgcn_fence(__ATOMIC_ACQUIRE, "agent");
            asm volatile("s_waitcnt vmcnt(0)" ::: "memory");
        }
    }
    __syncthreads();
}

constexpr int NWAVES = 8;
constexpr int BATCH = 8, SEQ = 4096, D = 1024, M = BATCH * SEQ;
constexpr int NC_IN = 3592, C_BETA = 2048, C_QB = 2056;
constexpr int NIN = 3584;
constexpr int DFF = 2816, NGU = 2 * DFF;
constexpr float EPS = 1e-6f;
constexpr size_t MiB = 1u << 20;
constexpr size_t WS_CTL = 0, CTL_ZERO_BYTES = 1 * MiB;
constexpr size_t WS_WIN = 1 * MiB, WS_WO = 8 * MiB, WS_WGU = 10 * MiB, WS_WD = 21 * MiB, WS_BG = 27 * MiB;
constexpr size_t WS_XN = 32 * MiB;
constexpr size_t WS_PROJ = 96 * MiB;
constexpr size_t SEG = 32 * MiB;
constexpr size_t WS_QH = 320 * MiB, WS_KH = 352 * MiB, WS_VH = 384 * MiB, WS_ORAW = 416 * MiB;
constexpr size_t WS_Y = 320 * MiB;
constexpr size_t WS_XN2 = 448 * MiB;
constexpr size_t WS_HID = 96 * MiB;
constexpr size_t WS_END = 512 * MiB;
constexpr int CW_BAR = 4096;
constexpr int RING_OFF = 0, RING_BYTES = 131072;
constexpr int LDSCTL_OFF = RING_BYTES, MISC_OFF = LDSCTL_OFF + 320;
constexpr int LDS_BYTES = 147456;

__constant__ int c_bkt[3][129] = {
 {0, 1, 2, 3, 4, 5, 6, 7, 8, 9, 10, 11, 12, 13, 14, 15, 16, 16, 16, 16, 16, 16, 17, 17, 17, 17, 17, 17, 17, 17, 18, 18, 18, 18, 18, 18, 18, 18, 18, 18, 19, 19, 19, 19, 19, 19, 19, 19, 19, 19, 19, 19, 19, 19, 20, 20, 20, 20, 20, 20, 20, 20, 20, 20, 20, 20, 20, 20, 20, 20, 20, 20, 20, 21, 21, 21, 21, 21, 21, 21, 21, 21, 21, 21, 21, 21, 21, 21, 21, 21, 21, 21, 21, 21, 21, 21, 21, 21, 21, 22, 22, 22, 22, 22, 22, 22, 22, 22, 22, 22, 22, 22, 22, 22, 22, 22, 22, 22, 22, 22, 22, 22, 22, 22, 22, 22, 22, 22, 22},
 {0, 4, 8, 12, 16, 16, 17, 17, 18, 18, 19, 19, 19, 19, 20, 20, 20, 20, 20, 21, 21, 21, 21, 21, 21, 22, 22, 22, 22, 22, 22, 22, 22, 22, 23, 23, 23, 23, 23, 23, 23, 23, 23, 23, 23, 23, 24, 24, 24, 24, 24, 24, 24, 24, 24, 24, 24, 24, 24, 24, 24, 24, 25, 25, 25, 25, 25, 25, 25, 25, 25, 25, 25, 25, 25, 25, 25, 25, 25, 25, 25, 25, 25, 26, 26, 26, 26, 26, 26, 26, 26, 26, 26, 26, 26, 26, 26, 26, 26, 26, 26, 26, 26, 26, 26, 26, 26, 26, 26, 26, 26, 26, 26, 27, 27, 27, 27, 27, 27, 27, 27, 27, 27, 27, 27, 27, 27, 27, 27},
 {0, 16, 18, 19, 20, 21, 21, 22, 22, 23, 23, 23, 24, 24, 24, 24, 25, 25, 25, 25, 25, 26, 26, 26, 26, 26, 26, 26, 26, 27, 27, 27, 27, 27, 27, 27, 27, 27, 27, 28, 28, 28, 28, 28, 28, 28, 28, 28, 28, 28, 28, 28, 29, 29, 29, 29, 29, 29, 29, 29, 29, 29, 29, 29, 29, 29, 29, 29, 29, 29, 30, 30, 30, 30, 30, 30, 30, 30, 30, 30, 30, 30, 30, 30, 30, 30, 30, 30, 30, 30, 30, 30, 30, 30, 30, 31, 31, 31, 31, 31, 31, 31, 31, 31, 31, 31, 31, 31, 31, 31, 31, 31, 31, 31, 31, 31, 31, 31, 31, 31, 31, 31, 31, 31, 31, 31, 31, 31, 31}};

struct Frame {
    LAS unsigned char* lds;
    volatile LAS unsigned* MISC;
    gu32* ctl;
    int tid, lane, wave, vcu, G;
    unsigned char* ws;
};
struct Args { const float* in[15]; float* out; unsigned char* ws; int ph_lo, ph_hi; };
#define A_x          (A.in[0])
#define A_w_in       (A.in[1])
#define A_conv_w     (A.in[2])
#define A_a_log      (A.in[3])
#define A_dt_bias    (A.in[4])
#define A_onorm_g    (A.in[5])
#define A_rel_bias   (A.in[6])
#define A_w_out      (A.in[7])
#define A_g_mix_pre  (A.in[8])
#define A_g_mix_post (A.in[9])
#define A_w_gate     (A.in[10])
#define A_w_up       (A.in[11])
#define A_w_down     (A.in[12])
#define A_g_ffn_pre  (A.in[13])
#define A_g_ffn_post (A.in[14])
#define W_WIN  ((bf16*)(F.ws + WS_WIN))
#define W_WO   ((bf16*)(F.ws + WS_WO))
#define W_WGU  ((bf16*)(F.ws + WS_WGU))
#define W_WD   ((bf16*)(F.ws + WS_WD))
#define W_BG   ((float*)(F.ws + WS_BG))
#define W_XN   ((bf16*)(F.ws + WS_XN))
#define W_PROJ ((bf16*)(F.ws + WS_PROJ))
#define W_QH   ((bf16*)(F.ws + WS_QH))
#define W_KH   ((bf16*)(F.ws + WS_KH))
#define W_VH   ((bf16*)(F.ws + WS_VH))
#define W_MIXO ((bf16*)(F.ws + WS_XN))
#define W_XN2  ((bf16*)(F.ws + WS_XN2))
#define W_HID  ((bf16*)(F.ws + WS_HID))
#define W_ORAW ((float*)(F.ws + WS_ORAW))
#define W_Y    ((float*)(F.ws + WS_Y))
__device__ __forceinline__ float wave_sum(float v) {
#pragma unroll
    for (int o = 1; o < 64; o <<= 1) v += __shfl_xor(v, o);
    return v;
}
__device__ __forceinline__ float bf2f(bf16 b) { return __builtin_bit_cast(float, (unsigned)b << 16); }
__device__ __forceinline__ float siluf(float x) { return x / (1.f + __expf(-x)); }

__device__ __forceinline__ void p0_transpose_item(const float* W, int ldw, int col0, int K, bf16* WT, int dst_row0, int k0, LAS float* scr, int lane) {
#pragma unroll 8
    for (int i = 0; i < 32; ++i) { const int kk = 2 * i + (lane >> 5); scr[kk * 33 + (lane & 31)] = W[(size_t)(k0 + kk) * ldw + col0 + (lane & 31)]; }
    LDS_WAIT(); asm volatile("" ::: "memory");
    const int c = lane & 7;
#pragma unroll
    for (int j = 0; j < 4; ++j) { const int n = (lane >> 3) + 8 * j; const LAS float* s = scr + (8 * c) * 33 + n;
        v4u o; o.x = pk2(s[0 * 33], s[1 * 33]); o.y = pk2(s[2 * 33], s[3 * 33]); o.z = pk2(s[4 * 33], s[5 * 33]); o.w = pk2(s[6 * 33], s[7 * 33]);
        *(GAS v4u*)(WT + (size_t)(dst_row0 + n) * K + k0 + 8 * c) = o; }
    LDS_WAIT(); asm volatile("" ::: "memory");
}

__device__ __forceinline__ void ph_prologue(Frame& F, const Args& A) {
    LAS float* scr = (LAS float*)(F.lds + RING_OFF + F.wave * 16384);
    const int gw = F.vcu * NWAVES + F.wave, NGW = F.G * NWAVES;
    constexpr int I_A = 16 * 64, I_B = 16 * 48, I_O = 16 * 32, I_G = 16 * 88, I_D = 44 * 32;
    constexpr int NITEMS = I_A + I_B + I_O + 2 * I_G + I_D;
    for (int it = gw; it < NITEMS; it += NGW) {
        int r = it;
        if (r < I_A) { const int kb = r / 64, nb = r % 64; p0_transpose_item(A_w_in, NC_IN, 32 * nb, D, W_WIN, 32 * nb, 64 * kb, scr, F.lane); continue; } r -= I_A;
        if (r < I_B) { const int kb = r / 48, nb = r % 48; p0_transpose_item(A_w_in, NC_IN, C_QB + 32 * nb, D, W_WIN, 2048 + 32 * nb, 64 * kb, scr, F.lane); continue; } r -= I_B;
        if (r < I_O) { const int kb = r / 32, nb = r % 32; p0_transpose_item(A_w_out, D, 32 * nb, D, W_WO, 32 * nb, 64 * kb, scr, F.lane); continue; } r -= I_O;
        if (r < I_G) { const int kb = r / 88, nb = r % 88, n0 = 32 * nb; p0_transpose_item(A_w_gate, DFF, n0, D, W_WGU, 256 * (n0 >> 7) + (n0 & 127), 64 * kb, scr, F.lane); continue; } r -= I_G;
        if (r < I_G) { const int kb = r / 88, nb = r % 88, n0 = 32 * nb; p0_transpose_item(A_w_up, DFF, n0, D, W_WGU, 256 * (n0 >> 7) + 128 + (n0 & 127), 64 * kb, scr, F.lane); continue; } r -= I_G;
        { const int kb = r / 32, nb = r % 32; p0_transpose_item(A_w_down, D, 32 * nb, DFF, W_WD, 32 * nb, 64 * kb, scr, F.lane); }
    }
    __syncthreads();
    LAS float* wba = (LAS float*)(F.lds + RING_OFF);
    for (int e = F.tid; e < 8 * D; e += NWAVES * 64) { const int k = e >> 3, c = e & 7; wba[c * D + k] = A_w_in[(size_t)k * NC_IN + C_BETA + c]; }
    __syncthreads();
    for (int m = gw; m < M; m += NGW) {
        const GAS f32x4* xr = (const GAS f32x4*)(A_x + (size_t)m * D) + F.lane;
        const GAS f32x4* gr = (const GAS f32x4*)A_g_mix_pre + F.lane;
        f32x4 v[4]; float s = 0.f;
#pragma unroll
        for (int j = 0; j < 4; ++j) { v[j] = xr[64 * j]; s += (v[j].x * v[j].x + v[j].y * v[j].y) + (v[j].z * v[j].z + v[j].w * v[j].w); }
        const float rstd = rsqrtf(wave_sum(s) * (1.f / D) + EPS);
        GAS unsigned long long* o8 = (GAS unsigned long long*)(W_XN + (size_t)m * D) + F.lane;
        float acc[8];
#pragma unroll
        for (int c = 0; c < 8; ++c) acc[c] = 0.f;
#pragma unroll
        for (int j = 0; j < 4; ++j) {
            const f32x4 g = gr[64 * j]; v[j] = v[j] * rstd * g;
            o8[64 * j] = (unsigned long long)pk2(v[j].x, v[j].y) | ((unsigned long long)pk2(v[j].z, v[j].w) << 32);
#pragma unroll
            for (int c = 0; c < 8; ++c) { const f32x4 w = *((const LAS f32x4*)(wba + c * D) + F.lane + 64 * j); acc[c] += (v[j].x * w.x + v[j].y * w.y) + (v[j].z * w.z + v[j].w * w.w); }
        }
#pragma unroll
        for (int c = 0; c < 8; ++c) acc[c] = wave_sum(acc[c]);
        if (F.lane < 4) {
            const int h = F.lane;
            const float bl = h == 0 ? acc[0] : h == 1 ? acc[1] : h == 2 ? acc[2] : acc[3];
            const float al = h == 0 ? acc[4] : h == 1 ? acc[5] : h == 2 ? acc[6] : acc[7];
            const float beta = 1.f / (1.f + expf(-bl));
            const float xx = al + A_dt_bias[h];
            const float sp = fmaxf(xx, 0.f) + log1pf(expf(-fabsf(xx)));
            W_BG[(size_t)m * 8 + h] = beta;
            W_BG[(size_t)m * 8 + 4 + h] = -expf(A_a_log[h]) * sp;
        }
    }
}

__device__ __forceinline__ void ph_gdn_prep(Frame& F, const Args& A) {
    const int gw = F.vcu * NWAVES + F.wave, NGW = F.G * NWAVES;
    for (int it = gw; it < M * 4; it += NGW) {
        const int m = it >> 2, h = it & 3, t = m & (SEQ - 1);
        float val[3][2];
#pragma unroll
        for (int s = 0; s < 3; ++s)
#pragma unroll
            for (int j = 0; j < 2; ++j) {
                const int c = h * 128 + F.lane + 64 * j, ch = s * 512 + c;
                const bf16* seg = W_PROJ + (size_t)s * M * 512;
                float a = 0.f;
#pragma unroll
                for (int i = 0; i < 4; ++i) { const int tt = t - 3 + i; if (tt >= 0) a += A_conv_w[i * 1536 + ch] * bf2f(seg[(size_t)(m - 3 + i) * 512 + c]); }
                val[s][j] = siluf(a);
            }
        const float sq = wave_sum(val[0][0] * val[0][0] + val[0][1] * val[0][1]);
        const float sk = wave_sum(val[1][0] * val[1][0] + val[1][1] * val[1][1]);
        const float rq = rsqrtf(sq + 1e-6f) * 0.08838834764831845f, rk = rsqrtf(sk + 1e-6f);
#pragma unroll
        for (int j = 0; j < 2; ++j) {
            const size_t o = (size_t)m * 512 + h * 128 + F.lane + 64 * j;
            W_QH[o] = (bf16)f2bf(val[0][j] * rq); W_KH[o] = (bf16)f2bf(val[1][j] * rk); W_VH[o] = (bf16)f2bf(val[2][j]);
        }
    }
}
__device__ __forceinline__ void ph_gdn_seq(Frame& F, const Args& A, int bh) {
    const int b = bh >> 2, h = bh & 3, dv = F.tid & 127;
    LAS float* kq = (LAS float*)(F.lds + RING_OFF);
    float Sx[128];
#pragma unroll
    for (int i = 0; i < 128; ++i) Sx[i] = 0.f;
    const bool act = F.tid < 128;
    for (int t = 0; t < SEQ; ++t) {
        const size_t m = (size_t)b * SEQ + t;
        const int p = t & 1;
        float v = 0.f, beta = 0.f, eg = 0.f;
        if (act) {
            kq[(p * 2 + 0) * 128 + dv] = bf2f(W_KH[m * 512 + h * 128 + dv]);
            kq[(p * 2 + 1) * 128 + dv] = bf2f(W_QH[m * 512 + h * 128 + dv]);
            v = bf2f(W_VH[m * 512 + h * 128 + dv]);
            beta = W_BG[m * 8 + h]; eg = expf(W_BG[m * 8 + 4 + h]);
        }
        __syncthreads();
        if (act) {
            float ks = 0.f;
            const LAS f32x4* kp = (const LAS f32x4*)(kq + (p * 2 + 0) * 128);
            const LAS f32x4* qp = (const LAS f32x4*)(kq + (p * 2 + 1) * 128);
#pragma unroll
            for (int i0 = 0; i0 < 32; i0 += 4) {
#pragma unroll
                for (int i = i0; i < i0 + 4; ++i) { const f32x4 kk = kp[i]; ks += (kk.x * Sx[4 * i] + kk.y * Sx[4 * i + 1]) + (kk.z * Sx[4 * i + 2] + kk.w * Sx[4 * i + 3]); }
                asm volatile("" ::: "memory");
            }
            const float dlt = beta * (v - eg * ks);
            float o = 0.f;
#pragma unroll
            for (int i0 = 0; i0 < 32; i0 += 4) {
#pragma unroll
                for (int i = i0; i < i0 + 4; ++i) { const f32x4 kk = kp[i], qq = qp[i];
                    Sx[4 * i] = eg * Sx[4 * i] + kk.x * dlt; Sx[4 * i + 1] = eg * Sx[4 * i + 1] + kk.y * dlt; Sx[4 * i + 2] = eg * Sx[4 * i + 2] + kk.z * dlt; Sx[4 * i + 3] = eg * Sx[4 * i + 3] + kk.w * dlt;
                    o += (qq.x * Sx[4 * i] + qq.y * Sx[4 * i + 1]) + (qq.z * Sx[4 * i + 2] + qq.w * Sx[4 * i + 3]); }
                asm volatile("" ::: "memory");
            }
            W_ORAW[m * 512 + h * 128 + dv] = o;
        }
    }
}
__device__ __forceinline__ void ph_gdn_out(Frame& F, const Args& A) {
    const int gw = F.vcu * NWAVES + F.wave, NGW = F.G * NWAVES;
    const bf16* GA = W_PROJ + (size_t)3 * M * 512;
    for (int it = gw; it < M * 4; it += NGW) {
        const int m = it >> 2, h = it & 3;
        const size_t o0 = (size_t)m * 512 + h * 128 + F.lane;
        const float a = W_ORAW[o0], b = W_ORAW[o0 + 64];
        const float s = wave_sum(a * a + b * b);
        const float r = rsqrtf(s * (1.f / 128.f) + EPS);
        W_MIXO[(size_t)m * D + h * 128 + F.lane] = (bf16)f2bf(a * r * A_onorm_g[F.lane] * siluf(bf2f(GA[o0])));
        W_MIXO[(size_t)m * D + h * 128 + F.lane + 64] = (bf16)f2bf(b * r * A_onorm_g[F.lane + 64] * siluf(bf2f(GA[o0 + 64])));
    }
}
__device__ __forceinline__ void ph_swa_naive(Frame& F, const Args& A, int gw, int NGW) {
    LAS float* sc = (LAS float*)(F.lds + RING_OFF + 4096 + F.wave * 2048);
    LAS float* qs = sc + 3 * 132;
    const bf16* QB = W_PROJ + (size_t)4 * M * 512; const bf16* KB = W_PROJ + (size_t)5 * M * 512; const bf16* VB = W_PROJ + (size_t)6 * M * 512;
    for (int it = gw; it < M * 8; it += NGW) {
        const int m = it >> 3, h = it & 7, t = m & (SEQ - 1), lane = F.lane;
        asm volatile("s_waitcnt lgkmcnt(0)" ::: "memory");
        qs[lane] = bf2f(QB[(size_t)m * 512 + h * 64 + lane]);
        asm volatile("s_waitcnt lgkmcnt(0)" ::: "memory");
        float mx = -INFINITY;
        for (int p = 0; p < 3; ++p) {
            const int dil = p == 0 ? 1 : (p == 1 ? 4 : 16);
            for (int j = lane; j < 129; j += 64) {
                const int tk = t - j * dil;
                float s = -INFINITY;
                if (tk >= 0) {
                    const bf16* kr = KB + (size_t)(m - j * dil) * 512 + h * 64;
                    float a = 0.f;
                    for (int d = 0; d < 64; ++d) a += qs[d] * bf2f(kr[d]);
                    s = a * 0.125f + A_rel_bias[c_bkt[p][j] * 8 + h];
                }
                sc[p * 132 + j] = s; mx = fmaxf(mx, s);
            }
        }
#pragma unroll
        for (int o = 1; o < 64; o <<= 1) mx = fmaxf(mx, __shfl_xor(mx, o));
        asm volatile("s_waitcnt lgkmcnt(0)" ::: "memory");
        float sum = 0.f;
        for (int p = 0; p < 3; ++p)
            for (int j = lane; j < 129; j += 64) { const float sv = sc[p * 132 + j]; const float e = (sv == -INFINITY) ? 0.f : __expf(sv - mx); sc[p * 132 + j] = e; sum += e; }
        sum = wave_sum(sum);
        asm volatile("s_waitcnt lgkmcnt(0)" ::: "memory");
        float acc = 0.f;
        for (int p = 0; p < 3; ++p) {
            const int dil = p == 0 ? 1 : (p == 1 ? 4 : 16);
            for (int j = 0; j < 129; ++j) {
                const int tk = t - j * dil; if (tk < 0) break;
                acc += sc[p * 132 + j] * bf2f(VB[(size_t)(m - j * dil) * 512 + h * 64 + lane]);
            }
        }
        W_MIXO[(size_t)m * D + 512 + h * 64 + lane] = (bf16)f2bf(acc / sum);
    }
}
__device__ __forceinline__ void ph_norm_res(Frame& F, const float* y, const float* g1, const float* base, float* out, const float* g2, bf16* hn) {
    const int gw = F.vcu * NWAVES + F.wave, NGW = F.G * NWAVES;
    for (int m = gw; m < M; m += NGW) {
        const GAS f32x4* yr = (const GAS f32x4*)(y + (size_t)m * D) + F.lane;
        const GAS f32x4* br = (const GAS f32x4*)(base + (size_t)m * D) + F.lane;
        GAS f32x4* orow = (GAS f32x4*)(out + (size_t)m * D) + F.lane;
        f32x4 v[4]; float s = 0.f;
#pragma unroll
        for (int j = 0; j < 4; ++j) { v[j] = yr[64 * j]; s += (v[j].x * v[j].x + v[j].y * v[j].y) + (v[j].z * v[j].z + v[j].w * v[j].w); }
        const float r = rsqrtf(wave_sum(s) * (1.f / D) + EPS);
        float s2 = 0.f;
#pragma unroll
        for (int j = 0; j < 4; ++j) { const f32x4 g = ((const GAS f32x4*)g1)[F.lane + 64 * j]; v[j] = br[64 * j] + v[j] * r * g; orow[64 * j] = v[j];
            s2 += (v[j].x * v[j].x + v[j].y * v[j].y) + (v[j].z * v[j].z + v[j].w * v[j].w); }
        if (hn) {
            const float r2 = rsqrtf(wave_sum(s2) * (1.f / D) + EPS);
            GAS unsigned long long* o8 = (GAS unsigned long long*)(hn + (size_t)m * D) + F.lane;
#pragma unroll
            for (int j = 0; j < 4; ++j) { const f32x4 g = ((const GAS f32x4*)g2)[F.lane + 64 * j]; const f32x4 w = v[j] * r2 * g;
                o8[64 * j] = (unsigned long long)pk2(w.x, w.y) | ((unsigned long long)pk2(w.z, w.w) << 32); }
        }
    }
}

constexpr int N_PHASES = 10;
#ifndef MK_PER_PHASE
#define MK_PER_PHASE 0
#endif
__global__ void __launch_bounds__(NWAVES * 64, 2) mk_fwd(Args args) {
    extern __shared__ __attribute__((aligned(16))) unsigned char lds[];
    Frame F;
    F.lds = (LAS unsigned char*)lds;
    F.MISC = (volatile LAS unsigned*)(F.lds + MISC_OFF);
    F.tid = threadIdx.x; F.lane = F.tid & 63; F.wave = __builtin_amdgcn_readfirstlane(F.tid >> 6);
    F.G = gridDim.x; { const int bx = blockIdx.x; F.vcu = (F.G % 8 == 0) ? (bx % 8) * (F.G / 8) + bx / 8 : bx; }
    unsigned char* ws = args.ws;
    F.ctl = (gu32*)(ws + WS_CTL);
    F.ws = ws; const Args& A = args;
    for (int u = F.tid; u < (LDS_BYTES - LDSCTL_OFF) / 4; u += NWAVES * 64) ((LAS unsigned*)(F.lds + LDSCTL_OFF))[u] = 0u;
    __syncthreads();
    XcdBarrier bar; bar.bar = (unsigned*)(F.ctl + CW_BAR); bar.x = 0; bar.st = nullptr;
    if (!MK_PER_PHASE) bar = xcd_barrier_post((unsigned*)(F.ctl + CW_BAR), F.MISC + 8);
    const int lo = args.ph_lo, hi = args.ph_hi;
#ifndef PHMASK
#define PHMASK 0xFFFF
#endif
#define IN(k) (((PHMASK >> (k)) & 1) && lo <= (k) && (k) < hi)
#define SEAM(k) do { if (IN(k) && IN((k) + 1)) xcd_barrier(bar); } while (0)

    if (IN(0)) { ph_prologue(F, args); } SEAM(0);
    if (IN(1)) {
        pg8::Gemm g{W_XN, W_WIN, M, NIN, D}; pg8::StaticOrder S; S.init(M, NIN, F.G, (int)blockIdx.x);
        pg8::EpiBf16<0> E{W_PROJ, 512, nullptr, 512, (size_t)M * 512, 1.f};
        pg8::gemm_phase<pg8::EpiBf16<0>, pg8::StaticOrder, true, true>(F.lds + RING_OFF, g, S, E);
    } SEAM(1);
    if (IN(2)) { ph_gdn_prep(F, args); } SEAM(2);
    if (IN(3)) {
        if (blockIdx.x < 32) ph_gdn_seq(F, args, (int)blockIdx.x);
        else ph_swa_naive(F, args, ((int)blockIdx.x - 32) * NWAVES + F.wave, (F.G - 32) * NWAVES);
    } SEAM(3);
    if (IN(4)) { ph_gdn_out(F, args); } SEAM(4);
    if (IN(5)) {
        pg8::Gemm g{W_MIXO, W_WO, M, D, D}; pg8::StaticOrder S; S.init(M, D, F.G, (int)blockIdx.x);
        pg8::EpiF32 E{W_Y, D};
        pg8::gemm_phase<pg8::EpiF32, pg8::StaticOrder, true, true>(F.lds + RING_OFF, g, S, E);
    } SEAM(5);
    if (IN(6)) { ph_norm_res(F, W_Y, A_g_mix_post, A_x, A.out, A_g_ffn_pre, W_XN2); } SEAM(6);
    if (IN(7)) {
        pg8::Gemm g{W_XN2, W_WGU, M, NGU, D}; pg8::StaticOrder S; S.init(M, NGU, F.G, (int)blockIdx.x);
        pg8::EpiSwiGLU E{W_HID, DFF};
        pg8::gemm_phase<pg8::EpiSwiGLU, pg8::StaticOrder, true, true>(F.lds + RING_OFF, g, S, E);
    } SEAM(7);
    if (IN(8)) {
        pg8::Gemm g{W_HID, W_WD, M, D, DFF}; pg8::StaticOrder S; S.init(M, D, F.G, (int)blockIdx.x);
        pg8::EpiF32 E{W_Y, D};
        pg8::gemm_phase<pg8::EpiF32, pg8::StaticOrder, true, true>(F.lds + RING_OFF, g, S, E);
    } SEAM(8);
    if (IN(9)) { ph_norm_res(F, W_Y, A_g_ffn_post, A.out, A.out, nullptr, nullptr); }
#undef IN
#undef SEAM
}

extern "C" void kernel_launch(void* const* d_in, const int* in_sizes, int n_in, void* d_out, int out_size, void* d_ws, size_t ws_size, hipStream_t stream) {
    static int grid = 0;
    if (grid == 0) {
        if (n_in != 15 || in_sizes[0] != M * D || out_size != M * D || ws_size < WS_END) {
            fprintf(stderr, "kernel_launch: unexpected shapes/workspace: n_in %d in0 %d out %d ws %zu (need %zu); nothing launched\n", n_in, n_in > 0 ? in_sizes[0] : -1, out_size, ws_size, (size_t)WS_END); grid = -1; return; }
        int dev = 0, cus = 0, per_cu = 0;
        if (hipGetDevice(&dev) != hipSuccess || hipDeviceGetAttribute(&cus, hipDeviceAttributeMultiprocessorCount, dev) != hipSuccess) { fprintf(stderr, "kernel_launch: device query failed\n"); grid = -1; return; }
        if (hipFuncSetAttribute((const void*)mk_fwd, hipFuncAttributeMaxDynamicSharedMemorySize, LDS_BYTES) != hipSuccess) { fprintf(stderr, "kernel_launch: hipFuncSetAttribute failed\n"); grid = -1; return; }
        if (hipOccupancyMaxActiveBlocksPerMultiprocessor(&per_cu, (const void*)mk_fwd, NWAVES * 64, LDS_BYTES) != hipSuccess || per_cu < 1) {
            fprintf(stderr, "kernel_launch: occupancy query reports %d workgroups per CU; nothing launched\n", per_cu); (void)hipGetLastError(); grid = -1; return; }
        (void)hipGetLastError();
        grid = cus;
    }
    if (grid < 0) return;
    if (hipMemsetAsync((char*)d_ws + WS_CTL, 0, CTL_ZERO_BYTES, stream) != hipSuccess) { fprintf(stderr, "kernel_launch: memset failed\n"); return; }
    Args a{};
    for (int i = 0; i < 15; ++i) a.in[i] = (const float*)d_in[i];
    a.out = (float*)d_out; a.ws = (unsigned char*)d_ws;
#if MK_PER_PHASE
    for (int p = 0; p < N_PHASES; ++p) { a.ph_lo = p; a.ph_hi = p + 1; hipLaunchKernelGGL(mk_fwd, dim3(grid), dim3(NWAVES * 64), LDS_BYTES, stream, a); }
#else
    a.ph_lo = 0; a.ph_hi = N_PHASES;
    hipLaunchKernelGGL(mk_fwd, dim3(grid), dim3(NWAVES * 64), LDS_BYTES, stream, a);
#endif
    const hipError_t le = hipPeekAtLastError();
    if (le != hipSuccess) fprintf(stderr, "kernel_launch: launch failed: %s\n", hipGetErrorName(le));
}
```

```cpp
#include <hip/hip_runtime.h>
#include <cstdio>
#include <cstdint>
#include <cmath>
namespace pg8 {
#define PG8_LAS __attribute__((address_space(3)))
typedef unsigned short bf16_t;
typedef short bf16x8 __attribute__((ext_vector_type(8)));
typedef float f32x4 __attribute__((ext_vector_type(4)));
typedef unsigned u32x4 __attribute__((ext_vector_type(4)));
constexpr int BM = 256, BK = 64, HALF = 128, HTB = HALF * BK * 2  , STAGE_BYTES = 8 * HTB, NXCD = 8, WGM = 8;

__host__ __device__ __forceinline__ int lds_byte(int r, int c) { const int st = (r >> 4) * 2 + (c >> 5), rr = r & 15, cc = c & 31, ob = rr * 64 + cc * 2; return st * 1024 + (ob ^ (((ob >> 9) & 1) << 5)); }
__host__ __device__ __forceinline__ void stage_rc(int b, int& R, int& C) { const int st = b / 1024, sb = b % 1024, swz = sb ^ (((sb >> 9) & 1) << 5); R = (st >> 1) * 16 + swz / 64; C = (st & 1) * 32 + (swz % 64) / 2; }
__host__ __device__ __forceinline__ int perm32(int rho) { const int n = rho >> 4, i = rho & 15; return 8 * (i >> 2) + 4 * n + (i & 3); }

struct Unit { int pm, pn; };
struct Gemm { const bf16_t* A; const bf16_t* Bt; int M, N, K; };

struct StaticOrder {
    int nM, nN, nwg, G, c;
    __host__ __device__ void init(int M, int N, int G_, int c_) { nM = M / BM; nN = N / BM; nwg = nM * nN; G = G_; c = c_; }
    __host__ __device__ bool next(int i, Unit& u) const {
        const long L = (long)i * G + c; if (L >= nwg) return false;
        int wgid = (int)L; { const int q = nwg / NXCD, r = nwg % NXCD, xcd = wgid % NXCD, off = wgid / NXCD; wgid = (xcd < r ? xcd * (q + 1) : r * (q + 1) + (xcd - r) * q) + off; }
        const int nig = WGM * nN, gid = wgid / nig, fm = gid * WGM, gsz = (nM - fm) < WGM ? (nM - fm) : WGM;
        u.pm = fm + ((wgid % nig) % gsz); u.pn = (wgid % nig) / gsz; return true;
    }
    __device__ __forceinline__ void a_ready(const Unit&) const {}
    __device__ __forceinline__ void done(const Unit&) const {}
};

__device__ __forceinline__ unsigned cvt_pk_bf16(float lo, float hi) { unsigned r; asm volatile("v_cvt_pk_bf16_f32 %0, %1, %2" : "=v"(r) : "v"(lo), "v"(hi)); return r; }
typedef float f32x2 __attribute__((ext_vector_type(2)));
__device__ __forceinline__ f32x2 gelu_pk(f32x2 v) {
    const f32x2 av = __builtin_elementwise_abs(v), d = av * 0.2316418882f + 1.0f;
    f32x2 t; t.x = __builtin_amdgcn_rcpf(d.x); t.y = __builtin_amdgcn_rcpf(d.y);
    f32x2 q = t * 0.5307027145f + (-0.7265760135f); q = q * t + 0.7107068705f; q = q * t + (-0.142248368f); q = q * t + 0.127414796f; q = q * t;
    const f32x2 s = (v * v) * (-0.72134752044f);
    f32x2 e; e.x = __builtin_amdgcn_exp2f(s.x); e.y = __builtin_amdgcn_exp2f(s.y);
    const f32x2 m = v * (q * e), r = v - m;
    f32x2 o; o.x = v.x < 0.f ? m.x : r.x; o.y = v.y < 0.f ? m.y : r.y; return o;
}

template <int ACT  > struct EpiBf16 {
    static constexpr bool PERM = true, AFTER_DRAIN = false; static_assert(ACT == 0 || ACT == 1, "EpiBf16: ACT is 0 (none) or 1 (gelu_pk)");
    bf16_t* O; int ldc; const float* bias; int split_cols; size_t split_stride; float scale0;
    __device__ __forceinline__ void operator()(const f32x4 (&acc)[2][2][4][2], const Unit& u, int wr, int wc, int fr, int fq) const {
        const int row0 = u.pm * BM + wr * 64 + fr; int colt = u.pn * BM; bf16_t* base = O;
        float sc = 1.f; if (split_cols) { const int t = colt / split_cols; base += (size_t)t * split_stride; colt -= t * split_cols; if (t == 0) sc = scale0; }
        const int col0 = colt + wc * 32 + 8 * fq, bcol0 = u.pn * BM + wc * 32 + 8 * fq;
        f32x4 bv[2][2];
#pragma unroll
        for (int bj = 0; bj < 2; ++bj)
#pragma unroll
            for (int n = 0; n < 2; ++n) bv[bj][n] = bias ? *(const f32x4*)(bias + bcol0 + bj * HALF + 4 * n) : (f32x4){0.f, 0.f, 0.f, 0.f};
#pragma unroll
        for (int ai = 0; ai < 2; ++ai)
#pragma unroll
            for (int m = 0; m < 4; ++m) { bf16_t* rowp = base + (size_t)(row0 + ai * HALF + m * 16) * ldc + col0;
#pragma unroll
                for (int bj = 0; bj < 2; ++bj) { f32x4 v0 = acc[ai][bj][m][0] + bv[bj][0], v1 = acc[ai][bj][m][1] + bv[bj][1];
                    if (ACT == 1) { f32x2 a = gelu_pk((f32x2){v0[0], v0[1]}), b = gelu_pk((f32x2){v0[2], v0[3]}), c = gelu_pk((f32x2){v1[0], v1[1]}), d = gelu_pk((f32x2){v1[2], v1[3]});
                        v0 = (f32x4){a.x, a.y, b.x, b.y}; v1 = (f32x4){c.x, c.y, d.x, d.y}; }
                    v0 = v0 * sc; v1 = v1 * sc; u32x4 w; w.x = cvt_pk_bf16(v0[0], v0[1]); w.y = cvt_pk_bf16(v0[2], v0[3]); w.z = cvt_pk_bf16(v1[0], v1[1]); w.w = cvt_pk_bf16(v1[2], v1[3]);
                    *(u32x4*)(rowp + bj * HALF) = w; } }
    }
};

struct PanelStats {
    unsigned* xbuf;
    unsigned* cnt;
    unsigned* tmo;
    int ntn; float eps;
    unsigned code;
    __device__ __forceinline__ bool run(const f32x4 (&v)[2][2][4][2], const Unit& u, int wr, int wc, int fr, int fq, PG8_LAS unsigned char* lds, int wid, int lane) const {
        typedef float f32x2v __attribute__((ext_vector_type(2)));
        PG8_LAS f32x2v* P = (PG8_LAS f32x2v*)lds;
        PG8_LAS f32x2v* S = (PG8_LAS f32x2v*)(lds + 8192);
        PG8_LAS unsigned* flag = (PG8_LAS unsigned*)(lds + 8192 + 2048);
#pragma unroll
        for (int ai = 0; ai < 2; ++ai)
#pragma unroll
            for (int m = 0; m < 4; ++m) {
                float s = 0.f;
#pragma unroll
                for (int bj = 0; bj < 2; ++bj)
#pragma unroll
                    for (int n = 0; n < 2; ++n) { const f32x4 x = v[ai][bj][m][n]; s += (x[0] + x[1]) + (x[2] + x[3]); }
                s += __shfl_xor(s, 16); s += __shfl_xor(s, 32);
                const float mw = s * (1.0f / 64.0f); float q = 0.f;
#pragma unroll
                for (int bj = 0; bj < 2; ++bj)
#pragma unroll
                    for (int n = 0; n < 2; ++n) { const f32x4 d = v[ai][bj][m][n] - mw; q += (d[0] * d[0] + d[1] * d[1]) + (d[2] * d[2] + d[3] * d[3]); }
                q += __shfl_xor(q, 16); q += __shfl_xor(q, 32);
                if (fq == 0) P[(ai * HALF + wr * 64 + m * 16 + fr) * 4 + wc] = (f32x2v){mw, q};
            }
        asm volatile("s_waitcnt lgkmcnt(0)" ::: "memory"); __builtin_amdgcn_s_barrier(); asm volatile("" ::: "memory");
#if defined(BROKEN_EXCHANGE_NO_WAIT)
#warning BROKEN CONTROL BUILD: the row-statistics exchange does not wait; results are wrong by design
        if (blockIdx.x >= 64) { const long long t0_ = clock64(); while (clock64() - t0_ < 60000) __builtin_amdgcn_s_sleep(8); }
#endif
        const int row = wid * 32 + (lane & 31);
        if (lane < 32) {
            const f32x2v a = P[row * 4 + 0], b = P[row * 4 + 1], c = P[row * 4 + 2], d = P[row * 4 + 3];
            const float mt = (a.x + b.x + c.x + d.x) * 0.25f;
            const float da = a.x - mt, db = b.x - mt, dc = c.x - mt, dd = d.x - mt;
            const float m2 = (a.y + b.y) + (c.y + d.y) + 64.0f * ((da * da + db * db) + (dc * dc + dd * dd));
            unsigned long long* slot = (unsigned long long*)xbuf + ((size_t)(u.pm * BM + row) * 4 + u.pn);
            __hip_atomic_store(slot, ((unsigned long long)__float_as_uint(m2) << 32) | __float_as_uint(mt), __ATOMIC_RELAXED, __HIP_MEMORY_SCOPE_AGENT);
        }
        asm volatile("s_waitcnt vmcnt(0)" ::: "memory");
        if (lane == 0) __hip_atomic_fetch_add(cnt + 64 * u.pm, 1u, __ATOMIC_RELAXED, __HIP_MEMORY_SCOPE_AGENT);
        if (wid == 0) {
            bool dead = false; const unsigned long long t0 = __builtin_amdgcn_s_memrealtime(); const unsigned want = 8u * (unsigned)ntn;
            for (;;) {
#if defined(BROKEN_EXCHANGE_NO_WAIT)
                break;
#endif
                if ((unsigned)__builtin_amdgcn_readfirstlane(__hip_atomic_load(cnt + 64 * u.pm, __ATOMIC_RELAXED, __HIP_MEMORY_SCOPE_AGENT)) >= want) break;
                if (__builtin_amdgcn_s_memrealtime() - t0 > 2000000ull) {
                    if (lane == 0) { unsigned expect = 0u; __hip_atomic_compare_exchange_strong(tmo + 1, &expect, code | (unsigned)(u.pm & 0xff), __ATOMIC_RELAXED, __ATOMIC_RELAXED, __HIP_MEMORY_SCOPE_AGENT);
                                     __hip_atomic_store(tmo, 1u, __ATOMIC_RELAXED, __HIP_MEMORY_SCOPE_AGENT); }
                    dead = true; break; }
                __builtin_amdgcn_s_sleep(2);
            }
            __builtin_amdgcn_fence(__ATOMIC_ACQUIRE, "agent");
            if (lane == 0) flag[0] = dead ? 1u : 0u;
        }
        asm volatile("s_waitcnt vmcnt(0) lgkmcnt(0)" ::: "memory"); __builtin_amdgcn_s_barrier(); asm volatile("" ::: "memory");
        const bool bad = flag[0] != 0u;
        if (lane < 32) {
            const unsigned long long* slot = (const unsigned long long*)xbuf + (size_t)(u.pm * BM + row) * 4; float mt[4], m2[4]; float ms = 0.f;
#pragma unroll
            for (int t = 0; t < 4; ++t) { if (t < ntn) { const unsigned long long w = __hip_atomic_load(slot + t, __ATOMIC_RELAXED, __HIP_MEMORY_SCOPE_AGENT); mt[t] = __uint_as_float((unsigned)w); m2[t] = __uint_as_float((unsigned)(w >> 32)); } else { mt[t] = 0.f; m2[t] = 0.f; } ms += mt[t]; }
            const float mean = ms / (float)ntn; float q = 0.f;
#pragma unroll
            for (int t = 0; t < 4; ++t) if (t < ntn) { const float dm = mt[t] - mean; q += m2[t] + 256.0f * dm * dm; }
            S[row] = (f32x2v){mean, 1.0f / sqrtf(q / (256.0f * (float)ntn) + eps)};
        }
        asm volatile("s_waitcnt lgkmcnt(0)" ::: "memory"); __builtin_amdgcn_s_barrier(); asm volatile("" ::: "memory");
        return bad;
    }
};
struct EpiLnRes {
    static constexpr bool PERM = false, AFTER_DRAIN = true;
    const float* base; float* out; int ldc; const float* bias; PanelStats st; unsigned poison;
    __device__ __forceinline__ void fused(f32x4 (&acc)[2][2][4][2], const Unit& u, int wr, int wc, int fr, int fq, PG8_LAS unsigned char* lds, int wid, int lane) const {
        typedef float f32x2v __attribute__((ext_vector_type(2)));
        const PG8_LAS f32x2v* S = (const PG8_LAS f32x2v*)(lds + 8192);
        const int col0 = u.pn * BM + wc * 32 + 4 * fq;
#pragma unroll
        for (int bj = 0; bj < 2; ++bj)
#pragma unroll
            for (int n = 0; n < 2; ++n) { const f32x4 bv = bias ? *(const f32x4*)(bias + col0 + bj * HALF + n * 16) : (f32x4){0.f, 0.f, 0.f, 0.f};
#pragma unroll
                for (int ai = 0; ai < 2; ++ai)
#pragma unroll
                    for (int m = 0; m < 4; ++m) acc[ai][bj][m][n] += bv; }
        f32x4 pre[4][2][2];
#pragma unroll
        for (int m = 0; m < 4; ++m) { const size_t off = (size_t)(u.pm * BM + wr * 64 + m * 16 + fr) * ldc + col0;
#pragma unroll
            for (int bj = 0; bj < 2; ++bj)
#pragma unroll
                for (int n = 0; n < 2; ++n) pre[m][bj][n] = *(const f32x4*)(base + off + bj * HALF + n * 16); }
        const bool bad = st.run(acc, u, wr, wc, fr, fq, lds, wid, lane) || poison != 0u;
        const float qnan = __builtin_nanf("");
#pragma unroll
        for (int ai = 0; ai < 2; ++ai)
#pragma unroll
            for (int m = 0; m < 4; ++m) { const int r = ai * HALF + wr * 64 + m * 16 + fr; const f32x2v sr = S[r]; const size_t off = (size_t)(u.pm * BM + r) * ldc + col0;
#pragma unroll
                for (int bj = 0; bj < 2; ++bj)
#pragma unroll
                    for (int n = 0; n < 2; ++n) { const f32x4 bs = ai == 0 ? pre[m][bj][n] : *(const f32x4*)(base + off + bj * HALF + n * 16); f32x4 o = bs + (acc[ai][bj][m][n] - sr.x) * sr.y;
                        if (bad) o = (f32x4){qnan, qnan, qnan, qnan}; *(f32x4*)(out + off + bj * HALF + n * 16) = o; }
                if (m & 1) asm volatile("" ::: "memory"); }
    }
};
struct EpiLnResLn {
    static constexpr bool PERM = false, AFTER_DRAIN = true;
    const float* base; float* out; bf16_t* xn; int ldc; const float* bias; PanelStats st1, st2; unsigned poison;
    __device__ __forceinline__ void fused(f32x4 (&acc)[2][2][4][2], const Unit& u, int wr, int wc, int fr, int fq, PG8_LAS unsigned char* lds, int wid, int lane) const {
        typedef float f32x2v __attribute__((ext_vector_type(2))); typedef unsigned u32x2v __attribute__((ext_vector_type(2)));
        const PG8_LAS f32x2v* S = (const PG8_LAS f32x2v*)(lds + 8192);
        const int col0 = u.pn * BM + wc * 32 + 4 * fq;
#pragma unroll
        for (int bj = 0; bj < 2; ++bj)
#pragma unroll
            for (int n = 0; n < 2; ++n) { const f32x4 bv = bias ? *(const f32x4*)(bias + col0 + bj * HALF + n * 16) : (f32x4){0.f, 0.f, 0.f, 0.f};
#pragma unroll
                for (int ai = 0; ai < 2; ++ai)
#pragma unroll
                    for (int m = 0; m < 4; ++m) acc[ai][bj][m][n] += bv; }
        bool bad = st1.run(acc, u, wr, wc, fr, fq, lds, wid, lane) || poison != 0u;
        const float qnan = __builtin_nanf("");
#pragma unroll
        for (int ai = 0; ai < 2; ++ai)
#pragma unroll
            for (int m = 0; m < 4; ++m) { const int r = ai * HALF + wr * 64 + m * 16 + fr; const f32x2v sr = S[r]; const size_t off = (size_t)(u.pm * BM + r) * ldc + col0;
#pragma unroll
                for (int bj = 0; bj < 2; ++bj)
#pragma unroll
                    for (int n = 0; n < 2; ++n) { const f32x4 bs = *(const f32x4*)(base + off + bj * HALF + n * 16); acc[ai][bj][m][n] = bs + (acc[ai][bj][m][n] - sr.x) * sr.y; }
                asm volatile("" : "+v"(acc[ai][0][m][0]), "+v"(acc[ai][0][m][1]), "+v"(acc[ai][1][m][0]), "+v"(acc[ai][1][m][1]));
                if (m & 1) asm volatile("" ::: "memory"); }
        const bool bad1 = bad;
        bad = st2.run(acc, u, wr, wc, fr, fq, lds, wid, lane) || bad;
#pragma unroll
        for (int ai = 0; ai < 2; ++ai)
#pragma unroll
            for (int m = 0; m < 4; ++m) { const int r = ai * HALF + wr * 64 + m * 16 + fr; const f32x2v sr = S[r]; const size_t off = (size_t)(u.pm * BM + r) * ldc + col0;
#pragma unroll
                for (int bj = 0; bj < 2; ++bj)
#pragma unroll
                    for (int n = 0; n < 2; ++n) { const f32x4 x1 = acc[ai][bj][m][n]; *(f32x4*)(out + off + bj * HALF + n * 16) = bad1 ? (f32x4){qnan, qnan, qnan, qnan} : x1;
                        const f32x4 o = (x1 - sr.x) * sr.y; u32x2v w; w.x = cvt_pk_bf16(o[0], o[1]); w.y = cvt_pk_bf16(o[2], o[3]);
                        if (bad) { w.x = 0x7fc07fc0u; w.y = 0x7fc07fc0u; } *(u32x2v*)(xn + off + bj * HALF + n * 16) = w; }
                asm volatile("" ::: "memory"); }
    }
};

template <class Epi, class Sched, bool ALIGN_EPI = false, bool SP2 = false>
__device__ __forceinline__ void gemm_phase(PG8_LAS unsigned char* lds, const Gemm g, const Sched& S, const Epi& E) {
    const int tid = threadIdx.x, wid = __builtin_amdgcn_readfirstlane(tid >> 6), lane = tid & 63, wr = wid >> 2, wc = wid & 3, fr = lane & 15, fq = lane >> 4;
    const int K = g.K, nt = K / BK;
    unsigned voffA[2], voffB[2];
#pragma unroll
    for (int i = 0; i < 2; ++i) { int R, C; stage_rc(tid * 16 + i * 8192, R, C); const int Rb = Epi::PERM ? ((R & ~31) + perm32(R & 31)) : R;
        voffA[i] = (unsigned)(R * K + C) * 2u; voffB[i] = (unsigned)(Rb * K + C) * 2u; }
    const size_t kstep = (size_t)(BK * 2);
    const size_t hstep = (size_t)HALF * K * 2;
    const size_t tstep = 2 * hstep;
    const unsigned ldsw = (unsigned)wid * 1024u;
    const int aoff = lds_byte(wr * 64 + fr, fq * 8), boff = lds_byte(wc * 32 + fr, fq * 8);
#define PG8_SA(b, h) (((b) * 2 + (h)) * HTB)
#define PG8_SB(b, h) ((4 + (b) * 2 + (h)) * HTB)
#define PG8_STAGE(bufoff, gbase, voff) do { _Pragma("unroll") for (int _i = 0; _i < 2; ++_i) \
        __builtin_amdgcn_global_load_lds((const unsigned*)((const char*)(gbase) + (voff)[_i]), (PG8_LAS unsigned*)(lds + (bufoff) + ldsw + _i * 8192), 16, 0, 0); } while (0)
#define PG8_LDA(dst, b, h) do { _Pragma("unroll") for (int m = 0; m < 4; ++m) _Pragma("unroll") for (int k = 0; k < 2; ++k) dst[m][k] = *(const PG8_LAS bf16x8*)(lds + PG8_SA(b, h) + aoff + m * 2048 + k * 1024); } while (0)
#define PG8_LDB(dst, b, h) do { _Pragma("unroll") for (int n = 0; n < 2; ++n) _Pragma("unroll") for (int k = 0; k < 2; ++k) dst[n][k] = *(const PG8_LAS bf16x8*)(lds + PG8_SB(b, h) + boff + n * 2048 + k * 1024); } while (0)
#define PG8_MMA(ai, bj, At, Bt) do { __builtin_amdgcn_s_setprio(1); _Pragma("unroll") for (int m = 0; m < 4; ++m) _Pragma("unroll") for (int n = 0; n < 2; ++n) _Pragma("unroll") for (int k = 0; k < 2; ++k) \
        acc[ai][bj][m][n] = __builtin_amdgcn_mfma_f32_16x16x32_bf16(Bt[n][k], At[m][k], acc[ai][bj][m][n], 0, 0, 0); __builtin_amdgcn_s_setprio(0); } while (0)
#define PG8_WAIT_V(n) asm volatile("s_waitcnt vmcnt(" #n ")" ::: "memory")
#define PG8_WAIT_L(n) asm volatile("s_waitcnt lgkmcnt(" #n ")" ::: "memory")
#define PG8_BAR __builtin_amdgcn_s_barrier()
#define PG8_SCHED __builtin_amdgcn_sched_barrier(0)
    Unit cur, nxt; int ui = 0;
    if (!S.next(0, cur)) return;
    f32x4 acc[2][2][4][2];
#pragma unroll
    for (int a = 0; a < 2; ++a)
#pragma unroll
        for (int b = 0; b < 2; ++b)
#pragma unroll
            for (int m = 0; m < 4; ++m)
#pragma unroll
                for (int n = 0; n < 2; ++n) acc[a][b][m][n] = (f32x4){0.f, 0.f, 0.f, 0.f};
    bf16x8 At[4][2], B0[2][2], B1[2][2];
    const char* cA = (const char*)g.A + (size_t)cur.pm * tstep; const char* cB = (const char*)g.Bt + (size_t)cur.pn * tstep;
    S.a_ready(cur);
    if constexpr (SP2) {
        PG8_STAGE(PG8_SB(0, 0), cB, voffB); PG8_STAGE(PG8_SB(0, 1), cB + hstep, voffB); PG8_STAGE(PG8_SA(0, 0), cA, voffA); PG8_STAGE(PG8_SA(0, 1), cA + hstep, voffA);
        if (wr == 1) PG8_BAR;
        PG8_WAIT_V(2); PG8_BAR;
        PG8_STAGE(PG8_SB(1, 0), cB + kstep, voffB); PG8_STAGE(PG8_SA(1, 0), cA + kstep, voffA); PG8_STAGE(PG8_SB(1, 1), cB + hstep + kstep, voffB);
        PG8_WAIT_V(6); PG8_BAR;
    } else {
        PG8_STAGE(PG8_SB(0, 0), cB, voffB); PG8_STAGE(PG8_SA(0, 0), cA, voffA); PG8_STAGE(PG8_SB(0, 1), cB + hstep, voffB); PG8_STAGE(PG8_SA(0, 1), cA + hstep, voffA);
        if (wr == 1) PG8_BAR;
        PG8_WAIT_V(4); PG8_BAR;
        PG8_STAGE(PG8_SB(1, 0), cB + kstep, voffB); PG8_STAGE(PG8_SA(1, 0), cA + kstep, voffA); PG8_STAGE(PG8_SB(1, 1), cB + hstep + kstep, voffB);
        PG8_WAIT_V(6); PG8_BAR;
    }
    for (;;) {
        const bool has_next = S.next(ui + 1, nxt);
        const char* nA = has_next ? (const char*)g.A + (size_t)nxt.pm * tstep : cA; const char* nB = has_next ? (const char*)g.Bt + (size_t)nxt.pn * tstep : cB;
        for (int t = 0; t < nt; t += 2) {
            const bool last = (t == nt - 2);
            const char* a1 = cA + (size_t)(t + 1) * kstep;
            const char* a2 = last ? nA : cA + (size_t)(t + 2) * kstep; const char* b2 = last ? nB : cB + (size_t)(t + 2) * kstep;
            const char* a3 = a2 + kstep; const char* b3 = b2 + kstep;
            if (last && has_next) S.a_ready(nxt);
            if constexpr (SP2) {
            PG8_LDB(B0, 0, 0); PG8_LDB(B1, 0, 1); PG8_SCHED; PG8_LDA(At, 0, 0); PG8_STAGE(PG8_SA(1, 1), a1 + hstep, voffA);
            PG8_WAIT_V(8); PG8_WAIT_L(0); PG8_BAR; PG8_MMA(0, 0, At, B0); PG8_MMA(0, 1, At, B1); PG8_BAR; PG8_SCHED;
            PG8_LDA(At, 0, 1); PG8_STAGE(PG8_SB(0, 0), b2, voffB); PG8_STAGE(PG8_SB(0, 1), b2 + hstep, voffB); PG8_STAGE(PG8_SA(0, 0), a2, voffA);
            PG8_WAIT_V(8); PG8_WAIT_L(0); PG8_BAR; PG8_MMA(1, 0, At, B0); PG8_MMA(1, 1, At, B1); PG8_BAR; PG8_SCHED;
            PG8_LDB(B0, 1, 0); PG8_LDB(B1, 1, 1); PG8_SCHED; PG8_LDA(At, 1, 0); PG8_STAGE(PG8_SA(0, 1), a2 + hstep, voffA);
            PG8_WAIT_V(8); PG8_WAIT_L(0); PG8_BAR; PG8_MMA(0, 0, At, B0); PG8_MMA(0, 1, At, B1); PG8_BAR; PG8_SCHED;
            PG8_LDA(At, 1, 1); PG8_STAGE(PG8_SB(1, 0), b3, voffB); PG8_STAGE(PG8_SB(1, 1), b3 + hstep, voffB); PG8_STAGE(PG8_SA(1, 0), a3, voffA);
            PG8_WAIT_V(8); PG8_WAIT_L(0); PG8_BAR; PG8_MMA(1, 0, At, B0); PG8_MMA(1, 1, At, B1); PG8_BAR; PG8_SCHED;
            } else {
            PG8_LDB(B0, 0, 0); PG8_SCHED; PG8_LDA(At, 0, 0); PG8_STAGE(PG8_SA(1, 1), a1 + hstep, voffA);
            PG8_WAIT_L(8); PG8_BAR; PG8_WAIT_L(0); PG8_MMA(0, 0, At, B0); PG8_BAR; PG8_SCHED;
            PG8_LDB(B1, 0, 1); PG8_STAGE(PG8_SB(0, 0), b2, voffB);
            PG8_BAR; PG8_WAIT_L(0); PG8_MMA(0, 1, At, B1); PG8_BAR;
            PG8_LDA(At, 0, 1); PG8_STAGE(PG8_SA(0, 0), a2, voffA);
            PG8_BAR; PG8_WAIT_L(0); PG8_MMA(1, 0, At, B0); PG8_BAR; PG8_SCHED;
            PG8_STAGE(PG8_SB(0, 1), b2 + hstep, voffB);
            PG8_WAIT_V(6); PG8_BAR; PG8_MMA(1, 1, At, B1); PG8_BAR;
            PG8_LDB(B0, 1, 0); PG8_SCHED; PG8_LDA(At, 1, 0); PG8_STAGE(PG8_SA(0, 1), a2 + hstep, voffA);
            PG8_WAIT_L(8); PG8_BAR; PG8_WAIT_L(0); PG8_MMA(0, 0, At, B0); PG8_BAR; PG8_SCHED;
            PG8_LDB(B1, 1, 1); PG8_STAGE(PG8_SB(1, 0), b3, voffB);
            PG8_BAR; PG8_WAIT_L(0); PG8_MMA(0, 1, At, B1); PG8_BAR;
            PG8_LDA(At, 1, 1); PG8_STAGE(PG8_SA(1, 0), a3, voffA);
            PG8_BAR; PG8_WAIT_L(0); PG8_MMA(1, 0, At, B0); PG8_BAR; PG8_SCHED;
            PG8_STAGE(PG8_SB(1, 1), b3 + hstep, voffB);
            PG8_WAIT_V(6); PG8_BAR; PG8_MMA(1, 1, At, B1); PG8_BAR;
            }
        }
        if constexpr (ALIGN_EPI) { if (wr == 0) PG8_BAR; }
        if constexpr (!Epi::AFTER_DRAIN) { E(acc, cur, wr, wc, fr, fq); S.done(cur); }
        if (!has_next) break;
#pragma unroll
        for (int a = 0; a < 2; ++a)
#pragma unroll
            for (int b = 0; b < 2; ++b)
#pragma unroll
                for (int m = 0; m < 4; ++m)
#pragma unroll
                    for (int n = 0; n < 2; ++n) acc[a][b][m][n] = (f32x4){0.f, 0.f, 0.f, 0.f};
        cur = nxt; cA = nA; cB = nB; ++ui;
        if constexpr (ALIGN_EPI) { if (wr == 1) PG8_BAR; }
    }
    PG8_WAIT_V(0);
    if constexpr (!ALIGN_EPI) { if (wr == 0) PG8_BAR; }
    PG8_BAR;
    if constexpr (Epi::AFTER_DRAIN) { E.fused(acc, cur, wr, wc, fr, fq, lds, wid, lane); S.done(cur); }
#undef PG8_SA
#undef PG8_SB
#undef PG8_STAGE
#undef PG8_LDA
#undef PG8_LDB
#undef PG8_MMA
#undef PG8_WAIT_V
#undef PG8_WAIT_L
#undef PG8_BAR
#undef PG8_SCHED
}
}

#ifndef PG8_SP2
#define PG8_SP2 true
#endif
#ifndef PG8_ALIGN
#define PG8_ALIGN true
#endif
namespace pg8 {
__device__ __forceinline__ float silu_f(float x) { return x * __builtin_amdgcn_rcpf(1.0f + __expf(-x)); }
struct EpiSwiGLU {
    static constexpr bool PERM = true, AFTER_DRAIN = false;
    bf16_t* O; int ldc;
    __device__ __forceinline__ void operator()(const f32x4 (&acc)[2][2][4][2], const Unit& u, int wr, int wc, int fr, int fq) const {
        const int row0 = u.pm * BM + wr * 64 + fr, col0 = u.pn * HALF + wc * 32 + 8 * fq;
#pragma unroll
        for (int ai = 0; ai < 2; ++ai)
#pragma unroll
            for (int m = 0; m < 4; ++m) {
                bf16_t* rowp = O + (size_t)(row0 + ai * HALF + m * 16) * ldc + col0;
                const f32x4 g0 = acc[ai][0][m][0], g1 = acc[ai][0][m][1], u0 = acc[ai][1][m][0], u1 = acc[ai][1][m][1];
                u32x4 w;
                w.x = cvt_pk_bf16(silu_f(g0[0]) * u0[0], silu_f(g0[1]) * u0[1]); w.y = cvt_pk_bf16(silu_f(g0[2]) * u0[2], silu_f(g0[3]) * u0[3]);
                w.z = cvt_pk_bf16(silu_f(g1[0]) * u1[0], silu_f(g1[1]) * u1[1]); w.w = cvt_pk_bf16(silu_f(g1[2]) * u1[2], silu_f(g1[3]) * u1[3]);
                *(u32x4*)rowp = w;
            }
    }
};
struct EpiF32 {
    static constexpr bool PERM = false, AFTER_DRAIN = false;
    float* O; int ldc;
    __device__ __forceinline__ void operator()(const f32x4 (&acc)[2][2][4][2], const Unit& u, int wr, int wc, int fr, int fq) const {
        const int row0 = u.pm * BM + wr * 64 + fr, col0 = u.pn * BM + wc * 32 + 4 * fq;
#pragma unroll
        for (int ai = 0; ai < 2; ++ai)
#pragma unroll
            for (int m = 0; m < 4; ++m) {
                float* rowp = O + (size_t)(row0 + ai * HALF + m * 16) * ldc + col0;
#pragma unroll
                for (int bj = 0; bj < 2; ++bj)
#pragma unroll
                    for (int n = 0; n < 2; ++n) *(f32x4*)(rowp + bj * HALF + n * 16) = acc[ai][bj][m][n];
            }
    }
};
}
#define GAS __attribute__((address_space(1)))
#define LAS __attribute__((address_space(3)))
typedef unsigned short bf16;
typedef unsigned v4u __attribute__((ext_vector_type(4)));
typedef float f32x4 __attribute__((ext_vector_type(4)));
typedef short bf16x8 __attribute__((ext_vector_type(8)));
typedef GAS unsigned gu32;
typedef GAS unsigned long long gu64;
#define RLX_AGENT __ATOMIC_RELAXED, __HIP_MEMORY_SCOPE_AGENT
#define LDS_WAIT() asm volatile("s_waitcnt lgkmcnt(0)" ::: "memory")
#define VM_WAIT() asm volatile("s_waitcnt vmcnt(0)" ::: "memory")
__device__ __forceinline__ unsigned long long rt() { return __builtin_amdgcn_s_memrealtime(); }
__device__ __forceinline__ unsigned f2bf(float f) { unsigned u = __builtin_bit_cast(unsigned, f); return (u + 0x7fffu + ((u >> 16) & 1u)) >> 16; }
__device__ __forceinline__ unsigned pk2(float lo, float hi) { return f2bf(lo) | (f2bf(hi) << 16); }

#define XB_TMO      128
#define XB_XCNT(j)  (256  + 64 * (j))
#define XB_XSUB(j)  (1280 + 64 * (j))
#define XB_XGEN(j)  (2304 + 64 * (j))
#define XB_TOP      3328
#define XB_TOPGEN   3392
#define XCD_BAR_WORDS 3456
#define XB_SPIN_CAP (1u << 18)

__device__ __forceinline__ unsigned xb_ld(unsigned* p)              { return __hip_atomic_load(p, __ATOMIC_RELAXED, __HIP_MEMORY_SCOPE_AGENT); }
__device__ __forceinline__ unsigned xb_add(unsigned* p, unsigned v) { return __hip_atomic_fetch_add(p, v, __ATOMIC_RELAXED, __HIP_MEMORY_SCOPE_AGENT); }
__device__ __forceinline__ unsigned xb_xcc_id() { return (unsigned)__builtin_amdgcn_s_getreg((3 << 11) | 20) & 0xFu; }
#define XB_SPIN(cond, bar) do { unsigned _sp = 0; while (cond) { __builtin_amdgcn_s_sleep(1); \
    if ((++_sp & 255u) == 0u) { if (xb_ld(&(bar)[XB_TMO])) break; if (_sp > XB_SPIN_CAP) { atomicAdd(&(bar)[XB_TMO], 1u); break; } } } } while (0)

struct XcdBarrier {
    unsigned* bar; unsigned x;
    volatile LAS unsigned* st;
};

__device__ __forceinline__ XcdBarrier xcd_barrier_post(unsigned* bar, volatile LAS unsigned* st) {
    XcdBarrier b; b.bar = bar; b.x = xb_xcc_id(); b.st = st;
    if (threadIdx.x == 0) (void)xb_add(&bar[XB_XCNT(b.x)], 1u);
    return b;
}
__device__ __forceinline__ void xcd_barrier_complete(unsigned* bar, unsigned x, unsigned& nloc, unsigned& nx) {
    const unsigned G = gridDim.x * gridDim.y * gridDim.z;
    unsigned sum, cnt, mine, sp = 0u;
    for (;;) {
        sum = 0u; cnt = 0u; mine = 0u;
#pragma unroll
        for (unsigned j = 0; j < 16; ++j) { const unsigned c = xb_ld(&bar[XB_XCNT(j)]); sum += c; cnt += (c > 0u) ? 1u : 0u; mine = (j == x) ? c : mine; }
        if (sum == G) break;
        __builtin_amdgcn_s_sleep(1);
        if ((++sp & 255u) == 0u) { if (xb_ld(&bar[XB_TMO])) break; if (sp > XB_SPIN_CAP) { atomicAdd(&bar[XB_TMO], 1u); break; } }
    }
    nloc = mine > 0u ? mine : 1u; nx = cnt > 0u ? cnt : 1u;
}

__device__ __forceinline__ void xcd_barrier(const XcdBarrier& b) {
    asm volatile("s_waitcnt vmcnt(0)" ::: "memory");
    __syncthreads();
    if (threadIdx.x == 0) {
        unsigned* bar = b.bar;
        __builtin_amdgcn_s_waitcnt(0);
        unsigned nloc = b.st[0], nx = b.st[1];
        if (nloc == 0u) { xcd_barrier_complete(bar, b.x, nloc, nx); b.st[0] = nloc; b.st[1] = nx; }
        const unsigned old = xb_add(&bar[XB_XSUB(b.x)], 1u);
        const unsigned gen = old / nloc;
        if (old + 1u == (gen + 1u) * nloc) {
            __builtin_amdgcn_fence(__ATOMIC_RELEASE, "agent");
            asm volatile("s_waitcnt vmcnt(0)" ::: "memory");
            const unsigned og = xb_add(&bar[XB_TOP], 1u);
            const unsigned tg = og / nx;
            if (og + 1u == (tg + 1u) * nx) xb_add(&bar[XB_TOPGEN], 1u);
            else XB_SPIN(xb_ld(&bar[XB_TOPGEN]) == tg, bar);
            __builtin_amdgcn_fence(__ATOMIC_ACQUIRE, "agent");
            xb_add(&bar[XB_XGEN(b.x)], 1u);
            asm volatile("s_waitcnt vmcnt(0)" ::: "memory");
        } else {
            XB_SPIN(xb_ld(&bar[XB_XGEN(b.x)]) == gen, bar);
            __builtin_amdgcn_fence(__ATOMIC_ACQUIRE, "agent");
            asm volatile("s_waitcnt vmcnt(0)" ::: "memory");
        }
    }
    __syncthreads();
}

constexpr int NWAVES = 8;
constexpr int BATCH = 8, SEQ = 4096, D = 1024, M = BATCH * SEQ;
constexpr int NC_IN = 3592, C_BETA = 2048, C_QB = 2056;
constexpr int NIN = 3584;
constexpr int DFF = 2816, NGU = 2 * DFF;
constexpr float EPS = 1e-6f;
constexpr size_t MiB = 1u << 20;
constexpr size_t WS_CTL = 0, CTL_ZERO_BYTES = 1 * MiB;
constexpr size_t WS_WIN = 1 * MiB, WS_WO = 8 * MiB, WS_WGU = 10 * MiB, WS_WD = 21 * MiB, WS_BG = 27 * MiB;
constexpr size_t WS_XN = 32 * MiB;
constexpr size_t WS_PROJ = 96 * MiB;
constexpr size_t SEG = 32 * MiB;
constexpr size_t WS_QH = 320 * MiB, WS_KH = 352 * MiB, WS_VH = 384 * MiB, WS_ORAW = 416 * MiB;
constexpr size_t WS_Y = 320 * MiB;
constexpr size_t WS_XN2 = 448 * MiB;
constexpr size_t WS_HID = 96 * MiB;
constexpr size_t WS_SO1 = 32 * MiB, WS_SO2 = 64 * MiB, WS_SO3 = 480 * MiB;
constexpr size_t WS_LSE = 28 * MiB;
constexpr size_t WS_MIXO = 96 * MiB;
constexpr size_t WS_END = 512 * MiB;
constexpr int CW_BAR = 4096;
constexpr int RING_OFF = 0, RING_BYTES = 131072;
constexpr int LDSCTL_OFF = RING_BYTES, MISC_OFF = LDSCTL_OFF + 320;
constexpr int LDS_BYTES = 147456;

__constant__ int c_bkt[3][129] = {
 {0, 1, 2, 3, 4, 5, 6, 7, 8, 9, 10, 11, 12, 13, 14, 15, 16, 16, 16, 16, 16, 16, 17, 17, 17, 17, 17, 17, 17, 17, 18, 18, 18, 18, 18, 18, 18, 18, 18, 18, 19, 19, 19, 19, 19, 19, 19, 19, 19, 19, 19, 19, 19, 19, 20, 20, 20, 20, 20, 20, 20, 20, 20, 20, 20, 20, 20, 20, 20, 20, 20, 20, 20, 21, 21, 21, 21, 21, 21, 21, 21, 21, 21, 21, 21, 21, 21, 21, 21, 21, 21, 21, 21, 21, 21, 21, 21, 21, 21, 22, 22, 22, 22, 22, 22, 22, 22, 22, 22, 22, 22, 22, 22, 22, 22, 22, 22, 22, 22, 22, 22, 22, 22, 22, 22, 22, 22, 22, 22},
 {0, 4, 8, 12, 16, 16, 17, 17, 18, 18, 19, 19, 19, 19, 20, 20, 20, 20, 20, 21, 21, 21, 21, 21, 21, 22, 22, 22, 22, 22, 22, 22, 22, 22, 23, 23, 23, 23, 23, 23, 23, 23, 23, 23, 23, 23, 24, 24, 24, 24, 24, 24, 24, 24, 24, 24, 24, 24, 24, 24, 24, 24, 25, 25, 25, 25, 25, 25, 25, 25, 25, 25, 25, 25, 25, 25, 25, 25, 25, 25, 25, 25, 25, 26, 26, 26, 26, 26, 26, 26, 26, 26, 26, 26, 26, 26, 26, 26, 26, 26, 26, 26, 26, 26, 26, 26, 26, 26, 26, 26, 26, 26, 26, 27, 27, 27, 27, 27, 27, 27, 27, 27, 27, 27, 27, 27, 27, 27, 27},
 {0, 16, 18, 19, 20, 21, 21, 22, 22, 23, 23, 23, 24, 24, 24, 24, 25, 25, 25, 25, 25, 26, 26, 26, 26, 26, 26, 26, 26, 27, 27, 27, 27, 27, 27, 27, 27, 27, 27, 28, 28, 28, 28, 28, 28, 28, 28, 28, 28, 28, 28, 28, 29, 29, 29, 29, 29, 29, 29, 29, 29, 29, 29, 29, 29, 29, 29, 29, 29, 29, 30, 30, 30, 30, 30, 30, 30, 30, 30, 30, 30, 30, 30, 30, 30, 30, 30, 30, 30, 30, 30, 30, 30, 30, 30, 31, 31, 31, 31, 31, 31, 31, 31, 31, 31, 31, 31, 31, 31, 31, 31, 31, 31, 31, 31, 31, 31, 31, 31, 31, 31, 31, 31, 31, 31, 31, 31, 31, 31}};

struct Frame {
    LAS unsigned char* lds;
    volatile LAS unsigned* MISC;
    gu32* ctl;
    int tid, lane, wave, vcu, G;
    unsigned char* ws;
};
struct Args { const float* in[15]; float* out; unsigned char* ws; int ph_lo, ph_hi; };
#define A_x          (A.in[0])
#define A_w_in       (A.in[1])
#define A_conv_w     (A.in[2])
#define A_a_log      (A.in[3])
#define A_dt_bias    (A.in[4])
#define A_onorm_g    (A.in[5])
#define A_rel_bias   (A.in[6])
#define A_w_out      (A.in[7])
#define A_g_mix_pre  (A.in[8])
#define A_g_mix_post (A.in[9])
#define A_w_gate     (A.in[10])
#define A_w_up       (A.in[11])
#define A_w_down     (A.in[12])
#define A_g_ffn_pre  (A.in[13])
#define A_g_ffn_post (A.in[14])
#define W_WIN  ((bf16*)(F.ws + WS_WIN))
#define W_WO   ((bf16*)(F.ws + WS_WO))
#define W_WGU  ((bf16*)(F.ws + WS_WGU))
#define W_WD   ((bf16*)(F.ws + WS_WD))
#define W_BG   ((float*)(F.ws + WS_BG))
#define W_XN   ((bf16*)(F.ws + WS_XN))
#define W_PROJ ((bf16*)(F.ws + WS_PROJ))
#define W_QH   ((bf16*)(F.ws + WS_QH))
#define W_KH   ((bf16*)(F.ws + WS_KH))
#define W_VH   ((bf16*)(F.ws + WS_VH))
#define W_MIXO ((bf16*)(F.ws + WS_MIXO))
#define W_XN2  ((bf16*)(F.ws + WS_XN2))
#define W_HID  ((bf16*)(F.ws + WS_HID))
#define W_ORAW ((float*)(F.ws + WS_ORAW))
#define W_Y    ((float*)(F.ws + WS_Y))
__device__ __forceinline__ float wave_sum(float v) {
#pragma unroll
    for (int o = 1; o < 64; o <<= 1) v += __shfl_xor(v, o);
    return v;
}
__device__ __forceinline__ float bf2f(bf16 b) { return __builtin_bit_cast(float, (unsigned)b << 16); }
__device__ __forceinline__ float siluf(float x) { return x / (1.f + __expf(-x)); }

__device__ __forceinline__ void p0_transpose_item(const float* W, int ldw, int col0, int K, bf16* WT, int dst_row0, int k0, LAS float* scr, int lane) {
#pragma unroll 8
    for (int i = 0; i < 32; ++i) { const int kk = 2 * i + (lane >> 5); scr[kk * 33 + (lane & 31)] = W[(size_t)(k0 + kk) * ldw + col0 + (lane & 31)]; }
    LDS_WAIT(); asm volatile("" ::: "memory");
    const int c = lane & 7;
#pragma unroll
    for (int j = 0; j < 4; ++j) { const int n = (lane >> 3) + 8 * j; const LAS float* s = scr + (8 * c) * 33 + n;
        v4u o; o.x = pk2(s[0 * 33], s[1 * 33]); o.y = pk2(s[2 * 33], s[3 * 33]); o.z = pk2(s[4 * 33], s[5 * 33]); o.w = pk2(s[6 * 33], s[7 * 33]);
        *(GAS v4u*)(WT + (size_t)(dst_row0 + n) * K + k0 + 8 * c) = o; }
    LDS_WAIT(); asm volatile("" ::: "memory");
}

__device__ __forceinline__ void ph_prologue(Frame& F, const Args& A) {
    LAS float* scr = (LAS float*)(F.lds + RING_OFF + F.wave * 16384);
    const int gw = F.vcu * NWAVES + F.wave, NGW = F.G * NWAVES;
    constexpr int I_A = 16 * 64, I_B = 16 * 48, I_O = 16 * 32, I_G = 16 * 88, I_D = 44 * 32;
    constexpr int NITEMS = I_A + I_B + I_O + 2 * I_G + I_D;
    for (int it = gw; it < NITEMS; it += NGW) {
        int r = it;
        if (r < I_A) { const int kb = r / 64, nb = r % 64; p0_transpose_item(A_w_in, NC_IN, 32 * nb, D, W_WIN, 32 * nb, 64 * kb, scr, F.lane); continue; } r -= I_A;
        if (r < I_B) { const int kb = r / 48, nb = r % 48; p0_transpose_item(A_w_in, NC_IN, C_QB + 32 * nb, D, W_WIN, 2048 + 32 * nb, 64 * kb, scr, F.lane); continue; } r -= I_B;
        if (r < I_O) { const int kb = r / 32, nb = r % 32; p0_transpose_item(A_w_out, D, 32 * nb, D, W_WO, 32 * nb, 64 * kb, scr, F.lane); continue; } r -= I_O;
        if (r < I_G) { const int kb = r / 88, nb = r % 88, n0 = 32 * nb; p0_transpose_item(A_w_gate, DFF, n0, D, W_WGU, 256 * (n0 >> 7) + (n0 & 127), 64 * kb, scr, F.lane); continue; } r -= I_G;
        if (r < I_G) { const int kb = r / 88, nb = r % 88, n0 = 32 * nb; p0_transpose_item(A_w_up, DFF, n0, D, W_WGU, 256 * (n0 >> 7) + 128 + (n0 & 127), 64 * kb, scr, F.lane); continue; } r -= I_G;
        { const int kb = r / 32, nb = r % 32; p0_transpose_item(A_w_down, D, 32 * nb, DFF, W_WD, 32 * nb, 64 * kb, scr, F.lane); }
    }
    __syncthreads();
    LAS float* wba = (LAS float*)(F.lds + RING_OFF);
    for (int e = F.tid; e < 8 * D; e += NWAVES * 64) { const int k = e >> 3, c = e & 7; wba[c * D + k] = A_w_in[(size_t)k * NC_IN + C_BETA + c]; }
    __syncthreads();
    for (int m = gw; m < M; m += NGW) {
        const GAS f32x4* xr = (const GAS f32x4*)(A_x + (size_t)m * D) + F.lane;
        const GAS f32x4* gr = (const GAS f32x4*)A_g_mix_pre + F.lane;
        f32x4 v[4]; float s = 0.f;
#pragma unroll
        for (int j = 0; j < 4; ++j) { v[j] = xr[64 * j]; s += (v[j].x * v[j].x + v[j].y * v[j].y) + (v[j].z * v[j].z + v[j].w * v[j].w); }
        const float rstd = rsqrtf(wave_sum(s) * (1.f / D) + EPS);
        GAS unsigned long long* o8 = (GAS unsigned long long*)(W_XN + (size_t)m * D) + F.lane;
        float acc[8];
#pragma unroll
        for (int c = 0; c < 8; ++c) acc[c] = 0.f;
#pragma unroll
        for (int j = 0; j < 4; ++j) {
            const f32x4 g = gr[64 * j]; v[j] = v[j] * rstd * g;
            o8[64 * j] = (unsigned long long)pk2(v[j].x, v[j].y) | ((unsigned long long)pk2(v[j].z, v[j].w) << 32);
#pragma unroll
            for (int c = 0; c < 8; ++c) { const f32x4 w = *((const LAS f32x4*)(wba + c * D) + F.lane + 64 * j); acc[c] += (v[j].x * w.x + v[j].y * w.y) + (v[j].z * w.z + v[j].w * w.w); }
        }
#pragma unroll
        for (int c = 0; c < 8; ++c) acc[c] = wave_sum(acc[c]);
        if (F.lane < 4) {
            const int h = F.lane;
            const float bl = h == 0 ? acc[0] : h == 1 ? acc[1] : h == 2 ? acc[2] : acc[3];
            const float al = h == 0 ? acc[4] : h == 1 ? acc[5] : h == 2 ? acc[6] : acc[7];
            const float beta = 1.f / (1.f + expf(-bl));
            const float xx = al + A_dt_bias[h];
            const float sp = fmaxf(xx, 0.f) + log1pf(expf(-fabsf(xx)));
            W_BG[(size_t)m * 8 + h] = beta;
            W_BG[(size_t)m * 8 + 4 + h] = -expf(A_a_log[h]) * sp;
        }
    }
}

__device__ __forceinline__ void ph_gdn_prep(Frame& F, const Args& A) {
    const int gw = F.vcu * NWAVES + F.wave, NGW = F.G * NWAVES;
    for (int it = gw; it < M * 4; it += NGW) {
        const int m = it >> 2, h = it & 3, t = m & (SEQ - 1);
        float val[3][2];
#pragma unroll
        for (int s = 0; s < 3; ++s)
#pragma unroll
            for (int j = 0; j < 2; ++j) {
                const int c = h * 128 + F.lane + 64 * j, ch = s * 512 + c;
                const bf16* seg = W_PROJ + (size_t)s * M * 512;
                float a = 0.f;
#pragma unroll
                for (int i = 0; i < 4; ++i) { const int tt = t - 3 + i; if (tt >= 0) a += A_conv_w[i * 1536 + ch] * bf2f(seg[(size_t)(m - 3 + i) * 512 + c]); }
                val[s][j] = siluf(a);
            }
        const float sq = wave_sum(val[0][0] * val[0][0] + val[0][1] * val[0][1]);
        const float sk = wave_sum(val[1][0] * val[1][0] + val[1][1] * val[1][1]);
        const float rq = rsqrtf(sq + 1e-6f) * 0.08838834764831845f, rk = rsqrtf(sk + 1e-6f);
#pragma unroll
        for (int j = 0; j < 2; ++j) {
            const size_t o = (size_t)m * 512 + h * 128 + F.lane + 64 * j;
            W_QH[o] = (bf16)f2bf(val[0][j] * rq); W_KH[o] = (bf16)f2bf(val[1][j] * rk); W_VH[o] = (bf16)f2bf(val[2][j]);
        }
    }
}
__device__ __forceinline__ void ph_gdn_seq(Frame& F, const Args& A, int bh) {
    const int b = bh >> 2, h = bh & 3, dv = F.tid & 127;
    LAS float* kq = (LAS float*)(F.lds + RING_OFF);
    float Sx[128];
#pragma unroll
    for (int i = 0; i < 128; ++i) Sx[i] = 0.f;
    const bool act = F.tid < 128;
    for (int t = 0; t < SEQ; ++t) {
        const size_t m = (size_t)b * SEQ + t;
        const int p = t & 1;
        float v = 0.f, beta = 0.f, eg = 0.f;
        if (act) {
            kq[(p * 2 + 0) * 128 + dv] = bf2f(W_KH[m * 512 + h * 128 + dv]);
            kq[(p * 2 + 1) * 128 + dv] = bf2f(W_QH[m * 512 + h * 128 + dv]);
            v = bf2f(W_VH[m * 512 + h * 128 + dv]);
            beta = W_BG[m * 8 + h]; eg = expf(W_BG[m * 8 + 4 + h]);
        }
        __syncthreads();
        if (act) {
            float ks = 0.f;
            const LAS f32x4* kp = (const LAS f32x4*)(kq + (p * 2 + 0) * 128);
            const LAS f32x4* qp = (const LAS f32x4*)(kq + (p * 2 + 1) * 128);
#pragma unroll
            for (int i0 = 0; i0 < 32; i0 += 4) {
#pragma unroll
                for (int i = i0; i < i0 + 4; ++i) { const f32x4 kk = kp[i]; ks += (kk.x * Sx[4 * i] + kk.y * Sx[4 * i + 1]) + (kk.z * Sx[4 * i + 2] + kk.w * Sx[4 * i + 3]); }
                asm volatile("" ::: "memory");
            }
            const float dlt = beta * (v - eg * ks);
            float o = 0.f;
#pragma unroll
            for (int i0 = 0; i0 < 32; i0 += 4) {
#pragma unroll
                for (int i = i0; i < i0 + 4; ++i) { const f32x4 kk = kp[i], qq = qp[i];
                    Sx[4 * i] = eg * Sx[4 * i] + kk.x * dlt; Sx[4 * i + 1] = eg * Sx[4 * i + 1] + kk.y * dlt; Sx[4 * i + 2] = eg * Sx[4 * i + 2] + kk.z * dlt; Sx[4 * i + 3] = eg * Sx[4 * i + 3] + kk.w * dlt;
                    o += (qq.x * Sx[4 * i] + qq.y * Sx[4 * i + 1]) + (qq.z * Sx[4 * i + 2] + qq.w * Sx[4 * i + 3]); }
                asm volatile("" ::: "memory");
            }
            W_ORAW[m * 512 + h * 128 + dv] = o;
        }
    }
}
__device__ __forceinline__ void ph_gdn_out(Frame& F, const Args& A) {
    const int gw = F.vcu * NWAVES + F.wave, NGW = F.G * NWAVES;
    const bf16* GA = W_PROJ + (size_t)3 * M * 512;
    for (int it = gw; it < M * 4; it += NGW) {
        const int m = it >> 2, h = it & 3;
        const size_t o0 = (size_t)m * 512 + h * 128 + F.lane;
        const float a = W_ORAW[o0], b = W_ORAW[o0 + 64];
        const float s = wave_sum(a * a + b * b);
        const float r = rsqrtf(s * (1.f / 128.f) + EPS);
        W_MIXO[(size_t)m * D + h * 128 + F.lane] = (bf16)f2bf(a * r * A_onorm_g[F.lane] * siluf(bf2f(GA[o0])));
        W_MIXO[(size_t)m * D + h * 128 + F.lane + 64] = (bf16)f2bf(b * r * A_onorm_g[F.lane + 64] * siluf(bf2f(GA[o0 + 64])));
    }
}
__device__ __forceinline__ void ph_swa_naive(Frame& F, const Args& A, int gw, int NGW) {
    LAS float* sc = (LAS float*)(F.lds + RING_OFF + 4096 + F.wave * 2048);
    LAS float* qs = sc + 3 * 132;
    const bf16* QB = W_PROJ + (size_t)4 * M * 512; const bf16* KB = W_PROJ + (size_t)5 * M * 512; const bf16* VB = W_PROJ + (size_t)6 * M * 512;
    for (int it = gw; it < M * 8; it += NGW) {
        const int m = it >> 3, h = it & 7, t = m & (SEQ - 1), lane = F.lane;
        asm volatile("s_waitcnt lgkmcnt(0)" ::: "memory");
        qs[lane] = bf2f(QB[(size_t)m * 512 + h * 64 + lane]);
        asm volatile("s_waitcnt lgkmcnt(0)" ::: "memory");
        float mx = -INFINITY;
        for (int p = 0; p < 3; ++p) {
            const int dil = p == 0 ? 1 : (p == 1 ? 4 : 16);
            for (int j = lane; j < 129; j += 64) {
                const int tk = t - j * dil;
                float s = -INFINITY;
                if (tk >= 0) {
                    const bf16* kr = KB + (size_t)(m - j * dil) * 512 + h * 64;
                    float a = 0.f;
                    for (int d = 0; d < 64; ++d) a += qs[d] * bf2f(kr[d]);
                    s = a * 0.125f + A_rel_bias[c_bkt[p][j] * 8 + h];
                }
                sc[p * 132 + j] = s; mx = fmaxf(mx, s);
            }
        }
#pragma unroll
        for (int o = 1; o < 64; o <<= 1) mx = fmaxf(mx, __shfl_xor(mx, o));
        asm volatile("s_waitcnt lgkmcnt(0)" ::: "memory");
        float sum = 0.f;
        for (int p = 0; p < 3; ++p)
            for (int j = lane; j < 129; j += 64) { const float sv = sc[p * 132 + j]; const float e = (sv == -INFINITY) ? 0.f : __expf(sv - mx); sc[p * 132 + j] = e; sum += e; }
        sum = wave_sum(sum);
        asm volatile("s_waitcnt lgkmcnt(0)" ::: "memory");
        float acc = 0.f;
        for (int p = 0; p < 3; ++p) {
            const int dil = p == 0 ? 1 : (p == 1 ? 4 : 16);
            for (int j = 0; j < 129; ++j) {
                const int tk = t - j * dil; if (tk < 0) break;
                acc += sc[p * 132 + j] * bf2f(VB[(size_t)(m - j * dil) * 512 + h * 64 + lane]);
            }
        }
        W_MIXO[(size_t)m * D + 512 + h * 64 + lane] = (bf16)f2bf(acc / sum);
    }
}

typedef short s16x4 __attribute__((ext_vector_type(4)));
constexpr int SWA_TASKS = 64 * 48;
constexpr int SWA_KOFF = 0, SWA_VOFF = 49152, SWA_TB = 98304;
__device__ __forceinline__ s16x4 lds_tr16(unsigned addr) { return __builtin_bit_cast(s16x4, __builtin_amdgcn_ds_read_tr16_b64_v4i16((LAS s16x4*)(uintptr_t)addr)); }
__device__ __forceinline__ void swa_task(Frame& F, const Args& A, int tk) {
    const int bh = tk / 48, rem = tk % 48, p = rem >> 4, idx = rem & 15;
    const int b = bh >> 3, h = bh & 7;
    const int dil = p == 0 ? 1 : (p == 1 ? 4 : 16), nblk = 16 / dil, r = idx / nblk, m0 = 256 * (idx % nblk);
    const bf16* QB = W_PROJ + (size_t)4 * M * 512; const bf16* KB = W_PROJ + (size_t)5 * M * 512; const bf16* VB = W_PROJ + (size_t)6 * M * 512;
    bf16* OP = (bf16*)(F.ws + (p == 0 ? WS_SO1 : (p == 1 ? WS_SO2 : WS_SO3)));
    float* LSE = (float*)(F.ws + WS_LSE) + (size_t)p * M * 8;
    const size_t rowb = (size_t)b * SEQ;
    LAS unsigned char* lds = F.lds + RING_OFF;
    {
        v4u tmp[12];
#pragma unroll
        for (int i = 0; i < 12; ++i) {
            const int e = F.tid + 512 * i, which = e / 3072, rm = e % 3072, row = rm >> 3, c = rm & 7;
            int sp = m0 - 128 + row; sp = sp < 0 ? 0 : sp;
            const bf16* src = (which ? VB : KB) + (rowb + (size_t)sp * dil + r) * 512 + h * 64 + c * 8;
            tmp[i] = *(const GAS v4u*)src;
        }
#pragma unroll
        for (int i = 0; i < 12; ++i) {
            const int e = F.tid + 512 * i, which = e / 3072, rm = e % 3072, row = rm >> 3, c = rm & 7;
            *(LAS v4u*)(lds + which * SWA_VOFF + row * 128 + ((c ^ (row & 7)) << 4)) = tmp[i];
        }
        if (F.tid < 129) ((LAS float*)(lds + SWA_TB))[F.tid] = A_rel_bias[c_bkt[p][F.tid] * 8 + h];
    }
    __syncthreads();
    const int lane = F.lane, q = lane & 15, g = lane >> 4;
    const LAS float* tb = (const LAS float*)(lds + SWA_TB);
#pragma unroll 1
    for (int qi = 0; qi < 2; ++qi) {
        const int qt = F.wave * 2 + qi;
        const size_t qtok = rowb + (size_t)(m0 + 16 * qt + q) * dil + r;
        const bf16x8 qf0 = *(const GAS bf16x8*)(QB + qtok * 512 + h * 64 + 8 * g);
        const bf16x8 qf1 = *(const GAS bf16x8*)(QB + qtok * 512 + h * 64 + 32 + 8 * g);
        float sc[9][4];
        float mx = -INFINITY;
#pragma unroll
        for (int jt = 0; jt < 9; ++jt) {
            const int kt = qt + jt, krow = 16 * kt + q;
            const bf16x8 kf0 = *(const LAS bf16x8*)(lds + SWA_KOFF + krow * 128 + (((g) ^ (krow & 7)) << 4));
            const bf16x8 kf1 = *(const LAS bf16x8*)(lds + SWA_KOFF + krow * 128 + (((g + 4) ^ (krow & 7)) << 4));
            f32x4 acc = {0.f, 0.f, 0.f, 0.f};
            acc = __builtin_amdgcn_mfma_f32_16x16x32_bf16(kf0, qf0, acc, 0, 0, 0);
            acc = __builtin_amdgcn_mfma_f32_16x16x32_bf16(kf1, qf1, acc, 0, 0, 0);
#pragma unroll
            for (int e = 0; e < 4; ++e) {
                const int kx = 4 * g + e, rel = 128 - 16 * jt + q - kx, spk = m0 - 128 + 16 * kt + kx;
                const bool valid = (rel >= 0) && (rel <= 128) && (spk >= 0);
                const int relc = rel < 0 ? 0 : (rel > 128 ? 128 : rel);
                const float v = acc[e] * 0.125f + tb[relc];
                sc[jt][e] = valid ? v : -INFINITY;
                mx = fmaxf(mx, sc[jt][e]);
            }
        }
        mx = fmaxf(mx, __shfl_xor(mx, 16)); mx = fmaxf(mx, __shfl_xor(mx, 32));
        float l = 0.f;
#pragma unroll
        for (int jt = 0; jt < 9; ++jt)
#pragma unroll
            for (int e = 0; e < 4; ++e) { sc[jt][e] = __expf(sc[jt][e] - mx); l += sc[jt][e]; }
        l += __shfl_xor(l, 16); l += __shfl_xor(l, 32);
        bf16x8 pf[5];
#pragma unroll
        for (int s2 = 0; s2 < 5; ++s2) {
            v4u w;
            w.x = pk2(sc[2 * s2][0], sc[2 * s2][1]); w.y = pk2(sc[2 * s2][2], sc[2 * s2][3]);
            if (s2 < 4) { w.z = pk2(sc[2 * s2 + 1][0], sc[2 * s2 + 1][1]); w.w = pk2(sc[2 * s2 + 1][2], sc[2 * s2 + 1][3]); } else { w.z = 0u; w.w = 0u; }
            pf[s2] = __builtin_bit_cast(bf16x8, w);
        }
        const float rl = 1.0f / l;
        const unsigned vbase = (unsigned)(uintptr_t)(lds + SWA_VOFF);
#pragma unroll
        for (int mt = 0; mt < 4; ++mt) {
            f32x4 o = {0.f, 0.f, 0.f, 0.f};
#pragma unroll
            for (int s2 = 0; s2 < 5; ++s2) {
                const int row0 = 16 * (qt + 2 * s2) + 4 * g + (q >> 2), c = 2 * mt + ((q & 3) >> 1);
                const s16x4 lo = lds_tr16(vbase + row0 * 128 + ((c ^ (row0 & 7)) << 4) + 8 * (q & 1));
                s16x4 hi = {0, 0, 0, 0};
                if (s2 < 4) { const int row1 = row0 + 16; hi = lds_tr16(vbase + row1 * 128 + ((c ^ (row1 & 7)) << 4) + 8 * (q & 1)); }
                const bf16x8 vf = {lo[0], lo[1], lo[2], lo[3], hi[0], hi[1], hi[2], hi[3]};
                o = __builtin_amdgcn_mfma_f32_16x16x32_bf16(vf, pf[s2], o, 0, 0, 0);
            }
            unsigned long long w = (unsigned long long)pk2(o[0] * rl, o[1] * rl) | ((unsigned long long)pk2(o[2] * rl, o[3] * rl) << 32);
            *(GAS unsigned long long*)(OP + qtok * 512 + h * 64 + 16 * mt + 4 * g) = w;
        }
        if (g == 0) LSE[qtok * 8 + h] = mx + __logf(l);
    }
    __syncthreads();
}
__device__ __forceinline__ void ph_swa(Frame& F, const Args& A, int widx, int nw) {
    const int lo = (int)(((long)widx * SWA_TASKS) / nw), hi = (int)(((long)(widx + 1) * SWA_TASKS) / nw);
    for (int tk = lo; tk < hi; ++tk) swa_task(F, A, tk);
}
__device__ __forceinline__ void ph_swa_merge(Frame& F) {
    const int gw = F.vcu * NWAVES + F.wave, NGW = F.G * NWAVES;
    const float* LSE = (const float*)(F.ws + WS_LSE);
    const bf16* O1 = (const bf16*)(F.ws + WS_SO1); const bf16* O2 = (const bf16*)(F.ws + WS_SO2); const bf16* O3 = (const bf16*)(F.ws + WS_SO3);
    for (int it = gw; it < M * 8; it += NGW) {
        const int m = it >> 3, h = it & 7;
        const float l1 = LSE[(size_t)m * 8 + h], l2 = LSE[(size_t)M * 8 + (size_t)m * 8 + h], l3 = LSE[(size_t)2 * M * 8 + (size_t)m * 8 + h];
        const float mx = fmaxf(l1, fmaxf(l2, l3));
        const float w1 = __expf(l1 - mx), w2 = __expf(l2 - mx), w3 = __expf(l3 - mx);
        const size_t o = (size_t)m * 512 + h * 64 + F.lane;
        const float v = (w1 * bf2f(O1[o]) + w2 * bf2f(O2[o]) + w3 * bf2f(O3[o])) / (w1 + w2 + w3);
        W_MIXO[(size_t)m * D + 512 + h * 64 + F.lane] = (bf16)f2bf(v);
    }
}
__device__ __forceinline__ void ph_norm_res(Frame& F, const float* y, const float* g1, const float* base, float* out, const float* g2, bf16* hn) {
    const int gw = F.vcu * NWAVES + F.wave, NGW = F.G * NWAVES;
    for (int m = gw; m < M; m += NGW) {
        const GAS f32x4* yr = (const GAS f32x4*)(y + (size_t)m * D) + F.lane;
        const GAS f32x4* br = (const GAS f32x4*)(base + (size_t)m * D) + F.lane;
        GAS f32x4* orow = (GAS f32x4*)(out + (size_t)m * D) + F.lane;
        f32x4 v[4]; float s = 0.f;
#pragma unroll
        for (int j = 0; j < 4; ++j) { v[j] = yr[64 * j]; s += (v[j].x * v[j].x + v[j].y * v[j].y) + (v[j].z * v[j].z + v[j].w * v[j].w); }
        const float r = rsqrtf(wave_sum(s) * (1.f / D) + EPS);
        float s2 = 0.f;
#pragma unroll
        for (int j = 0; j < 4; ++j) { const f32x4 g = ((const GAS f32x4*)g1)[F.lane + 64 * j]; v[j] = br[64 * j] + v[j] * r * g; orow[64 * j] = v[j];
            s2 += (v[j].x * v[j].x + v[j].y * v[j].y) + (v[j].z * v[j].z + v[j].w * v[j].w); }
        if (hn) {
            const float r2 = rsqrtf(wave_sum(s2) * (1.f / D) + EPS);
            GAS unsigned long long* o8 = (GAS unsigned long long*)(hn + (size_t)m * D) + F.lane;
#pragma unroll
            for (int j = 0; j < 4; ++j) { const f32x4 g = ((const GAS f32x4*)g2)[F.lane + 64 * j]; const f32x4 w = v[j] * r2 * g;
                o8[64 * j] = (unsigned long long)pk2(w.x, w.y) | ((unsigned long long)pk2(w.z, w.w) << 32); }
        }
    }
}

constexpr int N_PHASES = 10;
#ifndef MK_PER_PHASE
#define MK_PER_PHASE 0
#endif
__global__ void __launch_bounds__(NWAVES * 64, 2) mk_fwd(Args args) {
    extern __shared__ __attribute__((aligned(16))) unsigned char lds[];
    Frame F;
    F.lds = (LAS unsigned char*)lds;
    F.MISC = (volatile LAS unsigned*)(F.lds + MISC_OFF);
    F.tid = threadIdx.x; F.lane = F.tid & 63; F.wave = __builtin_amdgcn_readfirstlane(F.tid >> 6);
    F.G = gridDim.x; { const int bx = blockIdx.x; F.vcu = (F.G % 8 == 0) ? (bx % 8) * (F.G / 8) + bx / 8 : bx; }
    unsigned char* ws = args.ws;
    F.ctl = (gu32*)(ws + WS_CTL);
    F.ws = ws; const Args& A = args;
    for (int u = F.tid; u < (LDS_BYTES - LDSCTL_OFF) / 4; u += NWAVES * 64) ((LAS unsigned*)(F.lds + LDSCTL_OFF))[u] = 0u;
    __syncthreads();
    XcdBarrier bar; bar.bar = (unsigned*)(F.ctl + CW_BAR); bar.x = 0; bar.st = nullptr;
    if (!MK_PER_PHASE) bar = xcd_barrier_post((unsigned*)(F.ctl + CW_BAR), F.MISC + 8);
    const int lo = args.ph_lo, hi = args.ph_hi;
#ifndef PHMASK
#define PHMASK 0xFFFF
#endif
#define IN(k) (((PHMASK >> (k)) & 1) && lo <= (k) && (k) < hi)
#define SEAM(k) do { if (IN(k) && IN((k) + 1)) xcd_barrier(bar); } while (0)

    if (IN(0)) { ph_prologue(F, args); } SEAM(0);
    if (IN(1)) {
        pg8::Gemm g{W_XN, W_WIN, M, NIN, D}; pg8::StaticOrder S; S.init(M, NIN, F.G, (int)blockIdx.x);
        pg8::EpiBf16<0> E{W_PROJ, 512, nullptr, 512, (size_t)M * 512, 1.f};
        pg8::gemm_phase<pg8::EpiBf16<0>, pg8::StaticOrder, true, true>(F.lds + RING_OFF, g, S, E);
    } SEAM(1);
    if (IN(2)) { ph_gdn_prep(F, args); } SEAM(2);
    if (IN(3)) {
        if (blockIdx.x < 32) ph_gdn_seq(F, args, (int)blockIdx.x);
        else ph_swa(F, args, (int)blockIdx.x - 32, F.G - 32);
    } SEAM(3);
    if (IN(4)) { ph_gdn_out(F, args); ph_swa_merge(F); } SEAM(4);
    if (IN(5)) {
        pg8::Gemm g{W_MIXO, W_WO, M, D, D}; pg8::StaticOrder S; S.init(M, D, F.G, (int)blockIdx.x);
        pg8::EpiF32 E{W_Y, D};
        pg8::gemm_phase<pg8::EpiF32, pg8::StaticOrder, true, true>(F.lds + RING_OFF, g, S, E);
    } SEAM(5);
    if (IN(6)) { ph_norm_res(F, W_Y, A_g_mix_post, A_x, A.out, A_g_ffn_pre, W_XN2); } SEAM(6);
    if (IN(7)) {
        pg8::Gemm g{W_XN2, W_WGU, M, NGU, D}; pg8::StaticOrder S; S.init(M, NGU, F.G, (int)blockIdx.x);
        pg8::EpiSwiGLU E{W_HID, DFF};
        pg8::gemm_phase<pg8::EpiSwiGLU, pg8::StaticOrder, true, true>(F.lds + RING_OFF, g, S, E);
    } SEAM(7);
    if (IN(8)) {
        pg8::Gemm g{W_HID, W_WD, M, D, DFF}; pg8::StaticOrder S; S.init(M, D, F.G, (int)blockIdx.x);
        pg8::EpiF32 E{W_Y, D};
        pg8::gemm_phase<pg8::EpiF32, pg8::StaticOrder, true, true>(F.lds + RING_OFF, g, S, E);
    } SEAM(8);
    if (IN(9)) { ph_norm_res(F, W_Y, A_g_ffn_post, A.out, A.out, nullptr, nullptr); }
#undef IN
#undef SEAM
}

extern "C" void kernel_launch(void* const* d_in, const int* in_sizes, int n_in, void* d_out, int out_size, void* d_ws, size_t ws_size, hipStream_t stream) {
    static int grid = 0;
    if (grid == 0) {
        if (n_in != 15 || in_sizes[0] != M * D || out_size != M * D || ws_size < WS_END) {
            fprintf(stderr, "kernel_launch: unexpected shapes/workspace: n_in %d in0 %d out %d ws %zu (need %zu); nothing launched\n", n_in, n_in > 0 ? in_sizes[0] : -1, out_size, ws_size, (size_t)WS_END); grid = -1; return; }
        int dev = 0, cus = 0, per_cu = 0;
        if (hipGetDevice(&dev) != hipSuccess || hipDeviceGetAttribute(&cus, hipDeviceAttributeMultiprocessorCount, dev) != hipSuccess) { fprintf(stderr, "kernel_launch: device query failed\n"); grid = -1; return; }
        if (hipFuncSetAttribute((const void*)mk_fwd, hipFuncAttributeMaxDynamicSharedMemorySize, LDS_BYTES) != hipSuccess) { fprintf(stderr, "kernel_launch: hipFuncSetAttribute failed\n"); grid = -1; return; }
        if (hipOccupancyMaxActiveBlocksPerMultiprocessor(&per_cu, (const void*)mk_fwd, NWAVES * 64, LDS_BYTES) != hipSuccess || per_cu < 1) {
            fprintf(stderr, "kernel_launch: occupancy query reports %d workgroups per CU; nothing launched\n", per_cu); (void)hipGetLastError(); grid = -1; return; }
        (void)hipGetLastError();
        grid = cus;
    }
    if (grid < 0) return;
    if (hipMemsetAsync((char*)d_ws + WS_CTL, 0, CTL_ZERO_BYTES, stream) != hipSuccess) { fprintf(stderr, "kernel_launch: memset failed\n"); return; }
    Args a{};
    for (int i = 0; i < 15; ++i) a.in[i] = (const float*)d_in[i];
    a.out = (float*)d_out; a.ws = (unsigned char*)d_ws;
#if MK_PER_PHASE
    for (int p = 0; p < N_PHASES; ++p) { a.ph_lo = p; a.ph_hi = p + 1; hipLaunchKernelGGL(mk_fwd, dim3(grid), dim3(NWAVES * 64), LDS_BYTES, stream, a); }
#else
    a.ph_lo = 0; a.ph_hi = N_PHASES;
    hipLaunchKernelGGL(mk_fwd, dim3(grid), dim3(NWAVES * 64), LDS_BYTES, stream, a);
#endif
    const hipError_t le = hipPeekAtLastError();
    if (le != hipSuccess) fprintf(stderr, "kernel_launch: launch failed: %s\n", hipGetErrorName(le));
}
```

```cpp
#include <hip/hip_runtime.h>
#include <cstdio>
#include <cstdint>
#include <cmath>
namespace pg8 {
#define PG8_LAS __attribute__((address_space(3)))
typedef unsigned short bf16_t;
typedef short bf16x8 __attribute__((ext_vector_type(8)));
typedef float f32x4 __attribute__((ext_vector_type(4)));
typedef unsigned u32x4 __attribute__((ext_vector_type(4)));
constexpr int BM = 256, BK = 64, HALF = 128, HTB = HALF * BK * 2  , STAGE_BYTES = 8 * HTB, NXCD = 8, WGM = 8;

__host__ __device__ __forceinline__ int lds_byte(int r, int c) { const int st = (r >> 4) * 2 + (c >> 5), rr = r & 15, cc = c & 31, ob = rr * 64 + cc * 2; return st * 1024 + (ob ^ (((ob >> 9) & 1) << 5)); }
__host__ __device__ __forceinline__ void stage_rc(int b, int& R, int& C) { const int st = b / 1024, sb = b % 1024, swz = sb ^ (((sb >> 9) & 1) << 5); R = (st >> 1) * 16 + swz / 64; C = (st & 1) * 32 + (swz % 64) / 2; }
__host__ __device__ __forceinline__ int perm32(int rho) { const int n = rho >> 4, i = rho & 15; return 8 * (i >> 2) + 4 * n + (i & 3); }

struct Unit { int pm, pn; };
struct Gemm { const bf16_t* A; const bf16_t* Bt; int M, N, K; };

struct StaticOrder {
    int nM, nN, nwg, G, c;
    __host__ __device__ void init(int M, int N, int G_, int c_) { nM = M / BM; nN = N / BM; nwg = nM * nN; G = G_; c = c_; }
    __host__ __device__ bool next(int i, Unit& u) const {
        const long L = (long)i * G + c; if (L >= nwg) return false;
        int wgid = (int)L; { const int q = nwg / NXCD, r = nwg % NXCD, xcd = wgid % NXCD, off = wgid / NXCD; wgid = (xcd < r ? xcd * (q + 1) : r * (q + 1) + (xcd - r) * q) + off; }
        const int nig = WGM * nN, gid = wgid / nig, fm = gid * WGM, gsz = (nM - fm) < WGM ? (nM - fm) : WGM;
        u.pm = fm + ((wgid % nig) % gsz); u.pn = (wgid % nig) / gsz; return true;
    }
    __device__ __forceinline__ void a_ready(const Unit&) const {}
    __device__ __forceinline__ void done(const Unit&) const {}
};

__device__ __forceinline__ unsigned cvt_pk_bf16(float lo, float hi) { unsigned r; asm volatile("v_cvt_pk_bf16_f32 %0, %1, %2" : "=v"(r) : "v"(lo), "v"(hi)); return r; }
typedef float f32x2 __attribute__((ext_vector_type(2)));
__device__ __forceinline__ f32x2 gelu_pk(f32x2 v) {
    const f32x2 av = __builtin_elementwise_abs(v), d = av * 0.2316418882f + 1.0f;
    f32x2 t; t.x = __builtin_amdgcn_rcpf(d.x); t.y = __builtin_amdgcn_rcpf(d.y);
    f32x2 q = t * 0.5307027145f + (-0.7265760135f); q = q * t + 0.7107068705f; q = q * t + (-0.142248368f); q = q * t + 0.127414796f; q = q * t;
    const f32x2 s = (v * v) * (-0.72134752044f);
    f32x2 e; e.x = __builtin_amdgcn_exp2f(s.x); e.y = __builtin_amdgcn_exp2f(s.y);
    const f32x2 m = v * (q * e), r = v - m;
    f32x2 o; o.x = v.x < 0.f ? m.x : r.x; o.y = v.y < 0.f ? m.y : r.y; return o;
}

template <int ACT  > struct EpiBf16 {
    static constexpr bool PERM = true, AFTER_DRAIN = false; static_assert(ACT == 0 || ACT == 1, "EpiBf16: ACT is 0 (none) or 1 (gelu_pk)");
    bf16_t* O; int ldc; const float* bias; int split_cols; size_t split_stride; float scale0;
    __device__ __forceinline__ void operator()(const f32x4 (&acc)[2][2][4][2], const Unit& u, int wr, int wc, int fr, int fq) const {
        const int row0 = u.pm * BM + wr * 64 + fr; int colt = u.pn * BM; bf16_t* base = O;
        float sc = 1.f; if (split_cols) { const int t = colt / split_cols; base += (size_t)t * split_stride; colt -= t * split_cols; if (t == 0) sc = scale0; }
        const int col0 = colt + wc * 32 + 8 * fq, bcol0 = u.pn * BM + wc * 32 + 8 * fq;
        f32x4 bv[2][2];
#pragma unroll
        for (int bj = 0; bj < 2; ++bj)
#pragma unroll
            for (int n = 0; n < 2; ++n) bv[bj][n] = bias ? *(const f32x4*)(bias + bcol0 + bj * HALF + 4 * n) : (f32x4){0.f, 0.f, 0.f, 0.f};
#pragma unroll
        for (int ai = 0; ai < 2; ++ai)
#pragma unroll
            for (int m = 0; m < 4; ++m) { bf16_t* rowp = base + (size_t)(row0 + ai * HALF + m * 16) * ldc + col0;
#pragma unroll
                for (int bj = 0; bj < 2; ++bj) { f32x4 v0 = acc[ai][bj][m][0] + bv[bj][0], v1 = acc[ai][bj][m][1] + bv[bj][1];
                    if (ACT == 1) { f32x2 a = gelu_pk((f32x2){v0[0], v0[1]}), b = gelu_pk((f32x2){v0[2], v0[3]}), c = gelu_pk((f32x2){v1[0], v1[1]}), d = gelu_pk((f32x2){v1[2], v1[3]});
                        v0 = (f32x4){a.x, a.y, b.x, b.y}; v1 = (f32x4){c.x, c.y, d.x, d.y}; }
                    v0 = v0 * sc; v1 = v1 * sc; u32x4 w; w.x = cvt_pk_bf16(v0[0], v0[1]); w.y = cvt_pk_bf16(v0[2], v0[3]); w.z = cvt_pk_bf16(v1[0], v1[1]); w.w = cvt_pk_bf16(v1[2], v1[3]);
                    *(u32x4*)(rowp + bj * HALF) = w; } }
    }
};

struct PanelStats {
    unsigned* xbuf;
    unsigned* cnt;
    unsigned* tmo;
    int ntn; float eps;
    unsigned code;
    __device__ __forceinline__ bool run(const f32x4 (&v)[2][2][4][2], const Unit& u, int wr, int wc, int fr, int fq, PG8_LAS unsigned char* lds, int wid, int lane) const {
        typedef float f32x2v __attribute__((ext_vector_type(2)));
        PG8_LAS f32x2v* P = (PG8_LAS f32x2v*)lds;
        PG8_LAS f32x2v* S = (PG8_LAS f32x2v*)(lds + 8192);
        PG8_LAS unsigned* flag = (PG8_LAS unsigned*)(lds + 8192 + 2048);
#pragma unroll
        for (int ai = 0; ai < 2; ++ai)
#pragma unroll
            for (int m = 0; m < 4; ++m) {
                float s = 0.f;
#pragma unroll
                for (int bj = 0; bj < 2; ++bj)
#pragma unroll
                    for (int n = 0; n < 2; ++n) { const f32x4 x = v[ai][bj][m][n]; s += (x[0] + x[1]) + (x[2] + x[3]); }
                s += __shfl_xor(s, 16); s += __shfl_xor(s, 32);
                const float mw = s * (1.0f / 64.0f); float q = 0.f;
#pragma unroll
                for (int bj = 0; bj < 2; ++bj)
#pragma unroll
                    for (int n = 0; n < 2; ++n) { const f32x4 d = v[ai][bj][m][n] - mw; q += (d[0] * d[0] + d[1] * d[1]) + (d[2] * d[2] + d[3] * d[3]); }
                q += __shfl_xor(q, 16); q += __shfl_xor(q, 32);
                if (fq == 0) P[(ai * HALF + wr * 64 + m * 16 + fr) * 4 + wc] = (f32x2v){mw, q};
            }
        asm volatile("s_waitcnt lgkmcnt(0)" ::: "memory"); __builtin_amdgcn_s_barrier(); asm volatile("" ::: "memory");
#if defined(BROKEN_EXCHANGE_NO_WAIT)
#warning BROKEN CONTROL BUILD: the row-statistics exchange does not wait; results are wrong by design
        if (blockIdx.x >= 64) { const long long t0_ = clock64(); while (clock64() - t0_ < 60000) __builtin_amdgcn_s_sleep(8); }
#endif
        const int row = wid * 32 + (lane & 31);
        if (lane < 32) {
            const f32x2v a = P[row * 4 + 0], b = P[row * 4 + 1], c = P[row * 4 + 2], d = P[row * 4 + 3];
            const float mt = (a.x + b.x + c.x + d.x) * 0.25f;
            const float da = a.x - mt, db = b.x - mt, dc = c.x - mt, dd = d.x - mt;
            const float m2 = (a.y + b.y) + (c.y + d.y) + 64.0f * ((da * da + db * db) + (dc * dc + dd * dd));
            unsigned long long* slot = (unsigned long long*)xbuf + ((size_t)(u.pm * BM + row) * 4 + u.pn);
            __hip_atomic_store(slot, ((unsigned long long)__float_as_uint(m2) << 32) | __float_as_uint(mt), __ATOMIC_RELAXED, __HIP_MEMORY_SCOPE_AGENT);
        }
        asm volatile("s_waitcnt vmcnt(0)" ::: "memory");
        if (lane == 0) __hip_atomic_fetch_add(cnt + 64 * u.pm, 1u, __ATOMIC_RELAXED, __HIP_MEMORY_SCOPE_AGENT);
        if (wid == 0) {
            bool dead = false; const unsigned long long t0 = __builtin_amdgcn_s_memrealtime(); const unsigned want = 8u * (unsigned)ntn;
            for (;;) {
#if defined(BROKEN_EXCHANGE_NO_WAIT)
                break;
#endif
                if ((unsigned)__builtin_amdgcn_readfirstlane(__hip_atomic_load(cnt + 64 * u.pm, __ATOMIC_RELAXED, __HIP_MEMORY_SCOPE_AGENT)) >= want) break;
                if (__builtin_amdgcn_s_memrealtime() - t0 > 2000000ull) {
                    if (lane == 0) { unsigned expect = 0u; __hip_atomic_compare_exchange_strong(tmo + 1, &expect, code | (unsigned)(u.pm & 0xff), __ATOMIC_RELAXED, __ATOMIC_RELAXED, __HIP_MEMORY_SCOPE_AGENT);
                                     __hip_atomic_store(tmo, 1u, __ATOMIC_RELAXED, __HIP_MEMORY_SCOPE_AGENT); }
                    dead = true; break; }
                __builtin_amdgcn_s_sleep(2);
            }
            __builtin_amdgcn_fence(__ATOMIC_ACQUIRE, "agent");
            if (lane == 0) flag[0] = dead ? 1u : 0u;
        }
        asm volatile("s_waitcnt vmcnt(0) lgkmcnt(0)" ::: "memory"); __builtin_amdgcn_s_barrier(); asm volatile("" ::: "memory");
        const bool bad = flag[0] != 0u;
        if (lane < 32) {
            const unsigned long long* slot = (const unsigned long long*)xbuf + (size_t)(u.pm * BM + row) * 4; float mt[4], m2[4]; float ms = 0.f;
#pragma unroll
            for (int t = 0; t < 4; ++t) { if (t < ntn) { const unsigned long long w = __hip_atomic_load(slot + t, __ATOMIC_RELAXED, __HIP_MEMORY_SCOPE_AGENT); mt[t] = __uint_as_float((unsigned)w); m2[t] = __uint_as_float((unsigned)(w >> 32)); } else { mt[t] = 0.f; m2[t] = 0.f; } ms += mt[t]; }
            const float mean = ms / (float)ntn; float q = 0.f;
#pragma unroll
            for (int t = 0; t < 4; ++t) if (t < ntn) { const float dm = mt[t] - mean; q += m2[t] + 256.0f * dm * dm; }
            S[row] = (f32x2v){mean, 1.0f / sqrtf(q / (256.0f * (float)ntn) + eps)};
        }
        asm volatile("s_waitcnt lgkmcnt(0)" ::: "memory"); __builtin_amdgcn_s_barrier(); asm volatile("" ::: "memory");
        return bad;
    }
};
struct EpiLnRes {
    static constexpr bool PERM = false, AFTER_DRAIN = true;
    const float* base; float* out; int ldc; const float* bias; PanelStats st; unsigned poison;
    __device__ __forceinline__ void fused(f32x4 (&acc)[2][2][4][2], const Unit& u, int wr, int wc, int fr, int fq, PG8_LAS unsigned char* lds, int wid, int lane) const {
        typedef float f32x2v __attribute__((ext_vector_type(2)));
        const PG8_LAS f32x2v* S = (const PG8_LAS f32x2v*)(lds + 8192);
        const int col0 = u.pn * BM + wc * 32 + 4 * fq;
#pragma unroll
        for (int bj = 0; bj < 2; ++bj)
#pragma unroll
            for (int n = 0; n < 2; ++n) { const f32x4 bv = bias ? *(const f32x4*)(bias + col0 + bj * HALF + n * 16) : (f32x4){0.f, 0.f, 0.f, 0.f};
#pragma unroll
                for (int ai = 0; ai < 2; ++ai)
#pragma unroll
                    for (int m = 0; m < 4; ++m) acc[ai][bj][m][n] += bv; }
        f32x4 pre[4][2][2];
#pragma unroll
        for (int m = 0; m < 4; ++m) { const size_t off = (size_t)(u.pm * BM + wr * 64 + m * 16 + fr) * ldc + col0;
#pragma unroll
            for (int bj = 0; bj < 2; ++bj)
#pragma unroll
                for (int n = 0; n < 2; ++n) pre[m][bj][n] = *(const f32x4*)(base + off + bj * HALF + n * 16); }
        const bool bad = st.run(acc, u, wr, wc, fr, fq, lds, wid, lane) || poison != 0u;
        const float qnan = __builtin_nanf("");
#pragma unroll
        for (int ai = 0; ai < 2; ++ai)
#pragma unroll
            for (int m = 0; m < 4; ++m) { const int r = ai * HALF + wr * 64 + m * 16 + fr; const f32x2v sr = S[r]; const size_t off = (size_t)(u.pm * BM + r) * ldc + col0;
#pragma unroll
                for (int bj = 0; bj < 2; ++bj)
#pragma unroll
                    for (int n = 0; n < 2; ++n) { const f32x4 bs = ai == 0 ? pre[m][bj][n] : *(const f32x4*)(base + off + bj * HALF + n * 16); f32x4 o = bs + (acc[ai][bj][m][n] - sr.x) * sr.y;
                        if (bad) o = (f32x4){qnan, qnan, qnan, qnan}; *(f32x4*)(out + off + bj * HALF + n * 16) = o; }
                if (m & 1) asm volatile("" ::: "memory"); }
    }
};
struct EpiLnResLn {
    static constexpr bool PERM = false, AFTER_DRAIN = true;
    const float* base; float* out; bf16_t* xn; int ldc; const float* bias; PanelStats st1, st2; unsigned poison;
    __device__ __forceinline__ void fused(f32x4 (&acc)[2][2][4][2], const Unit& u, int wr, int wc, int fr, int fq, PG8_LAS unsigned char* lds, int wid, int lane) const {
        typedef float f32x2v __attribute__((ext_vector_type(2))); typedef unsigned u32x2v __attribute__((ext_vector_type(2)));
        const PG8_LAS f32x2v* S = (const PG8_LAS f32x2v*)(lds + 8192);
        const int col0 = u.pn * BM + wc * 32 + 4 * fq;
#pragma unroll
        for (int bj = 0; bj < 2; ++bj)
#pragma unroll
            for (int n = 0; n < 2; ++n) { const f32x4 bv = bias ? *(const f32x4*)(bias + col0 + bj * HALF + n * 16) : (f32x4){0.f, 0.f, 0.f, 0.f};
#pragma unroll
                for (int ai = 0; ai < 2; ++ai)
#pragma unroll
                    for (int m = 0; m < 4; ++m) acc[ai][bj][m][n] += bv; }
        bool bad = st1.run(acc, u, wr, wc, fr, fq, lds, wid, lane) || poison != 0u;
        const float qnan = __builtin_nanf("");
#pragma unroll
        for (int ai = 0; ai < 2; ++ai)
#pragma unroll
            for (int m = 0; m < 4; ++m) { const int r = ai * HALF + wr * 64 + m * 16 + fr; const f32x2v sr = S[r]; const size_t off = (size_t)(u.pm * BM + r) * ldc + col0;
#pragma unroll
                for (int bj = 0; bj < 2; ++bj)
#pragma unroll
                    for (int n = 0; n < 2; ++n) { const f32x4 bs = *(const f32x4*)(base + off + bj * HALF + n * 16); acc[ai][bj][m][n] = bs + (acc[ai][bj][m][n] - sr.x) * sr.y; }
                asm volatile("" : "+v"(acc[ai][0][m][0]), "+v"(acc[ai][0][m][1]), "+v"(acc[ai][1][m][0]), "+v"(acc[ai][1][m][1]));
                if (m & 1) asm volatile("" ::: "memory"); }
        const bool bad1 = bad;
        bad = st2.run(acc, u, wr, wc, fr, fq, lds, wid, lane) || bad;
#pragma unroll
        for (int ai = 0; ai < 2; ++ai)
#pragma unroll
            for (int m = 0; m < 4; ++m) { const int r = ai * HALF + wr * 64 + m * 16 + fr; const f32x2v sr = S[r]; const size_t off = (size_t)(u.pm * BM + r) * ldc + col0;
#pragma unroll
                for (int bj = 0; bj < 2; ++bj)
#pragma unroll
                    for (int n = 0; n < 2; ++n) { const f32x4 x1 = acc[ai][bj][m][n]; *(f32x4*)(out + off + bj * HALF + n * 16) = bad1 ? (f32x4){qnan, qnan, qnan, qnan} : x1;
                        const f32x4 o = (x1 - sr.x) * sr.y; u32x2v w; w.x = cvt_pk_bf16(o[0], o[1]); w.y = cvt_pk_bf16(o[2], o[3]);
                        if (bad) { w.x = 0x7fc07fc0u; w.y = 0x7fc07fc0u; } *(u32x2v*)(xn + off + bj * HALF + n * 16) = w; }
                asm volatile("" ::: "memory"); }
    }
};

template <class Epi, class Sched, bool ALIGN_EPI = false, bool SP2 = false>
__device__ __forceinline__ void gemm_phase(PG8_LAS unsigned char* lds, const Gemm g, const Sched& S, const Epi& E) {
    const int tid = threadIdx.x, wid = __builtin_amdgcn_readfirstlane(tid >> 6), lane = tid & 63, wr = wid >> 2, wc = wid & 3, fr = lane & 15, fq = lane >> 4;
    const int K = g.K, nt = K / BK;
    unsigned voffA[2], voffB[2];
#pragma unroll
    for (int i = 0; i < 2; ++i) { int R, C; stage_rc(tid * 16 + i * 8192, R, C); const int Rb = Epi::PERM ? ((R & ~31) + perm32(R & 31)) : R;
        voffA[i] = (unsigned)(R * K + C) * 2u; voffB[i] = (unsigned)(Rb * K + C) * 2u; }
    const size_t kstep = (size_t)(BK * 2);
    const size_t hstep = (size_t)HALF * K * 2;
    const size_t tstep = 2 * hstep;
    const unsigned ldsw = (unsigned)wid * 1024u;
    const int aoff = lds_byte(wr * 64 + fr, fq * 8), boff = lds_byte(wc * 32 + fr, fq * 8);
#define PG8_SA(b, h) (((b) * 2 + (h)) * HTB)
#define PG8_SB(b, h) ((4 + (b) * 2 + (h)) * HTB)
#define PG8_STAGE(bufoff, gbase, voff) do { _Pragma("unroll") for (int _i = 0; _i < 2; ++_i) \
        __builtin_amdgcn_global_load_lds((const unsigned*)((const char*)(gbase) + (voff)[_i]), (PG8_LAS unsigned*)(lds + (bufoff) + ldsw + _i * 8192), 16, 0, 0); } while (0)
#define PG8_LDA(dst, b, h) do { _Pragma("unroll") for (int m = 0; m < 4; ++m) _Pragma("unroll") for (int k = 0; k < 2; ++k) dst[m][k] = *(const PG8_LAS bf16x8*)(lds + PG8_SA(b, h) + aoff + m * 2048 + k * 1024); } while (0)
#define PG8_LDB(dst, b, h) do { _Pragma("unroll") for (int n = 0; n < 2; ++n) _Pragma("unroll") for (int k = 0; k < 2; ++k) dst[n][k] = *(const PG8_LAS bf16x8*)(lds + PG8_SB(b, h) + boff + n * 2048 + k * 1024); } while (0)
#define PG8_MMA(ai, bj, At, Bt) do { __builtin_amdgcn_s_setprio(1); _Pragma("unroll") for (int m = 0; m < 4; ++m) _Pragma("unroll") for (int n = 0; n < 2; ++n) _Pragma("unroll") for (int k = 0; k < 2; ++k) \
        acc[ai][bj][m][n] = __builtin_amdgcn_mfma_f32_16x16x32_bf16(Bt[n][k], At[m][k], acc[ai][bj][m][n], 0, 0, 0); __builtin_amdgcn_s_setprio(0); } while (0)
#define PG8_WAIT_V(n) asm volatile("s_waitcnt vmcnt(" #n ")" ::: "memory")
#define PG8_WAIT_L(n) asm volatile("s_waitcnt lgkmcnt(" #n ")" ::: "memory")
#define PG8_BAR __builtin_amdgcn_s_barrier()
#define PG8_SCHED __builtin_amdgcn_sched_barrier(0)
    Unit cur, nxt; int ui = 0;
    if (!S.next(0, cur)) return;
    f32x4 acc[2][2][4][2];
#pragma unroll
    for (int a = 0; a < 2; ++a)
#pragma unroll
        for (int b = 0; b < 2; ++b)
#pragma unroll
            for (int m = 0; m < 4; ++m)
#pragma unroll
                for (int n = 0; n < 2; ++n) acc[a][b][m][n] = (f32x4){0.f, 0.f, 0.f, 0.f};
    bf16x8 At[4][2], B0[2][2], B1[2][2];
    const char* cA = (const char*)g.A + (size_t)cur.pm * tstep; const char* cB = (const char*)g.Bt + (size_t)cur.pn * tstep;
    S.a_ready(cur);
    if constexpr (SP2) {
        PG8_STAGE(PG8_SB(0, 0), cB, voffB); PG8_STAGE(PG8_SB(0, 1), cB + hstep, voffB); PG8_STAGE(PG8_SA(0, 0), cA, voffA); PG8_STAGE(PG8_SA(0, 1), cA + hstep, voffA);
        if (wr == 1) PG8_BAR;
        PG8_WAIT_V(2); PG8_BAR;
        PG8_STAGE(PG8_SB(1, 0), cB + kstep, voffB); PG8_STAGE(PG8_SA(1, 0), cA + kstep, voffA); PG8_STAGE(PG8_SB(1, 1), cB + hstep + kstep, voffB);
        PG8_WAIT_V(6); PG8_BAR;
    } else {
        PG8_STAGE(PG8_SB(0, 0), cB, voffB); PG8_STAGE(PG8_SA(0, 0), cA, voffA); PG8_STAGE(PG8_SB(0, 1), cB + hstep, voffB); PG8_STAGE(PG8_SA(0, 1), cA + hstep, voffA);
        if (wr == 1) PG8_BAR;
        PG8_WAIT_V(4); PG8_BAR;
        PG8_STAGE(PG8_SB(1, 0), cB + kstep, voffB); PG8_STAGE(PG8_SA(1, 0), cA + kstep, voffA); PG8_STAGE(PG8_SB(1, 1), cB + hstep + kstep, voffB);
        PG8_WAIT_V(6); PG8_BAR;
    }
    for (;;) {
        const bool has_next = S.next(ui + 1, nxt);
        const char* nA = has_next ? (const char*)g.A + (size_t)nxt.pm * tstep : cA; const char* nB = has_next ? (const char*)g.Bt + (size_t)nxt.pn * tstep : cB;
        for (int t = 0; t < nt; t += 2) {
            const bool last = (t == nt - 2);
            const char* a1 = cA + (size_t)(t + 1) * kstep;
            const char* a2 = last ? nA : cA + (size_t)(t + 2) * kstep; const char* b2 = last ? nB : cB + (size_t)(t + 2) * kstep;
            const char* a3 = a2 + kstep; const char* b3 = b2 + kstep;
            if (last && has_next) S.a_ready(nxt);
            if constexpr (SP2) {
            PG8_LDB(B0, 0, 0); PG8_LDB(B1, 0, 1); PG8_SCHED; PG8_LDA(At, 0, 0); PG8_STAGE(PG8_SA(1, 1), a1 + hstep, voffA);
            PG8_WAIT_V(8); PG8_WAIT_L(0); PG8_BAR; PG8_MMA(0, 0, At, B0); PG8_MMA(0, 1, At, B1); PG8_BAR; PG8_SCHED;
            PG8_LDA(At, 0, 1); PG8_STAGE(PG8_SB(0, 0), b2, voffB); PG8_STAGE(PG8_SB(0, 1), b2 + hstep, voffB); PG8_STAGE(PG8_SA(0, 0), a2, voffA);
            PG8_WAIT_V(8); PG8_WAIT_L(0); PG8_BAR; PG8_MMA(1, 0, At, B0); PG8_MMA(1, 1, At, B1); PG8_BAR; PG8_SCHED;
            PG8_LDB(B0, 1, 0); PG8_LDB(B1, 1, 1); PG8_SCHED; PG8_LDA(At, 1, 0); PG8_STAGE(PG8_SA(0, 1), a2 + hstep, voffA);
            PG8_WAIT_V(8); PG8_WAIT_L(0); PG8_BAR; PG8_MMA(0, 0, At, B0); PG8_MMA(0, 1, At, B1); PG8_BAR; PG8_SCHED;
            PG8_LDA(At, 1, 1); PG8_STAGE(PG8_SB(1, 0), b3, voffB); PG8_STAGE(PG8_SB(1, 1), b3 + hstep, voffB); PG8_STAGE(PG8_SA(1, 0), a3, voffA);
            PG8_WAIT_V(8); PG8_WAIT_L(0); PG8_BAR; PG8_MMA(1, 0, At, B0); PG8_MMA(1, 1, At, B1); PG8_BAR; PG8_SCHED;
            } else {
            PG8_LDB(B0, 0, 0); PG8_SCHED; PG8_LDA(At, 0, 0); PG8_STAGE(PG8_SA(1, 1), a1 + hstep, voffA);
            PG8_WAIT_L(8); PG8_BAR; PG8_WAIT_L(0); PG8_MMA(0, 0, At, B0); PG8_BAR; PG8_SCHED;
            PG8_LDB(B1, 0, 1); PG8_STAGE(PG8_SB(0, 0), b2, voffB);
            PG8_BAR; PG8_WAIT_L(0); PG8_MMA(0, 1, At, B1); PG8_BAR;
            PG8_LDA(At, 0, 1); PG8_STAGE(PG8_SA(0, 0), a2, voffA);
            PG8_BAR; PG8_WAIT_L(0); PG8_MMA(1, 0, At, B0); PG8_BAR; PG8_SCHED;
            PG8_STAGE(PG8_SB(0, 1), b2 + hstep, voffB);
            PG8_WAIT_V(6); PG8_BAR; PG8_MMA(1, 1, At, B1); PG8_BAR;
            PG8_LDB(B0, 1, 0); PG8_SCHED; PG8_LDA(At, 1, 0); PG8_STAGE(PG8_SA(0, 1), a2 + hstep, voffA);
            PG8_WAIT_L(8); PG8_BAR; PG8_WAIT_L(0); PG8_MMA(0, 0, At, B0); PG8_BAR; PG8_SCHED;
            PG8_LDB(B1, 1, 1); PG8_STAGE(PG8_SB(1, 0), b3, voffB);
            PG8_BAR; PG8_WAIT_L(0); PG8_MMA(0, 1, At, B1); PG8_BAR;
            PG8_LDA(At, 1, 1); PG8_STAGE(PG8_SA(1, 0), a3, voffA);
            PG8_BAR; PG8_WAIT_L(0); PG8_MMA(1, 0, At, B0); PG8_BAR; PG8_SCHED;
            PG8_STAGE(PG8_SB(1, 1), b3 + hstep, voffB);
            PG8_WAIT_V(6); PG8_BAR; PG8_MMA(1, 1, At, B1); PG8_BAR;
            }
        }
        if constexpr (ALIGN_EPI) { if (wr == 0) PG8_BAR; }
        if constexpr (!Epi::AFTER_DRAIN) { E(acc, cur, wr, wc, fr, fq); S.done(cur); }
        if (!has_next) break;
#pragma unroll
        for (int a = 0; a < 2; ++a)
#pragma unroll
            for (int b = 0; b < 2; ++b)
#pragma unroll
                for (int m = 0; m < 4; ++m)
#pragma unroll
                    for (int n = 0; n < 2; ++n) acc[a][b][m][n] = (f32x4){0.f, 0.f, 0.f, 0.f};
        cur = nxt; cA = nA; cB = nB; ++ui;
        if constexpr (ALIGN_EPI) { if (wr == 1) PG8_BAR; }
    }
    PG8_WAIT_V(0);
    if constexpr (!ALIGN_EPI) { if (wr == 0) PG8_BAR; }
    PG8_BAR;
    if constexpr (Epi::AFTER_DRAIN) { E.fused(acc, cur, wr, wc, fr, fq, lds, wid, lane); S.done(cur); }
#undef PG8_SA
#undef PG8_SB
#undef PG8_STAGE
#undef PG8_LDA
#undef PG8_LDB
#undef PG8_MMA
#undef PG8_WAIT_V
#undef PG8_WAIT_L
#undef PG8_BAR
#undef PG8_SCHED
}
}

#ifndef PG8_SP2
#define PG8_SP2 true
#endif
#ifndef PG8_ALIGN
#define PG8_ALIGN true
#endif
namespace pg8 {
__device__ __forceinline__ float silu_f(float x) { return x * __builtin_amdgcn_rcpf(1.0f + __expf(-x)); }
struct EpiSwiGLU {
    static constexpr bool PERM = true, AFTER_DRAIN = false;
    bf16_t* O; int ldc;
    __device__ __forceinline__ void operator()(const f32x4 (&acc)[2][2][4][2], const Unit& u, int wr, int wc, int fr, int fq) const {
        const int row0 = u.pm * BM + wr * 64 + fr, col0 = u.pn * HALF + wc * 32 + 8 * fq;
#pragma unroll
        for (int ai = 0; ai < 2; ++ai)
#pragma unroll
            for (int m = 0; m < 4; ++m) {
                bf16_t* rowp = O + (size_t)(row0 + ai * HALF + m * 16) * ldc + col0;
                const f32x4 g0 = acc[ai][0][m][0], g1 = acc[ai][0][m][1], u0 = acc[ai][1][m][0], u1 = acc[ai][1][m][1];
                u32x4 w;
                w.x = cvt_pk_bf16(silu_f(g0[0]) * u0[0], silu_f(g0[1]) * u0[1]); w.y = cvt_pk_bf16(silu_f(g0[2]) * u0[2], silu_f(g0[3]) * u0[3]);
                w.z = cvt_pk_bf16(silu_f(g1[0]) * u1[0], silu_f(g1[1]) * u1[1]); w.w = cvt_pk_bf16(silu_f(g1[2]) * u1[2], silu_f(g1[3]) * u1[3]);
                *(u32x4*)rowp = w;
            }
    }
};
struct EpiF32 {
    static constexpr bool PERM = false, AFTER_DRAIN = false;
    float* O; int ldc;
    __device__ __forceinline__ void operator()(const f32x4 (&acc)[2][2][4][2], const Unit& u, int wr, int wc, int fr, int fq) const {
        const int row0 = u.pm * BM + wr * 64 + fr, col0 = u.pn * BM + wc * 32 + 4 * fq;
#pragma unroll
        for (int ai = 0; ai < 2; ++ai)
#pragma unroll
            for (int m = 0; m < 4; ++m) {
                float* rowp = O + (size_t)(row0 + ai * HALF + m * 16) * ldc + col0;
#pragma unroll
                for (int bj = 0; bj < 2; ++bj)
#pragma unroll
                    for (int n = 0; n < 2; ++n) *(f32x4*)(rowp + bj * HALF + n * 16) = acc[ai][bj][m][n];
            }
    }
};
}
#define GAS __attribute__((address_space(1)))
#define LAS __attribute__((address_space(3)))
typedef unsigned short bf16;
typedef unsigned v4u __attribute__((ext_vector_type(4)));
typedef float f32x4 __attribute__((ext_vector_type(4)));
typedef short bf16x8 __attribute__((ext_vector_type(8)));
typedef GAS unsigned gu32;
typedef GAS unsigned long long gu64;
#define RLX_AGENT __ATOMIC_RELAXED, __HIP_MEMORY_SCOPE_AGENT
#define LDS_WAIT() asm volatile("s_waitcnt lgkmcnt(0)" ::: "memory")
#define VM_WAIT() asm volatile("s_waitcnt vmcnt(0)" ::: "memory")
__device__ __forceinline__ unsigned long long rt() { return __builtin_amdgcn_s_memrealtime(); }
__device__ __forceinline__ unsigned f2bf(float f) { unsigned u = __builtin_bit_cast(unsigned, f); return (u + 0x7fffu + ((u >> 16) & 1u)) >> 16; }
__device__ __forceinline__ unsigned pk2(float lo, float hi) { return f2bf(lo) | (f2bf(hi) << 16); }

#define XB_TMO      128
#define XB_XCNT(j)  (256  + 64 * (j))
#define XB_XSUB(j)  (1280 + 64 * (j))
#define XB_XGEN(j)  (2304 + 64 * (j))
#define XB_TOP      3328
#define XB_TOPGEN   3392
#define XCD_BAR_WORDS 3456
#define XB_SPIN_CAP (1u << 18)

__device__ __forceinline__ unsigned xb_ld(unsigned* p)              { return __hip_atomic_load(p, __ATOMIC_RELAXED, __HIP_MEMORY_SCOPE_AGENT); }
__device__ __forceinline__ unsigned xb_add(unsigned* p, unsigned v) { return __hip_atomic_fetch_add(p, v, __ATOMIC_RELAXED, __HIP_MEMORY_SCOPE_AGENT); }
__device__ __forceinline__ unsigned xb_xcc_id() { return (unsigned)__builtin_amdgcn_s_getreg((3 << 11) | 20) & 0xFu; }
#define XB_SPIN(cond, bar) do { unsigned _sp = 0; while (cond) { __builtin_amdgcn_s_sleep(1); \
    if ((++_sp & 255u) == 0u) { if (xb_ld(&(bar)[XB_TMO])) break; if (_sp > XB_SPIN_CAP) { atomicAdd(&(bar)[XB_TMO], 1u); break; } } } } while (0)

struct XcdBarrier {
    unsigned* bar; unsigned x;
    volatile LAS unsigned* st;
};

__device__ __forceinline__ XcdBarrier xcd_barrier_post(unsigned* bar, volatile LAS unsigned* st) {
    XcdBarrier b; b.bar = bar; b.x = xb_xcc_id(); b.st = st;
    if (threadIdx.x == 0) (void)xb_add(&bar[XB_XCNT(b.x)], 1u);
    return b;
}
__device__ __forceinline__ void xcd_barrier_complete(unsigned* bar, unsigned x, unsigned& nloc, unsigned& nx) {
    const unsigned G = gridDim.x * gridDim.y * gridDim.z;
    unsigned sum, cnt, mine, sp = 0u;
    for (;;) {
        sum = 0u; cnt = 0u; mine = 0u;
#pragma unroll
        for (unsigned j = 0; j < 16; ++j) { const unsigned c = xb_ld(&bar[XB_XCNT(j)]); sum += c; cnt += (c > 0u) ? 1u : 0u; mine = (j == x) ? c : mine; }
        if (sum == G) break;
        __builtin_amdgcn_s_sleep(1);
        if ((++sp & 255u) == 0u) { if (xb_ld(&bar[XB_TMO])) break; if (sp > XB_SPIN_CAP) { atomicAdd(&bar[XB_TMO], 1u); break; } }
    }
    nloc = mine > 0u ? mine : 1u; nx = cnt > 0u ? cnt : 1u;
}

__device__ __forceinline__ void xcd_barrier(const XcdBarrier& b) {
    asm volatile("s_waitcnt vmcnt(0)" ::: "memory");
    __syncthreads();
    if (threadIdx.x == 0) {
        unsigned* bar = b.bar;
        __builtin_amdgcn_s_waitcnt(0);
        unsigned nloc = b.st[0], nx = b.st[1];
        if (nloc == 0u) { xcd_barrier_complete(bar, b.x, nloc, nx); b.st[0] = nloc; b.st[1] = nx; }
        const unsigned old = xb_add(&bar[XB_XSUB(b.x)], 1u);
        const unsigned gen = old / nloc;
        if (old + 1u == (gen + 1u) * nloc) {
            __builtin_amdgcn_fence(__ATOMIC_RELEASE, "agent");
            asm volatile("s_waitcnt vmcnt(0)" ::: "memory");
            const unsigned og = xb_add(&bar[XB_TOP], 1u);
            const unsigned tg = og / nx;
            if (og + 1u == (tg + 1u) * nx) xb_add(&bar[XB_TOPGEN], 1u);
            else XB_SPIN(xb_ld(&bar[XB_TOPGEN]) == tg, bar);
            __builtin_amdgcn_fence(__ATOMIC_ACQUIRE, "agent");
            xb_add(&bar[XB_XGEN(b.x)], 1u);
            asm volatile("s_waitcnt vmcnt(0)" ::: "memory");
        } else {
            XB_SPIN(xb_ld(&bar[XB_XGEN(b.x)]) == gen, bar);
            __builtin_amdgcn_fence(__ATOMIC_ACQUIRE, "agent");
            asm volatile("s_waitcnt vmcnt(0)" ::: "memory");
        }
    }
    __syncthreads();
}

constexpr int NWAVES = 8;
constexpr int BATCH = 8, SEQ = 4096, D = 1024, M = BATCH * SEQ;
constexpr int NC_IN = 3592, C_BETA = 2048, C_QB = 2056;
constexpr int NIN = 3584;
constexpr int DFF = 2816, NGU = 2 * DFF;
constexpr float EPS = 1e-6f;
constexpr size_t MiB = 1u << 20;
constexpr size_t WS_CTL = 0, CTL_ZERO_BYTES = 1 * MiB;
constexpr size_t WS_WIN = 1 * MiB, WS_WO = 8 * MiB, WS_WGU = 10 * MiB, WS_WD = 21 * MiB, WS_BG = 27 * MiB;
constexpr size_t WS_XN = 32 * MiB;
constexpr size_t WS_PROJ = 96 * MiB;
constexpr size_t SEG = 32 * MiB;
constexpr size_t WS_ORAW = 96 * MiB;
constexpr size_t WS_Y = 320 * MiB;
constexpr size_t WS_XN2 = 448 * MiB;
constexpr size_t WS_HID = 96 * MiB;
constexpr size_t WS_SO1 = 32 * MiB, WS_SO2 = 64 * MiB, WS_SO3 = 480 * MiB;
constexpr size_t WS_LSE = 28 * MiB;
constexpr size_t WS_MIXO = 224 * MiB;
constexpr size_t WS_GDN = 320 * MiB;
constexpr size_t GDN_BLOB = 73728, GB_W = 0, GB_QD = 16384, GB_KDT = 32768, GB_ATT = 49152, GB_U = 57344, GB_SHARED = 57344;
constexpr size_t WS_GE = 31 * MiB;
constexpr size_t WS_END = 512 * MiB;
constexpr int CW_BAR = 4096;
constexpr int RING_OFF = 0, RING_BYTES = 131072;
constexpr int LDSCTL_OFF = RING_BYTES, MISC_OFF = LDSCTL_OFF + 320;
constexpr int LDS_BYTES = 147456;

__constant__ int c_bkt[3][129] = {
 {0, 1, 2, 3, 4, 5, 6, 7, 8, 9, 10, 11, 12, 13, 14, 15, 16, 16, 16, 16, 16, 16, 17, 17, 17, 17, 17, 17, 17, 17, 18, 18, 18, 18, 18, 18, 18, 18, 18, 18, 19, 19, 19, 19, 19, 19, 19, 19, 19, 19, 19, 19, 19, 19, 20, 20, 20, 20, 20, 20, 20, 20, 20, 20, 20, 20, 20, 20, 20, 20, 20, 20, 20, 21, 21, 21, 21, 21, 21, 21, 21, 21, 21, 21, 21, 21, 21, 21, 21, 21, 21, 21, 21, 21, 21, 21, 21, 21, 21, 22, 22, 22, 22, 22, 22, 22, 22, 22, 22, 22, 22, 22, 22, 22, 22, 22, 22, 22, 22, 22, 22, 22, 22, 22, 22, 22, 22, 22, 22},
 {0, 4, 8, 12, 16, 16, 17, 17, 18, 18, 19, 19, 19, 19, 20, 20, 20, 20, 20, 21, 21, 21, 21, 21, 21, 22, 22, 22, 22, 22, 22, 22, 22, 22, 23, 23, 23, 23, 23, 23, 23, 23, 23, 23, 23, 23, 24, 24, 24, 24, 24, 24, 24, 24, 24, 24, 24, 24, 24, 24, 24, 24, 25, 25, 25, 25, 25, 25, 25, 25, 25, 25, 25, 25, 25, 25, 25, 25, 25, 25, 25, 25, 25, 26, 26, 26, 26, 26, 26, 26, 26, 26, 26, 26, 26, 26, 26, 26, 26, 26, 26, 26, 26, 26, 26, 26, 26, 26, 26, 26, 26, 26, 26, 27, 27, 27, 27, 27, 27, 27, 27, 27, 27, 27, 27, 27, 27, 27, 27},
 {0, 16, 18, 19, 20, 21, 21, 22, 22, 23, 23, 23, 24, 24, 24, 24, 25, 25, 25, 25, 25, 26, 26, 26, 26, 26, 26, 26, 26, 27, 27, 27, 27, 27, 27, 27, 27, 27, 27, 28, 28, 28, 28, 28, 28, 28, 28, 28, 28, 28, 28, 28, 29, 29, 29, 29, 29, 29, 29, 29, 29, 29, 29, 29, 29, 29, 29, 29, 29, 29, 30, 30, 30, 30, 30, 30, 30, 30, 30, 30, 30, 30, 30, 30, 30, 30, 30, 30, 30, 30, 30, 30, 30, 30, 30, 31, 31, 31, 31, 31, 31, 31, 31, 31, 31, 31, 31, 31, 31, 31, 31, 31, 31, 31, 31, 31, 31, 31, 31, 31, 31, 31, 31, 31, 31, 31, 31, 31, 31}};

struct Frame {
    LAS unsigned char* lds;
    volatile LAS unsigned* MISC;
    gu32* ctl;
    int tid, lane, wave, vcu, G;
    unsigned char* ws;
};
struct Args { const float* in[15]; float* out; unsigned char* ws; int ph_lo, ph_hi; };
#define A_x          (A.in[0])
#define A_w_in       (A.in[1])
#define A_conv_w     (A.in[2])
#define A_a_log      (A.in[3])
#define A_dt_bias    (A.in[4])
#define A_onorm_g    (A.in[5])
#define A_rel_bias   (A.in[6])
#define A_w_out      (A.in[7])
#define A_g_mix_pre  (A.in[8])
#define A_g_mix_post (A.in[9])
#define A_w_gate     (A.in[10])
#define A_w_up       (A.in[11])
#define A_w_down     (A.in[12])
#define A_g_ffn_pre  (A.in[13])
#define A_g_ffn_post (A.in[14])
#define W_WIN  ((bf16*)(F.ws + WS_WIN))
#define W_WO   ((bf16*)(F.ws + WS_WO))
#define W_WGU  ((bf16*)(F.ws + WS_WGU))
#define W_WD   ((bf16*)(F.ws + WS_WD))
#define W_BG   ((float*)(F.ws + WS_BG))
#define W_XN   ((bf16*)(F.ws + WS_XN))
#define W_PROJ ((bf16*)(F.ws + WS_PROJ))
#define W_MIXO ((bf16*)(F.ws + WS_MIXO))
#define W_XN2  ((bf16*)(F.ws + WS_XN2))
#define W_HID  ((bf16*)(F.ws + WS_HID))
#define W_ORAW ((float*)(F.ws + WS_ORAW))
#define W_Y    ((float*)(F.ws + WS_Y))
__device__ __forceinline__ float wave_sum(float v) {
#pragma unroll
    for (int o = 1; o < 64; o <<= 1) v += __shfl_xor(v, o);
    return v;
}
__device__ __forceinline__ float bf2f(bf16 b) { return __builtin_bit_cast(float, (unsigned)b << 16); }
__device__ __forceinline__ float siluf(float x) { return x / (1.f + __expf(-x)); }

__device__ __forceinline__ void p0_transpose_item(const float* W, int ldw, int col0, int K, bf16* WT, int dst_row0, int k0, LAS float* scr, int lane) {
#pragma unroll 8
    for (int i = 0; i < 32; ++i) { const int kk = 2 * i + (lane >> 5); scr[kk * 33 + (lane & 31)] = W[(size_t)(k0 + kk) * ldw + col0 + (lane & 31)]; }
    LDS_WAIT(); asm volatile("" ::: "memory");
    const int c = lane & 7;
#pragma unroll
    for (int j = 0; j < 4; ++j) { const int n = (lane >> 3) + 8 * j; const LAS float* s = scr + (8 * c) * 33 + n;
        v4u o; o.x = pk2(s[0 * 33], s[1 * 33]); o.y = pk2(s[2 * 33], s[3 * 33]); o.z = pk2(s[4 * 33], s[5 * 33]); o.w = pk2(s[6 * 33], s[7 * 33]);
        *(GAS v4u*)(WT + (size_t)(dst_row0 + n) * K + k0 + 8 * c) = o; }
    LDS_WAIT(); asm volatile("" ::: "memory");
}

__device__ __forceinline__ void ph_prologue(Frame& F, const Args& A) {
    LAS float* scr = (LAS float*)(F.lds + RING_OFF + F.wave * 16384);
    const int gw = F.vcu * NWAVES + F.wave, NGW = F.G * NWAVES;
    constexpr int I_A = 16 * 64, I_B = 16 * 48, I_O = 16 * 32, I_G = 16 * 88, I_D = 44 * 32;
    constexpr int NITEMS = I_A + I_B + I_O + 2 * I_G + I_D;
    for (int it = gw; it < NITEMS; it += NGW) {
        int r = it;
        if (r < I_A) { const int kb = r / 64, nb = r % 64; p0_transpose_item(A_w_in, NC_IN, 32 * nb, D, W_WIN, 32 * nb, 64 * kb, scr, F.lane); continue; } r -= I_A;
        if (r < I_B) { const int kb = r / 48, nb = r % 48; p0_transpose_item(A_w_in, NC_IN, C_QB + 32 * nb, D, W_WIN, 2048 + 32 * nb, 64 * kb, scr, F.lane); continue; } r -= I_B;
        if (r < I_O) { const int kb = r / 32, nb = r % 32; p0_transpose_item(A_w_out, D, 32 * nb, D, W_WO, 32 * nb, 64 * kb, scr, F.lane); continue; } r -= I_O;
        if (r < I_G) { const int kb = r / 88, nb = r % 88, n0 = 32 * nb; p0_transpose_item(A_w_gate, DFF, n0, D, W_WGU, 256 * (n0 >> 7) + (n0 & 127), 64 * kb, scr, F.lane); continue; } r -= I_G;
        if (r < I_G) { const int kb = r / 88, nb = r % 88, n0 = 32 * nb; p0_transpose_item(A_w_up, DFF, n0, D, W_WGU, 256 * (n0 >> 7) + 128 + (n0 & 127), 64 * kb, scr, F.lane); continue; } r -= I_G;
        { const int kb = r / 32, nb = r % 32; p0_transpose_item(A_w_down, D, 32 * nb, DFF, W_WD, 32 * nb, 64 * kb, scr, F.lane); }
    }
    __syncthreads();
    LAS float* wba = (LAS float*)(F.lds + RING_OFF);
    for (int e = F.tid; e < 8 * D; e += NWAVES * 64) { const int k = e >> 3, c = e & 7; wba[c * D + k] = A_w_in[(size_t)k * NC_IN + C_BETA + c]; }
    __syncthreads();
    for (int m = gw; m < M; m += NGW) {
        const GAS f32x4* xr = (const GAS f32x4*)(A_x + (size_t)m * D) + F.lane;
        const GAS f32x4* gr = (const GAS f32x4*)A_g_mix_pre + F.lane;
        f32x4 v[4]; float s = 0.f;
#pragma unroll
        for (int j = 0; j < 4; ++j) { v[j] = xr[64 * j]; s += (v[j].x * v[j].x + v[j].y * v[j].y) + (v[j].z * v[j].z + v[j].w * v[j].w); }
        const float rstd = rsqrtf(wave_sum(s) * (1.f / D) + EPS);
        GAS unsigned long long* o8 = (GAS unsigned long long*)(W_XN + (size_t)m * D) + F.lane;
        float acc[8];
#pragma unroll
        for (int c = 0; c < 8; ++c) acc[c] = 0.f;
#pragma unroll
        for (int j = 0; j < 4; ++j) {
            const f32x4 g = gr[64 * j]; v[j] = v[j] * rstd * g;
            o8[64 * j] = (unsigned long long)pk2(v[j].x, v[j].y) | ((unsigned long long)pk2(v[j].z, v[j].w) << 32);
#pragma unroll
            for (int c = 0; c < 8; ++c) { const f32x4 w = *((const LAS f32x4*)(wba + c * D) + F.lane + 64 * j); acc[c] += (v[j].x * w.x + v[j].y * w.y) + (v[j].z * w.z + v[j].w * w.w); }
        }
#pragma unroll
        for (int c = 0; c < 8; ++c) acc[c] = wave_sum(acc[c]);
        if (F.lane < 4) {
            const int h = F.lane;
            const float bl = h == 0 ? acc[0] : h == 1 ? acc[1] : h == 2 ? acc[2] : acc[3];
            const float al = h == 0 ? acc[4] : h == 1 ? acc[5] : h == 2 ? acc[6] : acc[7];
            const float beta = 1.f / (1.f + expf(-bl));
            const float xx = al + A_dt_bias[h];
            const float sp = fmaxf(xx, 0.f) + log1pf(expf(-fabsf(xx)));
            W_BG[(size_t)m * 8 + h] = beta;
            W_BG[(size_t)m * 8 + 4 + h] = -expf(A_a_log[h]) * sp;
        }
    }
}


typedef short s16x4_t __attribute__((ext_vector_type(4)));
constexpr int GA_QI = 0, GA_KI = 17408, GA_VI = 34816, GA_AM = 52224, GA_TP = 69632, GA_TPP = 78848, GA_WI = 88064, GA_ATI = 105472, GA_TAB = 114688;
constexpr int GA_RS = 272, GA_TS = 144;
__device__ __forceinline__ s16x4_t lds_tr16p(LAS unsigned char* p) { return __builtin_bit_cast(s16x4_t, __builtin_amdgcn_ds_read_tr16_b64_v4i16((LAS s16x4_t*)p)); }
__device__ __forceinline__ unsigned mul_pk(unsigned w, float s0, float s1) {
    return pk2(__builtin_bit_cast(float, w << 16) * s0, __builtin_bit_cast(float, w & 0xffff0000u) * s1);
}
__device__ __forceinline__ void gdn_prep_chunk(Frame& F, const Args& A, int cu) {
    const int bh = cu >> 6, c = cu & 63, b = bh >> 2, h = bh & 3;
    const size_t row0 = (size_t)b * SEQ + (size_t)c * 64;
    LAS unsigned char* lds = F.lds + RING_OFF;
    LAS float* tab = (LAS float*)(lds + GA_TAB);
    unsigned char* blob = F.ws + WS_GDN + (size_t)cu * GDN_BLOB;
    int tid = F.tid; asm volatile("" : "+v"(tid));
    const int lane = tid & 63, x = lane & 15, g = lane >> 4;
    {
        const int i = tid >> 3, cc = tid & 7, t = c * 64 + i;
#pragma unroll
        for (int sgm = 0; sgm < 3; ++sgm) {
            const bf16* seg = W_PROJ + (size_t)sgm * M * 512 + h * 128 + cc * 16;
            const float* cw = A_conv_w + sgm * 512 + h * 128 + cc * 16;
            float a[16];
#pragma unroll
            for (int e = 0; e < 16; ++e) a[e] = 0.f;
#pragma unroll
            for (int tap = 0; tap < 4; ++tap) {
                const int tt = t - 3 + tap;
                if (tt >= 0) {
                    const v4u r0 = *(const GAS v4u*)(seg + (row0 + i - 3 + tap) * 512), r1 = *(const GAS v4u*)(seg + (row0 + i - 3 + tap) * 512 + 8);
                    const unsigned rw[8] = {r0.x, r0.y, r0.z, r0.w, r1.x, r1.y, r1.z, r1.w};
#pragma unroll
                    for (int e = 0; e < 8; ++e) {
                        a[2 * e] += cw[tap * 1536 + 2 * e] * __builtin_bit_cast(float, rw[e] << 16);
                        a[2 * e + 1] += cw[tap * 1536 + 2 * e + 1] * __builtin_bit_cast(float, rw[e] & 0xffff0000u);
                    }
                }
            }
            float ss = 0.f;
#pragma unroll
            for (int e = 0; e < 16; ++e) { a[e] = siluf(a[e]); ss += a[e] * a[e]; }
            float scale = 1.f;
            if (sgm < 2) { ss += __shfl_xor(ss, 1); ss += __shfl_xor(ss, 2); ss += __shfl_xor(ss, 4); scale = rsqrtf(ss + 1e-6f) * (sgm == 0 ? 0.08838834764831845f : 1.f); }
            v4u w0, w1;
            w0.x = pk2(a[0] * scale, a[1] * scale); w0.y = pk2(a[2] * scale, a[3] * scale); w0.z = pk2(a[4] * scale, a[5] * scale); w0.w = pk2(a[6] * scale, a[7] * scale);
            w1.x = pk2(a[8] * scale, a[9] * scale); w1.y = pk2(a[10] * scale, a[11] * scale); w1.z = pk2(a[12] * scale, a[13] * scale); w1.w = pk2(a[14] * scale, a[15] * scale);
            LAS unsigned char* img = lds + (sgm == 0 ? GA_QI : (sgm == 1 ? GA_KI : GA_VI)) + i * GA_RS + cc * 32;
            *(LAS v4u*)img = w0; *(LAS v4u*)(img + 16) = w1;
        }
        if (F.wave == 0) {
            const float beta = W_BG[(row0 + lane) * 8 + h]; float gcs = W_BG[(row0 + lane) * 8 + 4 + h];
#pragma unroll
            for (int o = 1; o < 64; o <<= 1) { const float up = __shfl_up(gcs, o); if (lane >= o) gcs += up; }
            const float gl = __shfl(gcs, 63);
            tab[lane] = gcs; tab[64 + lane] = __expf(gcs); tab[128 + lane] = __expf(gl - gcs); tab[192 + lane] = beta;
            if (lane == 0) ((float*)(F.ws + WS_GE))[cu] = __expf(gl);
        }
    }
    __syncthreads();
    {
        const int mi = F.wave >> 1;
        bf16x8 ak[4], aq[4];
#pragma unroll
        for (int s4 = 0; s4 < 4; ++s4) {
            ak[s4] = *(const LAS bf16x8*)(lds + GA_KI + (16 * mi + x) * GA_RS + (32 * s4 + 8 * g) * 2);
            aq[s4] = *(const LAS bf16x8*)(lds + GA_QI + (16 * mi + x) * GA_RS + (32 * s4 + 8 * g) * 2);
        }
#pragma unroll
        for (int t2 = 0; t2 < 2; ++t2) {
            const int nj = 2 * (F.wave & 1) + t2;
            f32x4 kk = {0.f, 0.f, 0.f, 0.f}, qk = {0.f, 0.f, 0.f, 0.f};
#pragma unroll
            for (int s4 = 0; s4 < 4; ++s4) {
                const bf16x8 bk = *(const LAS bf16x8*)(lds + GA_KI + (16 * nj + x) * GA_RS + (32 * s4 + 8 * g) * 2);
                kk = __builtin_amdgcn_mfma_f32_16x16x32_bf16(ak[s4], bk, kk, 0, 0, 0);
                qk = __builtin_amdgcn_mfma_f32_16x16x32_bf16(aq[s4], bk, qk, 0, 0, 0);
            }
            const int j = 16 * nj + x; const float gcj = tab[j];
            f32x4 arow;
#pragma unroll
            for (int e = 0; e < 4; ++e) {
                const int i = 16 * mi + 4 * g + e;
                const float dec = (i >= j) ? __expf(tab[i] - gcj) : 0.f;
                arow[e] = (i > j) ? tab[192 + i] * kk[e] * dec : 0.f;
                ((LAS bf16*)(lds + GA_ATI))[i * 72 + j] = (bf16)f2bf(qk[e] * dec);
            }
            *(LAS f32x4*)((LAS float*)(lds + GA_AM) + j * 68 + 16 * mi + 4 * g) = arow;
        }
    }
    __syncthreads();
    if (F.wave == 0) {
        const LAS float* am = (const LAS float*)(lds + GA_AM);
        float t0 = (lane == 0) ? 1.f : 0.f, t1 = (lane == 1) ? 1.f : 0.f, t2 = (lane == 2) ? 1.f : 0.f, t3 = (lane == 3) ? 1.f : 0.f, t4 = (lane == 4) ? 1.f : 0.f, t5 = (lane == 5) ? 1.f : 0.f, t6 = (lane == 6) ? 1.f : 0.f, t7 = (lane == 7) ? 1.f : 0.f, t8 = (lane == 8) ? 1.f : 0.f, t9 = (lane == 9) ? 1.f : 0.f, t10 = (lane == 10) ? 1.f : 0.f, t11 = (lane == 11) ? 1.f : 0.f, t12 = (lane == 12) ? 1.f : 0.f, t13 = (lane == 13) ? 1.f : 0.f, t14 = (lane == 14) ? 1.f : 0.f, t15 = (lane == 15) ? 1.f : 0.f, t16 = (lane == 16) ? 1.f : 0.f, t17 = (lane == 17) ? 1.f : 0.f, t18 = (lane == 18) ? 1.f : 0.f, t19 = (lane == 19) ? 1.f : 0.f, t20 = (lane == 20) ? 1.f : 0.f, t21 = (lane == 21) ? 1.f : 0.f, t22 = (lane == 22) ? 1.f : 0.f, t23 = (lane == 23) ? 1.f : 0.f, t24 = (lane == 24) ? 1.f : 0.f, t25 = (lane == 25) ? 1.f : 0.f, t26 = (lane == 26) ? 1.f : 0.f, t27 = (lane == 27) ? 1.f : 0.f, t28 = (lane == 28) ? 1.f : 0.f, t29 = (lane == 29) ? 1.f : 0.f, t30 = (lane == 30) ? 1.f : 0.f, t31 = (lane == 31) ? 1.f : 0.f, t32 = (lane == 32) ? 1.f : 0.f, t33 = (lane == 33) ? 1.f : 0.f, t34 = (lane == 34) ? 1.f : 0.f, t35 = (lane == 35) ? 1.f : 0.f, t36 = (lane == 36) ? 1.f : 0.f, t37 = (lane == 37) ? 1.f : 0.f, t38 = (lane == 38) ? 1.f : 0.f, t39 = (lane == 39) ? 1.f : 0.f, t40 = (lane == 40) ? 1.f : 0.f, t41 = (lane == 41) ? 1.f : 0.f, t42 = (lane == 42) ? 1.f : 0.f, t43 = (lane == 43) ? 1.f : 0.f, t44 = (lane == 44) ? 1.f : 0.f, t45 = (lane == 45) ? 1.f : 0.f, t46 = (lane == 46) ? 1.f : 0.f, t47 = (lane == 47) ? 1.f : 0.f, t48 = (lane == 48) ? 1.f : 0.f, t49 = (lane == 49) ? 1.f : 0.f, t50 = (lane == 50) ? 1.f : 0.f, t51 = (lane == 51) ? 1.f : 0.f, t52 = (lane == 52) ? 1.f : 0.f, t53 = (lane == 53) ? 1.f : 0.f, t54 = (lane == 54) ? 1.f : 0.f, t55 = (lane == 55) ? 1.f : 0.f, t56 = (lane == 56) ? 1.f : 0.f, t57 = (lane == 57) ? 1.f : 0.f, t58 = (lane == 58) ? 1.f : 0.f, t59 = (lane == 59) ? 1.f : 0.f, t60 = (lane == 60) ? 1.f : 0.f, t61 = (lane == 61) ? 1.f : 0.f, t62 = (lane == 62) ? 1.f : 0.f, t63 = (lane == 63) ? 1.f : 0.f;
        { { const f32x4 av = *(const LAS f32x4*)(am + 0); t1 -= av[1] * t0; t2 -= av[2] * t0; t3 -= av[3] * t0; } { const f32x4 av = *(const LAS f32x4*)(am + 4); t4 -= av[0] * t0; t5 -= av[1] * t0; t6 -= av[2] * t0; t7 -= av[3] * t0; } { const f32x4 av = *(const LAS f32x4*)(am + 8); t8 -= av[0] * t0; t9 -= av[1] * t0; t10 -= av[2] * t0; t11 -= av[3] * t0; } { const f32x4 av = *(const LAS f32x4*)(am + 12); t12 -= av[0] * t0; t13 -= av[1] * t0; t14 -= av[2] * t0; t15 -= av[3] * t0; } { const f32x4 av = *(const LAS f32x4*)(am + 16); t16 -= av[0] * t0; t17 -= av[1] * t0; t18 -= av[2] * t0; t19 -= av[3] * t0; } { const f32x4 av = *(const LAS f32x4*)(am + 20); t20 -= av[0] * t0; t21 -= av[1] * t0; t22 -= av[2] * t0; t23 -= av[3] * t0; } { const f32x4 av = *(const LAS f32x4*)(am + 24); t24 -= av[0] * t0; t25 -= av[1] * t0; t26 -= av[2] * t0; t27 -= av[3] * t0; } { const f32x4 av = *(const LAS f32x4*)(am + 28); t28 -= av[0] * t0; t29 -= av[1] * t0; t30 -= av[2] * t0; t31 -= av[3] * t0; } { const f32x4 av = *(const LAS f32x4*)(am + 32); t32 -= av[0] * t0; t33 -= av[1] * t0; t34 -= av[2] * t0; t35 -= av[3] * t0; } { const f32x4 av = *(const LAS f32x4*)(am + 36); t36 -= av[0] * t0; t37 -= av[1] * t0; t38 -= av[2] * t0; t39 -= av[3] * t0; } { const f32x4 av = *(const LAS f32x4*)(am + 40); t40 -= av[0] * t0; t41 -= av[1] * t0; t42 -= av[2] * t0; t43 -= av[3] * t0; } { const f32x4 av = *(const LAS f32x4*)(am + 44); t44 -= av[0] * t0; t45 -= av[1] * t0; t46 -= av[2] * t0; t47 -= av[3] * t0; } { const f32x4 av = *(const LAS f32x4*)(am + 48); t48 -= av[0] * t0; t49 -= av[1] * t0; t50 -= av[2] * t0; t51 -= av[3] * t0; } { const f32x4 av = *(const LAS f32x4*)(am + 52); t52 -= av[0] * t0; t53 -= av[1] * t0; t54 -= av[2] * t0; t55 -= av[3] * t0; } { const f32x4 av = *(const LAS f32x4*)(am + 56); t56 -= av[0] * t0; t57 -= av[1] * t0; t58 -= av[2] * t0; t59 -= av[3] * t0; } { const f32x4 av = *(const LAS f32x4*)(am + 60); t60 -= av[0] * t0; t61 -= av[1] * t0; t62 -= av[2] * t0; t63 -= av[3] * t0; } } asm volatile("" ::: "memory");
        { { const f32x4 av = *(const LAS f32x4*)(am + 68); t2 -= av[2] * t1; t3 -= av[3] * t1; } { const f32x4 av = *(const LAS f32x4*)(am + 72); t4 -= av[0] * t1; t5 -= av[1] * t1; t6 -= av[2] * t1; t7 -= av[3] * t1; } { const f32x4 av = *(const LAS f32x4*)(am + 76); t8 -= av[0] * t1; t9 -= av[1] * t1; t10 -= av[2] * t1; t11 -= av[3] * t1; } { const f32x4 av = *(const LAS f32x4*)(am + 80); t12 -= av[0] * t1; t13 -= av[1] * t1; t14 -= av[2] * t1; t15 -= av[3] * t1; } { const f32x4 av = *(const LAS f32x4*)(am + 84); t16 -= av[0] * t1; t17 -= av[1] * t1; t18 -= av[2] * t1; t19 -= av[3] * t1; } { const f32x4 av = *(const LAS f32x4*)(am + 88); t20 -= av[0] * t1; t21 -= av[1] * t1; t22 -= av[2] * t1; t23 -= av[3] * t1; } { const f32x4 av = *(const LAS f32x4*)(am + 92); t24 -= av[0] * t1; t25 -= av[1] * t1; t26 -= av[2] * t1; t27 -= av[3] * t1; } { const f32x4 av = *(const LAS f32x4*)(am + 96); t28 -= av[0] * t1; t29 -= av[1] * t1; t30 -= av[2] * t1; t31 -= av[3] * t1; } { const f32x4 av = *(const LAS f32x4*)(am + 100); t32 -= av[0] * t1; t33 -= av[1] * t1; t34 -= av[2] * t1; t35 -= av[3] * t1; } { const f32x4 av = *(const LAS f32x4*)(am + 104); t36 -= av[0] * t1; t37 -= av[1] * t1; t38 -= av[2] * t1; t39 -= av[3] * t1; } { const f32x4 av = *(const LAS f32x4*)(am + 108); t40 -= av[0] * t1; t41 -= av[1] * t1; t42 -= av[2] * t1; t43 -= av[3] * t1; } { const f32x4 av = *(const LAS f32x4*)(am + 112); t44 -= av[0] * t1; t45 -= av[1] * t1; t46 -= av[2] * t1; t47 -= av[3] * t1; } { const f32x4 av = *(const LAS f32x4*)(am + 116); t48 -= av[0] * t1; t49 -= av[1] * t1; t50 -= av[2] * t1; t51 -= av[3] * t1; } { const f32x4 av = *(const LAS f32x4*)(am + 120); t52 -= av[0] * t1; t53 -= av[1] * t1; t54 -= av[2] * t1; t55 -= av[3] * t1; } { const f32x4 av = *(const LAS f32x4*)(am + 124); t56 -= av[0] * t1; t57 -= av[1] * t1; t58 -= av[2] * t1; t59 -= av[3] * t1; } { const f32x4 av = *(const LAS f32x4*)(am + 128); t60 -= av[0] * t1; t61 -= av[1] * t1; t62 -= av[2] * t1; t63 -= av[3] * t1; } } asm volatile("" ::: "memory");
        { { const f32x4 av = *(const LAS f32x4*)(am + 136); t3 -= av[3] * t2; } { const f32x4 av = *(const LAS f32x4*)(am + 140); t4 -= av[0] * t2; t5 -= av[1] * t2; t6 -= av[2] * t2; t7 -= av[3] * t2; } { const f32x4 av = *(const LAS f32x4*)(am + 144); t8 -= av[0] * t2; t9 -= av[1] * t2; t10 -= av[2] * t2; t11 -= av[3] * t2; } { const f32x4 av = *(const LAS f32x4*)(am + 148); t12 -= av[0] * t2; t13 -= av[1] * t2; t14 -= av[2] * t2; t15 -= av[3] * t2; } { const f32x4 av = *(const LAS f32x4*)(am + 152); t16 -= av[0] * t2; t17 -= av[1] * t2; t18 -= av[2] * t2; t19 -= av[3] * t2; } { const f32x4 av = *(const LAS f32x4*)(am + 156); t20 -= av[0] * t2; t21 -= av[1] * t2; t22 -= av[2] * t2; t23 -= av[3] * t2; } { const f32x4 av = *(const LAS f32x4*)(am + 160); t24 -= av[0] * t2; t25 -= av[1] * t2; t26 -= av[2] * t2; t27 -= av[3] * t2; } { const f32x4 av = *(const LAS f32x4*)(am + 164); t28 -= av[0] * t2; t29 -= av[1] * t2; t30 -= av[2] * t2; t31 -= av[3] * t2; } { const f32x4 av = *(const LAS f32x4*)(am + 168); t32 -= av[0] * t2; t33 -= av[1] * t2; t34 -= av[2] * t2; t35 -= av[3] * t2; } { const f32x4 av = *(const LAS f32x4*)(am + 172); t36 -= av[0] * t2; t37 -= av[1] * t2; t38 -= av[2] * t2; t39 -= av[3] * t2; } { const f32x4 av = *(const LAS f32x4*)(am + 176); t40 -= av[0] * t2; t41 -= av[1] * t2; t42 -= av[2] * t2; t43 -= av[3] * t2; } { const f32x4 av = *(const LAS f32x4*)(am + 180); t44 -= av[0] * t2; t45 -= av[1] * t2; t46 -= av[2] * t2; t47 -= av[3] * t2; } { const f32x4 av = *(const LAS f32x4*)(am + 184); t48 -= av[0] * t2; t49 -= av[1] * t2; t50 -= av[2] * t2; t51 -= av[3] * t2; } { const f32x4 av = *(const LAS f32x4*)(am + 188); t52 -= av[0] * t2; t53 -= av[1] * t2; t54 -= av[2] * t2; t55 -= av[3] * t2; } { const f32x4 av = *(const LAS f32x4*)(am + 192); t56 -= av[0] * t2; t57 -= av[1] * t2; t58 -= av[2] * t2; t59 -= av[3] * t2; } { const f32x4 av = *(const LAS f32x4*)(am + 196); t60 -= av[0] * t2; t61 -= av[1] * t2; t62 -= av[2] * t2; t63 -= av[3] * t2; } } asm volatile("" ::: "memory");
        { { const f32x4 av = *(const LAS f32x4*)(am + 208); t4 -= av[0] * t3; t5 -= av[1] * t3; t6 -= av[2] * t3; t7 -= av[3] * t3; } { const f32x4 av = *(const LAS f32x4*)(am + 212); t8 -= av[0] * t3; t9 -= av[1] * t3; t10 -= av[2] * t3; t11 -= av[3] * t3; } { const f32x4 av = *(const LAS f32x4*)(am + 216); t12 -= av[0] * t3; t13 -= av[1] * t3; t14 -= av[2] * t3; t15 -= av[3] * t3; } { const f32x4 av = *(const LAS f32x4*)(am + 220); t16 -= av[0] * t3; t17 -= av[1] * t3; t18 -= av[2] * t3; t19 -= av[3] * t3; } { const f32x4 av = *(const LAS f32x4*)(am + 224); t20 -= av[0] * t3; t21 -= av[1] * t3; t22 -= av[2] * t3; t23 -= av[3] * t3; } { const f32x4 av = *(const LAS f32x4*)(am + 228); t24 -= av[0] * t3; t25 -= av[1] * t3; t26 -= av[2] * t3; t27 -= av[3] * t3; } { const f32x4 av = *(const LAS f32x4*)(am + 232); t28 -= av[0] * t3; t29 -= av[1] * t3; t30 -= av[2] * t3; t31 -= av[3] * t3; } { const f32x4 av = *(const LAS f32x4*)(am + 236); t32 -= av[0] * t3; t33 -= av[1] * t3; t34 -= av[2] * t3; t35 -= av[3] * t3; } { const f32x4 av = *(const LAS f32x4*)(am + 240); t36 -= av[0] * t3; t37 -= av[1] * t3; t38 -= av[2] * t3; t39 -= av[3] * t3; } { const f32x4 av = *(const LAS f32x4*)(am + 244); t40 -= av[0] * t3; t41 -= av[1] * t3; t42 -= av[2] * t3; t43 -= av[3] * t3; } { const f32x4 av = *(const LAS f32x4*)(am + 248); t44 -= av[0] * t3; t45 -= av[1] * t3; t46 -= av[2] * t3; t47 -= av[3] * t3; } { const f32x4 av = *(const LAS f32x4*)(am + 252); t48 -= av[0] * t3; t49 -= av[1] * t3; t50 -= av[2] * t3; t51 -= av[3] * t3; } { const f32x4 av = *(const LAS f32x4*)(am + 256); t52 -= av[0] * t3; t53 -= av[1] * t3; t54 -= av[2] * t3; t55 -= av[3] * t3; } { const f32x4 av = *(const LAS f32x4*)(am + 260); t56 -= av[0] * t3; t57 -= av[1] * t3; t58 -= av[2] * t3; t59 -= av[3] * t3; } { const f32x4 av = *(const LAS f32x4*)(am + 264); t60 -= av[0] * t3; t61 -= av[1] * t3; t62 -= av[2] * t3; t63 -= av[3] * t3; } } asm volatile("" ::: "memory");
        { { const f32x4 av = *(const LAS f32x4*)(am + 276); t5 -= av[1] * t4; t6 -= av[2] * t4; t7 -= av[3] * t4; } { const f32x4 av = *(const LAS f32x4*)(am + 280); t8 -= av[0] * t4; t9 -= av[1] * t4; t10 -= av[2] * t4; t11 -= av[3] * t4; } { const f32x4 av = *(const LAS f32x4*)(am + 284); t12 -= av[0] * t4; t13 -= av[1] * t4; t14 -= av[2] * t4; t15 -= av[3] * t4; } { const f32x4 av = *(const LAS f32x4*)(am + 288); t16 -= av[0] * t4; t17 -= av[1] * t4; t18 -= av[2] * t4; t19 -= av[3] * t4; } { const f32x4 av = *(const LAS f32x4*)(am + 292); t20 -= av[0] * t4; t21 -= av[1] * t4; t22 -= av[2] * t4; t23 -= av[3] * t4; } { const f32x4 av = *(const LAS f32x4*)(am + 296); t24 -= av[0] * t4; t25 -= av[1] * t4; t26 -= av[2] * t4; t27 -= av[3] * t4; } { const f32x4 av = *(const LAS f32x4*)(am + 300); t28 -= av[0] * t4; t29 -= av[1] * t4; t30 -= av[2] * t4; t31 -= av[3] * t4; } { const f32x4 av = *(const LAS f32x4*)(am + 304); t32 -= av[0] * t4; t33 -= av[1] * t4; t34 -= av[2] * t4; t35 -= av[3] * t4; } { const f32x4 av = *(const LAS f32x4*)(am + 308); t36 -= av[0] * t4; t37 -= av[1] * t4; t38 -= av[2] * t4; t39 -= av[3] * t4; } { const f32x4 av = *(const LAS f32x4*)(am + 312); t40 -= av[0] * t4; t41 -= av[1] * t4; t42 -= av[2] * t4; t43 -= av[3] * t4; } { const f32x4 av = *(const LAS f32x4*)(am + 316); t44 -= av[0] * t4; t45 -= av[1] * t4; t46 -= av[2] * t4; t47 -= av[3] * t4; } { const f32x4 av = *(const LAS f32x4*)(am + 320); t48 -= av[0] * t4; t49 -= av[1] * t4; t50 -= av[2] * t4; t51 -= av[3] * t4; } { const f32x4 av = *(const LAS f32x4*)(am + 324); t52 -= av[0] * t4; t53 -= av[1] * t4; t54 -= av[2] * t4; t55 -= av[3] * t4; } { const f32x4 av = *(const LAS f32x4*)(am + 328); t56 -= av[0] * t4; t57 -= av[1] * t4; t58 -= av[2] * t4; t59 -= av[3] * t4; } { const f32x4 av = *(const LAS f32x4*)(am + 332); t60 -= av[0] * t4; t61 -= av[1] * t4; t62 -= av[2] * t4; t63 -= av[3] * t4; } } asm volatile("" ::: "memory");
        { { const f32x4 av = *(const LAS f32x4*)(am + 344); t6 -= av[2] * t5; t7 -= av[3] * t5; } { const f32x4 av = *(const LAS f32x4*)(am + 348); t8 -= av[0] * t5; t9 -= av[1] * t5; t10 -= av[2] * t5; t11 -= av[3] * t5; } { const f32x4 av = *(const LAS f32x4*)(am + 352); t12 -= av[0] * t5; t13 -= av[1] * t5; t14 -= av[2] * t5; t15 -= av[3] * t5; } { const f32x4 av = *(const LAS f32x4*)(am + 356); t16 -= av[0] * t5; t17 -= av[1] * t5; t18 -= av[2] * t5; t19 -= av[3] * t5; } { const f32x4 av = *(const LAS f32x4*)(am + 360); t20 -= av[0] * t5; t21 -= av[1] * t5; t22 -= av[2] * t5; t23 -= av[3] * t5; } { const f32x4 av = *(const LAS f32x4*)(am + 364); t24 -= av[0] * t5; t25 -= av[1] * t5; t26 -= av[2] * t5; t27 -= av[3] * t5; } { const f32x4 av = *(const LAS f32x4*)(am + 368); t28 -= av[0] * t5; t29 -= av[1] * t5; t30 -= av[2] * t5; t31 -= av[3] * t5; } { const f32x4 av = *(const LAS f32x4*)(am + 372); t32 -= av[0] * t5; t33 -= av[1] * t5; t34 -= av[2] * t5; t35 -= av[3] * t5; } { const f32x4 av = *(const LAS f32x4*)(am + 376); t36 -= av[0] * t5; t37 -= av[1] * t5; t38 -= av[2] * t5; t39 -= av[3] * t5; } { const f32x4 av = *(const LAS f32x4*)(am + 380); t40 -= av[0] * t5; t41 -= av[1] * t5; t42 -= av[2] * t5; t43 -= av[3] * t5; } { const f32x4 av = *(const LAS f32x4*)(am + 384); t44 -= av[0] * t5; t45 -= av[1] * t5; t46 -= av[2] * t5; t47 -= av[3] * t5; } { const f32x4 av = *(const LAS f32x4*)(am + 388); t48 -= av[0] * t5; t49 -= av[1] * t5; t50 -= av[2] * t5; t51 -= av[3] * t5; } { const f32x4 av = *(const LAS f32x4*)(am + 392); t52 -= av[0] * t5; t53 -= av[1] * t5; t54 -= av[2] * t5; t55 -= av[3] * t5; } { const f32x4 av = *(const LAS f32x4*)(am + 396); t56 -= av[0] * t5; t57 -= av[1] * t5; t58 -= av[2] * t5; t59 -= av[3] * t5; } { const f32x4 av = *(const LAS f32x4*)(am + 400); t60 -= av[0] * t5; t61 -= av[1] * t5; t62 -= av[2] * t5; t63 -= av[3] * t5; } } asm volatile("" ::: "memory");
        { { const f32x4 av = *(const LAS f32x4*)(am + 412); t7 -= av[3] * t6; } { const f32x4 av = *(const LAS f32x4*)(am + 416); t8 -= av[0] * t6; t9 -= av[1] * t6; t10 -= av[2] * t6; t11 -= av[3] * t6; } { const f32x4 av = *(const LAS f32x4*)(am + 420); t12 -= av[0] * t6; t13 -= av[1] * t6; t14 -= av[2] * t6; t15 -= av[3] * t6; } { const f32x4 av = *(const LAS f32x4*)(am + 424); t16 -= av[0] * t6; t17 -= av[1] * t6; t18 -= av[2] * t6; t19 -= av[3] * t6; } { const f32x4 av = *(const LAS f32x4*)(am + 428); t20 -= av[0] * t6; t21 -= av[1] * t6; t22 -= av[2] * t6; t23 -= av[3] * t6; } { const f32x4 av = *(const LAS f32x4*)(am + 432); t24 -= av[0] * t6; t25 -= av[1] * t6; t26 -= av[2] * t6; t27 -= av[3] * t6; } { const f32x4 av = *(const LAS f32x4*)(am + 436); t28 -= av[0] * t6; t29 -= av[1] * t6; t30 -= av[2] * t6; t31 -= av[3] * t6; } { const f32x4 av = *(const LAS f32x4*)(am + 440); t32 -= av[0] * t6; t33 -= av[1] * t6; t34 -= av[2] * t6; t35 -= av[3] * t6; } { const f32x4 av = *(const LAS f32x4*)(am + 444); t36 -= av[0] * t6; t37 -= av[1] * t6; t38 -= av[2] * t6; t39 -= av[3] * t6; } { const f32x4 av = *(const LAS f32x4*)(am + 448); t40 -= av[0] * t6; t41 -= av[1] * t6; t42 -= av[2] * t6; t43 -= av[3] * t6; } { const f32x4 av = *(const LAS f32x4*)(am + 452); t44 -= av[0] * t6; t45 -= av[1] * t6; t46 -= av[2] * t6; t47 -= av[3] * t6; } { const f32x4 av = *(const LAS f32x4*)(am + 456); t48 -= av[0] * t6; t49 -= av[1] * t6; t50 -= av[2] * t6; t51 -= av[3] * t6; } { const f32x4 av = *(const LAS f32x4*)(am + 460); t52 -= av[0] * t6; t53 -= av[1] * t6; t54 -= av[2] * t6; t55 -= av[3] * t6; } { const f32x4 av = *(const LAS f32x4*)(am + 464); t56 -= av[0] * t6; t57 -= av[1] * t6; t58 -= av[2] * t6; t59 -= av[3] * t6; } { const f32x4 av = *(const LAS f32x4*)(am + 468); t60 -= av[0] * t6; t61 -= av[1] * t6; t62 -= av[2] * t6; t63 -= av[3] * t6; } } asm volatile("" ::: "memory");
        { { const f32x4 av = *(const LAS f32x4*)(am + 484); t8 -= av[0] * t7; t9 -= av[1] * t7; t10 -= av[2] * t7; t11 -= av[3] * t7; } { const f32x4 av = *(const LAS f32x4*)(am + 488); t12 -= av[0] * t7; t13 -= av[1] * t7; t14 -= av[2] * t7; t15 -= av[3] * t7; } { const f32x4 av = *(const LAS f32x4*)(am + 492); t16 -= av[0] * t7; t17 -= av[1] * t7; t18 -= av[2] * t7; t19 -= av[3] * t7; } { const f32x4 av = *(const LAS f32x4*)(am + 496); t20 -= av[0] * t7; t21 -= av[1] * t7; t22 -= av[2] * t7; t23 -= av[3] * t7; } { const f32x4 av = *(const LAS f32x4*)(am + 500); t24 -= av[0] * t7; t25 -= av[1] * t7; t26 -= av[2] * t7; t27 -= av[3] * t7; } { const f32x4 av = *(const LAS f32x4*)(am + 504); t28 -= av[0] * t7; t29 -= av[1] * t7; t30 -= av[2] * t7; t31 -= av[3] * t7; } { const f32x4 av = *(const LAS f32x4*)(am + 508); t32 -= av[0] * t7; t33 -= av[1] * t7; t34 -= av[2] * t7; t35 -= av[3] * t7; } { const f32x4 av = *(const LAS f32x4*)(am + 512); t36 -= av[0] * t7; t37 -= av[1] * t7; t38 -= av[2] * t7; t39 -= av[3] * t7; } { const f32x4 av = *(const LAS f32x4*)(am + 516); t40 -= av[0] * t7; t41 -= av[1] * t7; t42 -= av[2] * t7; t43 -= av[3] * t7; } { const f32x4 av = *(const LAS f32x4*)(am + 520); t44 -= av[0] * t7; t45 -= av[1] * t7; t46 -= av[2] * t7; t47 -= av[3] * t7; } { const f32x4 av = *(const LAS f32x4*)(am + 524); t48 -= av[0] * t7; t49 -= av[1] * t7; t50 -= av[2] * t7; t51 -= av[3] * t7; } { const f32x4 av = *(const LAS f32x4*)(am + 528); t52 -= av[0] * t7; t53 -= av[1] * t7; t54 -= av[2] * t7; t55 -= av[3] * t7; } { const f32x4 av = *(const LAS f32x4*)(am + 532); t56 -= av[0] * t7; t57 -= av[1] * t7; t58 -= av[2] * t7; t59 -= av[3] * t7; } { const f32x4 av = *(const LAS f32x4*)(am + 536); t60 -= av[0] * t7; t61 -= av[1] * t7; t62 -= av[2] * t7; t63 -= av[3] * t7; } } asm volatile("" ::: "memory");
        { { const f32x4 av = *(const LAS f32x4*)(am + 552); t9 -= av[1] * t8; t10 -= av[2] * t8; t11 -= av[3] * t8; } { const f32x4 av = *(const LAS f32x4*)(am + 556); t12 -= av[0] * t8; t13 -= av[1] * t8; t14 -= av[2] * t8; t15 -= av[3] * t8; } { const f32x4 av = *(const LAS f32x4*)(am + 560); t16 -= av[0] * t8; t17 -= av[1] * t8; t18 -= av[2] * t8; t19 -= av[3] * t8; } { const f32x4 av = *(const LAS f32x4*)(am + 564); t20 -= av[0] * t8; t21 -= av[1] * t8; t22 -= av[2] * t8; t23 -= av[3] * t8; } { const f32x4 av = *(const LAS f32x4*)(am + 568); t24 -= av[0] * t8; t25 -= av[1] * t8; t26 -= av[2] * t8; t27 -= av[3] * t8; } { const f32x4 av = *(const LAS f32x4*)(am + 572); t28 -= av[0] * t8; t29 -= av[1] * t8; t30 -= av[2] * t8; t31 -= av[3] * t8; } { const f32x4 av = *(const LAS f32x4*)(am + 576); t32 -= av[0] * t8; t33 -= av[1] * t8; t34 -= av[2] * t8; t35 -= av[3] * t8; } { const f32x4 av = *(const LAS f32x4*)(am + 580); t36 -= av[0] * t8; t37 -= av[1] * t8; t38 -= av[2] * t8; t39 -= av[3] * t8; } { const f32x4 av = *(const LAS f32x4*)(am + 584); t40 -= av[0] * t8; t41 -= av[1] * t8; t42 -= av[2] * t8; t43 -= av[3] * t8; } { const f32x4 av = *(const LAS f32x4*)(am + 588); t44 -= av[0] * t8; t45 -= av[1] * t8; t46 -= av[2] * t8; t47 -= av[3] * t8; } { const f32x4 av = *(const LAS f32x4*)(am + 592); t48 -= av[0] * t8; t49 -= av[1] * t8; t50 -= av[2] * t8; t51 -= av[3] * t8; } { const f32x4 av = *(const LAS f32x4*)(am + 596); t52 -= av[0] * t8; t53 -= av[1] * t8; t54 -= av[2] * t8; t55 -= av[3] * t8; } { const f32x4 av = *(const LAS f32x4*)(am + 600); t56 -= av[0] * t8; t57 -= av[1] * t8; t58 -= av[2] * t8; t59 -= av[3] * t8; } { const f32x4 av = *(const LAS f32x4*)(am + 604); t60 -= av[0] * t8; t61 -= av[1] * t8; t62 -= av[2] * t8; t63 -= av[3] * t8; } } asm volatile("" ::: "memory");
        { { const f32x4 av = *(const LAS f32x4*)(am + 620); t10 -= av[2] * t9; t11 -= av[3] * t9; } { const f32x4 av = *(const LAS f32x4*)(am + 624); t12 -= av[0] * t9; t13 -= av[1] * t9; t14 -= av[2] * t9; t15 -= av[3] * t9; } { const f32x4 av = *(const LAS f32x4*)(am + 628); t16 -= av[0] * t9; t17 -= av[1] * t9; t18 -= av[2] * t9; t19 -= av[3] * t9; } { const f32x4 av = *(const LAS f32x4*)(am + 632); t20 -= av[0] * t9; t21 -= av[1] * t9; t22 -= av[2] * t9; t23 -= av[3] * t9; } { const f32x4 av = *(const LAS f32x4*)(am + 636); t24 -= av[0] * t9; t25 -= av[1] * t9; t26 -= av[2] * t9; t27 -= av[3] * t9; } { const f32x4 av = *(const LAS f32x4*)(am + 640); t28 -= av[0] * t9; t29 -= av[1] * t9; t30 -= av[2] * t9; t31 -= av[3] * t9; } { const f32x4 av = *(const LAS f32x4*)(am + 644); t32 -= av[0] * t9; t33 -= av[1] * t9; t34 -= av[2] * t9; t35 -= av[3] * t9; } { const f32x4 av = *(const LAS f32x4*)(am + 648); t36 -= av[0] * t9; t37 -= av[1] * t9; t38 -= av[2] * t9; t39 -= av[3] * t9; } { const f32x4 av = *(const LAS f32x4*)(am + 652); t40 -= av[0] * t9; t41 -= av[1] * t9; t42 -= av[2] * t9; t43 -= av[3] * t9; } { const f32x4 av = *(const LAS f32x4*)(am + 656); t44 -= av[0] * t9; t45 -= av[1] * t9; t46 -= av[2] * t9; t47 -= av[3] * t9; } { const f32x4 av = *(const LAS f32x4*)(am + 660); t48 -= av[0] * t9; t49 -= av[1] * t9; t50 -= av[2] * t9; t51 -= av[3] * t9; } { const f32x4 av = *(const LAS f32x4*)(am + 664); t52 -= av[0] * t9; t53 -= av[1] * t9; t54 -= av[2] * t9; t55 -= av[3] * t9; } { const f32x4 av = *(const LAS f32x4*)(am + 668); t56 -= av[0] * t9; t57 -= av[1] * t9; t58 -= av[2] * t9; t59 -= av[3] * t9; } { const f32x4 av = *(const LAS f32x4*)(am + 672); t60 -= av[0] * t9; t61 -= av[1] * t9; t62 -= av[2] * t9; t63 -= av[3] * t9; } } asm volatile("" ::: "memory");
        { { const f32x4 av = *(const LAS f32x4*)(am + 688); t11 -= av[3] * t10; } { const f32x4 av = *(const LAS f32x4*)(am + 692); t12 -= av[0] * t10; t13 -= av[1] * t10; t14 -= av[2] * t10; t15 -= av[3] * t10; } { const f32x4 av = *(const LAS f32x4*)(am + 696); t16 -= av[0] * t10; t17 -= av[1] * t10; t18 -= av[2] * t10; t19 -= av[3] * t10; } { const f32x4 av = *(const LAS f32x4*)(am + 700); t20 -= av[0] * t10; t21 -= av[1] * t10; t22 -= av[2] * t10; t23 -= av[3] * t10; } { const f32x4 av = *(const LAS f32x4*)(am + 704); t24 -= av[0] * t10; t25 -= av[1] * t10; t26 -= av[2] * t10; t27 -= av[3] * t10; } { const f32x4 av = *(const LAS f32x4*)(am + 708); t28 -= av[0] * t10; t29 -= av[1] * t10; t30 -= av[2] * t10; t31 -= av[3] * t10; } { const f32x4 av = *(const LAS f32x4*)(am + 712); t32 -= av[0] * t10; t33 -= av[1] * t10; t34 -= av[2] * t10; t35 -= av[3] * t10; } { const f32x4 av = *(const LAS f32x4*)(am + 716); t36 -= av[0] * t10; t37 -= av[1] * t10; t38 -= av[2] * t10; t39 -= av[3] * t10; } { const f32x4 av = *(const LAS f32x4*)(am + 720); t40 -= av[0] * t10; t41 -= av[1] * t10; t42 -= av[2] * t10; t43 -= av[3] * t10; } { const f32x4 av = *(const LAS f32x4*)(am + 724); t44 -= av[0] * t10; t45 -= av[1] * t10; t46 -= av[2] * t10; t47 -= av[3] * t10; } { const f32x4 av = *(const LAS f32x4*)(am + 728); t48 -= av[0] * t10; t49 -= av[1] * t10; t50 -= av[2] * t10; t51 -= av[3] * t10; } { const f32x4 av = *(const LAS f32x4*)(am + 732); t52 -= av[0] * t10; t53 -= av[1] * t10; t54 -= av[2] * t10; t55 -= av[3] * t10; } { const f32x4 av = *(const LAS f32x4*)(am + 736); t56 -= av[0] * t10; t57 -= av[1] * t10; t58 -= av[2] * t10; t59 -= av[3] * t10; } { const f32x4 av = *(const LAS f32x4*)(am + 740); t60 -= av[0] * t10; t61 -= av[1] * t10; t62 -= av[2] * t10; t63 -= av[3] * t10; } } asm volatile("" ::: "memory");
        { { const f32x4 av = *(const LAS f32x4*)(am + 760); t12 -= av[0] * t11; t13 -= av[1] * t11; t14 -= av[2] * t11; t15 -= av[3] * t11; } { const f32x4 av = *(const LAS f32x4*)(am + 764); t16 -= av[0] * t11; t17 -= av[1] * t11; t18 -= av[2] * t11; t19 -= av[3] * t11; } { const f32x4 av = *(const LAS f32x4*)(am + 768); t20 -= av[0] * t11; t21 -= av[1] * t11; t22 -= av[2] * t11; t23 -= av[3] * t11; } { const f32x4 av = *(const LAS f32x4*)(am + 772); t24 -= av[0] * t11; t25 -= av[1] * t11; t26 -= av[2] * t11; t27 -= av[3] * t11; } { const f32x4 av = *(const LAS f32x4*)(am + 776); t28 -= av[0] * t11; t29 -= av[1] * t11; t30 -= av[2] * t11; t31 -= av[3] * t11; } { const f32x4 av = *(const LAS f32x4*)(am + 780); t32 -= av[0] * t11; t33 -= av[1] * t11; t34 -= av[2] * t11; t35 -= av[3] * t11; } { const f32x4 av = *(const LAS f32x4*)(am + 784); t36 -= av[0] * t11; t37 -= av[1] * t11; t38 -= av[2] * t11; t39 -= av[3] * t11; } { const f32x4 av = *(const LAS f32x4*)(am + 788); t40 -= av[0] * t11; t41 -= av[1] * t11; t42 -= av[2] * t11; t43 -= av[3] * t11; } { const f32x4 av = *(const LAS f32x4*)(am + 792); t44 -= av[0] * t11; t45 -= av[1] * t11; t46 -= av[2] * t11; t47 -= av[3] * t11; } { const f32x4 av = *(const LAS f32x4*)(am + 796); t48 -= av[0] * t11; t49 -= av[1] * t11; t50 -= av[2] * t11; t51 -= av[3] * t11; } { const f32x4 av = *(const LAS f32x4*)(am + 800); t52 -= av[0] * t11; t53 -= av[1] * t11; t54 -= av[2] * t11; t55 -= av[3] * t11; } { const f32x4 av = *(const LAS f32x4*)(am + 804); t56 -= av[0] * t11; t57 -= av[1] * t11; t58 -= av[2] * t11; t59 -= av[3] * t11; } { const f32x4 av = *(const LAS f32x4*)(am + 808); t60 -= av[0] * t11; t61 -= av[1] * t11; t62 -= av[2] * t11; t63 -= av[3] * t11; } } asm volatile("" ::: "memory");
        { { const f32x4 av = *(const LAS f32x4*)(am + 828); t13 -= av[1] * t12; t14 -= av[2] * t12; t15 -= av[3] * t12; } { const f32x4 av = *(const LAS f32x4*)(am + 832); t16 -= av[0] * t12; t17 -= av[1] * t12; t18 -= av[2] * t12; t19 -= av[3] * t12; } { const f32x4 av = *(const LAS f32x4*)(am + 836); t20 -= av[0] * t12; t21 -= av[1] * t12; t22 -= av[2] * t12; t23 -= av[3] * t12; } { const f32x4 av = *(const LAS f32x4*)(am + 840); t24 -= av[0] * t12; t25 -= av[1] * t12; t26 -= av[2] * t12; t27 -= av[3] * t12; } { const f32x4 av = *(const LAS f32x4*)(am + 844); t28 -= av[0] * t12; t29 -= av[1] * t12; t30 -= av[2] * t12; t31 -= av[3] * t12; } { const f32x4 av = *(const LAS f32x4*)(am + 848); t32 -= av[0] * t12; t33 -= av[1] * t12; t34 -= av[2] * t12; t35 -= av[3] * t12; } { const f32x4 av = *(const LAS f32x4*)(am + 852); t36 -= av[0] * t12; t37 -= av[1] * t12; t38 -= av[2] * t12; t39 -= av[3] * t12; } { const f32x4 av = *(const LAS f32x4*)(am + 856); t40 -= av[0] * t12; t41 -= av[1] * t12; t42 -= av[2] * t12; t43 -= av[3] * t12; } { const f32x4 av = *(const LAS f32x4*)(am + 860); t44 -= av[0] * t12; t45 -= av[1] * t12; t46 -= av[2] * t12; t47 -= av[3] * t12; } { const f32x4 av = *(const LAS f32x4*)(am + 864); t48 -= av[0] * t12; t49 -= av[1] * t12; t50 -= av[2] * t12; t51 -= av[3] * t12; } { const f32x4 av = *(const LAS f32x4*)(am + 868); t52 -= av[0] * t12; t53 -= av[1] * t12; t54 -= av[2] * t12; t55 -= av[3] * t12; } { const f32x4 av = *(const LAS f32x4*)(am + 872); t56 -= av[0] * t12; t57 -= av[1] * t12; t58 -= av[2] * t12; t59 -= av[3] * t12; } { const f32x4 av = *(const LAS f32x4*)(am + 876); t60 -= av[0] * t12; t61 -= av[1] * t12; t62 -= av[2] * t12; t63 -= av[3] * t12; } } asm volatile("" ::: "memory");
        { { const f32x4 av = *(const LAS f32x4*)(am + 896); t14 -= av[2] * t13; t15 -= av[3] * t13; } { const f32x4 av = *(const LAS f32x4*)(am + 900); t16 -= av[0] * t13; t17 -= av[1] * t13; t18 -= av[2] * t13; t19 -= av[3] * t13; } { const f32x4 av = *(const LAS f32x4*)(am + 904); t20 -= av[0] * t13; t21 -= av[1] * t13; t22 -= av[2] * t13; t23 -= av[3] * t13; } { const f32x4 av = *(const LAS f32x4*)(am + 908); t24 -= av[0] * t13; t25 -= av[1] * t13; t26 -= av[2] * t13; t27 -= av[3] * t13; } { const f32x4 av = *(const LAS f32x4*)(am + 912); t28 -= av[0] * t13; t29 -= av[1] * t13; t30 -= av[2] * t13; t31 -= av[3] * t13; } { const f32x4 av = *(const LAS f32x4*)(am + 916); t32 -= av[0] * t13; t33 -= av[1] * t13; t34 -= av[2] * t13; t35 -= av[3] * t13; } { const f32x4 av = *(const LAS f32x4*)(am + 920); t36 -= av[0] * t13; t37 -= av[1] * t13; t38 -= av[2] * t13; t39 -= av[3] * t13; } { const f32x4 av = *(const LAS f32x4*)(am + 924); t40 -= av[0] * t13; t41 -= av[1] * t13; t42 -= av[2] * t13; t43 -= av[3] * t13; } { const f32x4 av = *(const LAS f32x4*)(am + 928); t44 -= av[0] * t13; t45 -= av[1] * t13; t46 -= av[2] * t13; t47 -= av[3] * t13; } { const f32x4 av = *(const LAS f32x4*)(am + 932); t48 -= av[0] * t13; t49 -= av[1] * t13; t50 -= av[2] * t13; t51 -= av[3] * t13; } { const f32x4 av = *(const LAS f32x4*)(am + 936); t52 -= av[0] * t13; t53 -= av[1] * t13; t54 -= av[2] * t13; t55 -= av[3] * t13; } { const f32x4 av = *(const LAS f32x4*)(am + 940); t56 -= av[0] * t13; t57 -= av[1] * t13; t58 -= av[2] * t13; t59 -= av[3] * t13; } { const f32x4 av = *(const LAS f32x4*)(am + 944); t60 -= av[0] * t13; t61 -= av[1] * t13; t62 -= av[2] * t13; t63 -= av[3] * t13; } } asm volatile("" ::: "memory");
        { { const f32x4 av = *(const LAS f32x4*)(am + 964); t15 -= av[3] * t14; } { const f32x4 av = *(const LAS f32x4*)(am + 968); t16 -= av[0] * t14; t17 -= av[1] * t14; t18 -= av[2] * t14; t19 -= av[3] * t14; } { const f32x4 av = *(const LAS f32x4*)(am + 972); t20 -= av[0] * t14; t21 -= av[1] * t14; t22 -= av[2] * t14; t23 -= av[3] * t14; } { const f32x4 av = *(const LAS f32x4*)(am + 976); t24 -= av[0] * t14; t25 -= av[1] * t14; t26 -= av[2] * t14; t27 -= av[3] * t14; } { const f32x4 av = *(const LAS f32x4*)(am + 980); t28 -= av[0] * t14; t29 -= av[1] * t14; t30 -= av[2] * t14; t31 -= av[3] * t14; } { const f32x4 av = *(const LAS f32x4*)(am + 984); t32 -= av[0] * t14; t33 -= av[1] * t14; t34 -= av[2] * t14; t35 -= av[3] * t14; } { const f32x4 av = *(const LAS f32x4*)(am + 988); t36 -= av[0] * t14; t37 -= av[1] * t14; t38 -= av[2] * t14; t39 -= av[3] * t14; } { const f32x4 av = *(const LAS f32x4*)(am + 992); t40 -= av[0] * t14; t41 -= av[1] * t14; t42 -= av[2] * t14; t43 -= av[3] * t14; } { const f32x4 av = *(const LAS f32x4*)(am + 996); t44 -= av[0] * t14; t45 -= av[1] * t14; t46 -= av[2] * t14; t47 -= av[3] * t14; } { const f32x4 av = *(const LAS f32x4*)(am + 1000); t48 -= av[0] * t14; t49 -= av[1] * t14; t50 -= av[2] * t14; t51 -= av[3] * t14; } { const f32x4 av = *(const LAS f32x4*)(am + 1004); t52 -= av[0] * t14; t53 -= av[1] * t14; t54 -= av[2] * t14; t55 -= av[3] * t14; } { const f32x4 av = *(const LAS f32x4*)(am + 1008); t56 -= av[0] * t14; t57 -= av[1] * t14; t58 -= av[2] * t14; t59 -= av[3] * t14; } { const f32x4 av = *(const LAS f32x4*)(am + 1012); t60 -= av[0] * t14; t61 -= av[1] * t14; t62 -= av[2] * t14; t63 -= av[3] * t14; } } asm volatile("" ::: "memory");
        { { const f32x4 av = *(const LAS f32x4*)(am + 1036); t16 -= av[0] * t15; t17 -= av[1] * t15; t18 -= av[2] * t15; t19 -= av[3] * t15; } { const f32x4 av = *(const LAS f32x4*)(am + 1040); t20 -= av[0] * t15; t21 -= av[1] * t15; t22 -= av[2] * t15; t23 -= av[3] * t15; } { const f32x4 av = *(const LAS f32x4*)(am + 1044); t24 -= av[0] * t15; t25 -= av[1] * t15; t26 -= av[2] * t15; t27 -= av[3] * t15; } { const f32x4 av = *(const LAS f32x4*)(am + 1048); t28 -= av[0] * t15; t29 -= av[1] * t15; t30 -= av[2] * t15; t31 -= av[3] * t15; } { const f32x4 av = *(const LAS f32x4*)(am + 1052); t32 -= av[0] * t15; t33 -= av[1] * t15; t34 -= av[2] * t15; t35 -= av[3] * t15; } { const f32x4 av = *(const LAS f32x4*)(am + 1056); t36 -= av[0] * t15; t37 -= av[1] * t15; t38 -= av[2] * t15; t39 -= av[3] * t15; } { const f32x4 av = *(const LAS f32x4*)(am + 1060); t40 -= av[0] * t15; t41 -= av[1] * t15; t42 -= av[2] * t15; t43 -= av[3] * t15; } { const f32x4 av = *(const LAS f32x4*)(am + 1064); t44 -= av[0] * t15; t45 -= av[1] * t15; t46 -= av[2] * t15; t47 -= av[3] * t15; } { const f32x4 av = *(const LAS f32x4*)(am + 1068); t48 -= av[0] * t15; t49 -= av[1] * t15; t50 -= av[2] * t15; t51 -= av[3] * t15; } { const f32x4 av = *(const LAS f32x4*)(am + 1072); t52 -= av[0] * t15; t53 -= av[1] * t15; t54 -= av[2] * t15; t55 -= av[3] * t15; } { const f32x4 av = *(const LAS f32x4*)(am + 1076); t56 -= av[0] * t15; t57 -= av[1] * t15; t58 -= av[2] * t15; t59 -= av[3] * t15; } { const f32x4 av = *(const LAS f32x4*)(am + 1080); t60 -= av[0] * t15; t61 -= av[1] * t15; t62 -= av[2] * t15; t63 -= av[3] * t15; } } asm volatile("" ::: "memory");
        { { const f32x4 av = *(const LAS f32x4*)(am + 1104); t17 -= av[1] * t16; t18 -= av[2] * t16; t19 -= av[3] * t16; } { const f32x4 av = *(const LAS f32x4*)(am + 1108); t20 -= av[0] * t16; t21 -= av[1] * t16; t22 -= av[2] * t16; t23 -= av[3] * t16; } { const f32x4 av = *(const LAS f32x4*)(am + 1112); t24 -= av[0] * t16; t25 -= av[1] * t16; t26 -= av[2] * t16; t27 -= av[3] * t16; } { const f32x4 av = *(const LAS f32x4*)(am + 1116); t28 -= av[0] * t16; t29 -= av[1] * t16; t30 -= av[2] * t16; t31 -= av[3] * t16; } { const f32x4 av = *(const LAS f32x4*)(am + 1120); t32 -= av[0] * t16; t33 -= av[1] * t16; t34 -= av[2] * t16; t35 -= av[3] * t16; } { const f32x4 av = *(const LAS f32x4*)(am + 1124); t36 -= av[0] * t16; t37 -= av[1] * t16; t38 -= av[2] * t16; t39 -= av[3] * t16; } { const f32x4 av = *(const LAS f32x4*)(am + 1128); t40 -= av[0] * t16; t41 -= av[1] * t16; t42 -= av[2] * t16; t43 -= av[3] * t16; } { const f32x4 av = *(const LAS f32x4*)(am + 1132); t44 -= av[0] * t16; t45 -= av[1] * t16; t46 -= av[2] * t16; t47 -= av[3] * t16; } { const f32x4 av = *(const LAS f32x4*)(am + 1136); t48 -= av[0] * t16; t49 -= av[1] * t16; t50 -= av[2] * t16; t51 -= av[3] * t16; } { const f32x4 av = *(const LAS f32x4*)(am + 1140); t52 -= av[0] * t16; t53 -= av[1] * t16; t54 -= av[2] * t16; t55 -= av[3] * t16; } { const f32x4 av = *(const LAS f32x4*)(am + 1144); t56 -= av[0] * t16; t57 -= av[1] * t16; t58 -= av[2] * t16; t59 -= av[3] * t16; } { const f32x4 av = *(const LAS f32x4*)(am + 1148); t60 -= av[0] * t16; t61 -= av[1] * t16; t62 -= av[2] * t16; t63 -= av[3] * t16; } } asm volatile("" ::: "memory");
        { { const f32x4 av = *(const LAS f32x4*)(am + 1172); t18 -= av[2] * t17; t19 -= av[3] * t17; } { const f32x4 av = *(const LAS f32x4*)(am + 1176); t20 -= av[0] * t17; t21 -= av[1] * t17; t22 -= av[2] * t17; t23 -= av[3] * t17; } { const f32x4 av = *(const LAS f32x4*)(am + 1180); t24 -= av[0] * t17; t25 -= av[1] * t17; t26 -= av[2] * t17; t27 -= av[3] * t17; } { const f32x4 av = *(const LAS f32x4*)(am + 1184); t28 -= av[0] * t17; t29 -= av[1] * t17; t30 -= av[2] * t17; t31 -= av[3] * t17; } { const f32x4 av = *(const LAS f32x4*)(am + 1188); t32 -= av[0] * t17; t33 -= av[1] * t17; t34 -= av[2] * t17; t35 -= av[3] * t17; } { const f32x4 av = *(const LAS f32x4*)(am + 1192); t36 -= av[0] * t17; t37 -= av[1] * t17; t38 -= av[2] * t17; t39 -= av[3] * t17; } { const f32x4 av = *(const LAS f32x4*)(am + 1196); t40 -= av[0] * t17; t41 -= av[1] * t17; t42 -= av[2] * t17; t43 -= av[3] * t17; } { const f32x4 av = *(const LAS f32x4*)(am + 1200); t44 -= av[0] * t17; t45 -= av[1] * t17; t46 -= av[2] * t17; t47 -= av[3] * t17; } { const f32x4 av = *(const LAS f32x4*)(am + 1204); t48 -= av[0] * t17; t49 -= av[1] * t17; t50 -= av[2] * t17; t51 -= av[3] * t17; } { const f32x4 av = *(const LAS f32x4*)(am + 1208); t52 -= av[0] * t17; t53 -= av[1] * t17; t54 -= av[2] * t17; t55 -= av[3] * t17; } { const f32x4 av = *(const LAS f32x4*)(am + 1212); t56 -= av[0] * t17; t57 -= av[1] * t17; t58 -= av[2] * t17; t59 -= av[3] * t17; } { const f32x4 av = *(const LAS f32x4*)(am + 1216); t60 -= av[0] * t17; t61 -= av[1] * t17; t62 -= av[2] * t17; t63 -= av[3] * t17; } } asm volatile("" ::: "memory");
        { { const f32x4 av = *(const LAS f32x4*)(am + 1240); t19 -= av[3] * t18; } { const f32x4 av = *(const LAS f32x4*)(am + 1244); t20 -= av[0] * t18; t21 -= av[1] * t18; t22 -= av[2] * t18; t23 -= av[3] * t18; } { const f32x4 av = *(const LAS f32x4*)(am + 1248); t24 -= av[0] * t18; t25 -= av[1] * t18; t26 -= av[2] * t18; t27 -= av[3] * t18; } { const f32x4 av = *(const LAS f32x4*)(am + 1252); t28 -= av[0] * t18; t29 -= av[1] * t18; t30 -= av[2] * t18; t31 -= av[3] * t18; } { const f32x4 av = *(const LAS f32x4*)(am + 1256); t32 -= av[0] * t18; t33 -= av[1] * t18; t34 -= av[2] * t18; t35 -= av[3] * t18; } { const f32x4 av = *(const LAS f32x4*)(am + 1260); t36 -= av[0] * t18; t37 -= av[1] * t18; t38 -= av[2] * t18; t39 -= av[3] * t18; } { const f32x4 av = *(const LAS f32x4*)(am + 1264); t40 -= av[0] * t18; t41 -= av[1] * t18; t42 -= av[2] * t18; t43 -= av[3] * t18; } { const f32x4 av = *(const LAS f32x4*)(am + 1268); t44 -= av[0] * t18; t45 -= av[1] * t18; t46 -= av[2] * t18; t47 -= av[3] * t18; } { const f32x4 av = *(const LAS f32x4*)(am + 1272); t48 -= av[0] * t18; t49 -= av[1] * t18; t50 -= av[2] * t18; t51 -= av[3] * t18; } { const f32x4 av = *(const LAS f32x4*)(am + 1276); t52 -= av[0] * t18; t53 -= av[1] * t18; t54 -= av[2] * t18; t55 -= av[3] * t18; } { const f32x4 av = *(const LAS f32x4*)(am + 1280); t56 -= av[0] * t18; t57 -= av[1] * t18; t58 -= av[2] * t18; t59 -= av[3] * t18; } { const f32x4 av = *(const LAS f32x4*)(am + 1284); t60 -= av[0] * t18; t61 -= av[1] * t18; t62 -= av[2] * t18; t63 -= av[3] * t18; } } asm volatile("" ::: "memory");
        { { const f32x4 av = *(const LAS f32x4*)(am + 1312); t20 -= av[0] * t19; t21 -= av[1] * t19; t22 -= av[2] * t19; t23 -= av[3] * t19; } { const f32x4 av = *(const LAS f32x4*)(am + 1316); t24 -= av[0] * t19; t25 -= av[1] * t19; t26 -= av[2] * t19; t27 -= av[3] * t19; } { const f32x4 av = *(const LAS f32x4*)(am + 1320); t28 -= av[0] * t19; t29 -= av[1] * t19; t30 -= av[2] * t19; t31 -= av[3] * t19; } { const f32x4 av = *(const LAS f32x4*)(am + 1324); t32 -= av[0] * t19; t33 -= av[1] * t19; t34 -= av[2] * t19; t35 -= av[3] * t19; } { const f32x4 av = *(const LAS f32x4*)(am + 1328); t36 -= av[0] * t19; t37 -= av[1] * t19; t38 -= av[2] * t19; t39 -= av[3] * t19; } { const f32x4 av = *(const LAS f32x4*)(am + 1332); t40 -= av[0] * t19; t41 -= av[1] * t19; t42 -= av[2] * t19; t43 -= av[3] * t19; } { const f32x4 av = *(const LAS f32x4*)(am + 1336); t44 -= av[0] * t19; t45 -= av[1] * t19; t46 -= av[2] * t19; t47 -= av[3] * t19; } { const f32x4 av = *(const LAS f32x4*)(am + 1340); t48 -= av[0] * t19; t49 -= av[1] * t19; t50 -= av[2] * t19; t51 -= av[3] * t19; } { const f32x4 av = *(const LAS f32x4*)(am + 1344); t52 -= av[0] * t19; t53 -= av[1] * t19; t54 -= av[2] * t19; t55 -= av[3] * t19; } { const f32x4 av = *(const LAS f32x4*)(am + 1348); t56 -= av[0] * t19; t57 -= av[1] * t19; t58 -= av[2] * t19; t59 -= av[3] * t19; } { const f32x4 av = *(const LAS f32x4*)(am + 1352); t60 -= av[0] * t19; t61 -= av[1] * t19; t62 -= av[2] * t19; t63 -= av[3] * t19; } } asm volatile("" ::: "memory");
        { { const f32x4 av = *(const LAS f32x4*)(am + 1380); t21 -= av[1] * t20; t22 -= av[2] * t20; t23 -= av[3] * t20; } { const f32x4 av = *(const LAS f32x4*)(am + 1384); t24 -= av[0] * t20; t25 -= av[1] * t20; t26 -= av[2] * t20; t27 -= av[3] * t20; } { const f32x4 av = *(const LAS f32x4*)(am + 1388); t28 -= av[0] * t20; t29 -= av[1] * t20; t30 -= av[2] * t20; t31 -= av[3] * t20; } { const f32x4 av = *(const LAS f32x4*)(am + 1392); t32 -= av[0] * t20; t33 -= av[1] * t20; t34 -= av[2] * t20; t35 -= av[3] * t20; } { const f32x4 av = *(const LAS f32x4*)(am + 1396); t36 -= av[0] * t20; t37 -= av[1] * t20; t38 -= av[2] * t20; t39 -= av[3] * t20; } { const f32x4 av = *(const LAS f32x4*)(am + 1400); t40 -= av[0] * t20; t41 -= av[1] * t20; t42 -= av[2] * t20; t43 -= av[3] * t20; } { const f32x4 av = *(const LAS f32x4*)(am + 1404); t44 -= av[0] * t20; t45 -= av[1] * t20; t46 -= av[2] * t20; t47 -= av[3] * t20; } { const f32x4 av = *(const LAS f32x4*)(am + 1408); t48 -= av[0] * t20; t49 -= av[1] * t20; t50 -= av[2] * t20; t51 -= av[3] * t20; } { const f32x4 av = *(const LAS f32x4*)(am + 1412); t52 -= av[0] * t20; t53 -= av[1] * t20; t54 -= av[2] * t20; t55 -= av[3] * t20; } { const f32x4 av = *(const LAS f32x4*)(am + 1416); t56 -= av[0] * t20; t57 -= av[1] * t20; t58 -= av[2] * t20; t59 -= av[3] * t20; } { const f32x4 av = *(const LAS f32x4*)(am + 1420); t60 -= av[0] * t20; t61 -= av[1] * t20; t62 -= av[2] * t20; t63 -= av[3] * t20; } } asm volatile("" ::: "memory");
        { { const f32x4 av = *(const LAS f32x4*)(am + 1448); t22 -= av[2] * t21; t23 -= av[3] * t21; } { const f32x4 av = *(const LAS f32x4*)(am + 1452); t24 -= av[0] * t21; t25 -= av[1] * t21; t26 -= av[2] * t21; t27 -= av[3] * t21; } { const f32x4 av = *(const LAS f32x4*)(am + 1456); t28 -= av[0] * t21; t29 -= av[1] * t21; t30 -= av[2] * t21; t31 -= av[3] * t21; } { const f32x4 av = *(const LAS f32x4*)(am + 1460); t32 -= av[0] * t21; t33 -= av[1] * t21; t34 -= av[2] * t21; t35 -= av[3] * t21; } { const f32x4 av = *(const LAS f32x4*)(am + 1464); t36 -= av[0] * t21; t37 -= av[1] * t21; t38 -= av[2] * t21; t39 -= av[3] * t21; } { const f32x4 av = *(const LAS f32x4*)(am + 1468); t40 -= av[0] * t21; t41 -= av[1] * t21; t42 -= av[2] * t21; t43 -= av[3] * t21; } { const f32x4 av = *(const LAS f32x4*)(am + 1472); t44 -= av[0] * t21; t45 -= av[1] * t21; t46 -= av[2] * t21; t47 -= av[3] * t21; } { const f32x4 av = *(const LAS f32x4*)(am + 1476); t48 -= av[0] * t21; t49 -= av[1] * t21; t50 -= av[2] * t21; t51 -= av[3] * t21; } { const f32x4 av = *(const LAS f32x4*)(am + 1480); t52 -= av[0] * t21; t53 -= av[1] * t21; t54 -= av[2] * t21; t55 -= av[3] * t21; } { const f32x4 av = *(const LAS f32x4*)(am + 1484); t56 -= av[0] * t21; t57 -= av[1] * t21; t58 -= av[2] * t21; t59 -= av[3] * t21; } { const f32x4 av = *(const LAS f32x4*)(am + 1488); t60 -= av[0] * t21; t61 -= av[1] * t21; t62 -= av[2] * t21; t63 -= av[3] * t21; } } asm volatile("" ::: "memory");
        { { const f32x4 av = *(const LAS f32x4*)(am + 1516); t23 -= av[3] * t22; } { const f32x4 av = *(const LAS f32x4*)(am + 1520); t24 -= av[0] * t22; t25 -= av[1] * t22; t26 -= av[2] * t22; t27 -= av[3] * t22; } { const f32x4 av = *(const LAS f32x4*)(am + 1524); t28 -= av[0] * t22; t29 -= av[1] * t22; t30 -= av[2] * t22; t31 -= av[3] * t22; } { const f32x4 av = *(const LAS f32x4*)(am + 1528); t32 -= av[0] * t22; t33 -= av[1] * t22; t34 -= av[2] * t22; t35 -= av[3] * t22; } { const f32x4 av = *(const LAS f32x4*)(am + 1532); t36 -= av[0] * t22; t37 -= av[1] * t22; t38 -= av[2] * t22; t39 -= av[3] * t22; } { const f32x4 av = *(const LAS f32x4*)(am + 1536); t40 -= av[0] * t22; t41 -= av[1] * t22; t42 -= av[2] * t22; t43 -= av[3] * t22; } { const f32x4 av = *(const LAS f32x4*)(am + 1540); t44 -= av[0] * t22; t45 -= av[1] * t22; t46 -= av[2] * t22; t47 -= av[3] * t22; } { const f32x4 av = *(const LAS f32x4*)(am + 1544); t48 -= av[0] * t22; t49 -= av[1] * t22; t50 -= av[2] * t22; t51 -= av[3] * t22; } { const f32x4 av = *(const LAS f32x4*)(am + 1548); t52 -= av[0] * t22; t53 -= av[1] * t22; t54 -= av[2] * t22; t55 -= av[3] * t22; } { const f32x4 av = *(const LAS f32x4*)(am + 1552); t56 -= av[0] * t22; t57 -= av[1] * t22; t58 -= av[2] * t22; t59 -= av[3] * t22; } { const f32x4 av = *(const LAS f32x4*)(am + 1556); t60 -= av[0] * t22; t61 -= av[1] * t22; t62 -= av[2] * t22; t63 -= av[3] * t22; } } asm volatile("" ::: "memory");
        { { const f32x4 av = *(const LAS f32x4*)(am + 1588); t24 -= av[0] * t23; t25 -= av[1] * t23; t26 -= av[2] * t23; t27 -= av[3] * t23; } { const f32x4 av = *(const LAS f32x4*)(am + 1592); t28 -= av[0] * t23; t29 -= av[1] * t23; t30 -= av[2] * t23; t31 -= av[3] * t23; } { const f32x4 av = *(const LAS f32x4*)(am + 1596); t32 -= av[0] * t23; t33 -= av[1] * t23; t34 -= av[2] * t23; t35 -= av[3] * t23; } { const f32x4 av = *(const LAS f32x4*)(am + 1600); t36 -= av[0] * t23; t37 -= av[1] * t23; t38 -= av[2] * t23; t39 -= av[3] * t23; } { const f32x4 av = *(const LAS f32x4*)(am + 1604); t40 -= av[0] * t23; t41 -= av[1] * t23; t42 -= av[2] * t23; t43 -= av[3] * t23; } { const f32x4 av = *(const LAS f32x4*)(am + 1608); t44 -= av[0] * t23; t45 -= av[1] * t23; t46 -= av[2] * t23; t47 -= av[3] * t23; } { const f32x4 av = *(const LAS f32x4*)(am + 1612); t48 -= av[0] * t23; t49 -= av[1] * t23; t50 -= av[2] * t23; t51 -= av[3] * t23; } { const f32x4 av = *(const LAS f32x4*)(am + 1616); t52 -= av[0] * t23; t53 -= av[1] * t23; t54 -= av[2] * t23; t55 -= av[3] * t23; } { const f32x4 av = *(const LAS f32x4*)(am + 1620); t56 -= av[0] * t23; t57 -= av[1] * t23; t58 -= av[2] * t23; t59 -= av[3] * t23; } { const f32x4 av = *(const LAS f32x4*)(am + 1624); t60 -= av[0] * t23; t61 -= av[1] * t23; t62 -= av[2] * t23; t63 -= av[3] * t23; } } asm volatile("" ::: "memory");
        { { const f32x4 av = *(const LAS f32x4*)(am + 1656); t25 -= av[1] * t24; t26 -= av[2] * t24; t27 -= av[3] * t24; } { const f32x4 av = *(const LAS f32x4*)(am + 1660); t28 -= av[0] * t24; t29 -= av[1] * t24; t30 -= av[2] * t24; t31 -= av[3] * t24; } { const f32x4 av = *(const LAS f32x4*)(am + 1664); t32 -= av[0] * t24; t33 -= av[1] * t24; t34 -= av[2] * t24; t35 -= av[3] * t24; } { const f32x4 av = *(const LAS f32x4*)(am + 1668); t36 -= av[0] * t24; t37 -= av[1] * t24; t38 -= av[2] * t24; t39 -= av[3] * t24; } { const f32x4 av = *(const LAS f32x4*)(am + 1672); t40 -= av[0] * t24; t41 -= av[1] * t24; t42 -= av[2] * t24; t43 -= av[3] * t24; } { const f32x4 av = *(const LAS f32x4*)(am + 1676); t44 -= av[0] * t24; t45 -= av[1] * t24; t46 -= av[2] * t24; t47 -= av[3] * t24; } { const f32x4 av = *(const LAS f32x4*)(am + 1680); t48 -= av[0] * t24; t49 -= av[1] * t24; t50 -= av[2] * t24; t51 -= av[3] * t24; } { const f32x4 av = *(const LAS f32x4*)(am + 1684); t52 -= av[0] * t24; t53 -= av[1] * t24; t54 -= av[2] * t24; t55 -= av[3] * t24; } { const f32x4 av = *(const LAS f32x4*)(am + 1688); t56 -= av[0] * t24; t57 -= av[1] * t24; t58 -= av[2] * t24; t59 -= av[3] * t24; } { const f32x4 av = *(const LAS f32x4*)(am + 1692); t60 -= av[0] * t24; t61 -= av[1] * t24; t62 -= av[2] * t24; t63 -= av[3] * t24; } } asm volatile("" ::: "memory");
        { { const f32x4 av = *(const LAS f32x4*)(am + 1724); t26 -= av[2] * t25; t27 -= av[3] * t25; } { const f32x4 av = *(const LAS f32x4*)(am + 1728); t28 -= av[0] * t25; t29 -= av[1] * t25; t30 -= av[2] * t25; t31 -= av[3] * t25; } { const f32x4 av = *(const LAS f32x4*)(am + 1732); t32 -= av[0] * t25; t33 -= av[1] * t25; t34 -= av[2] * t25; t35 -= av[3] * t25; } { const f32x4 av = *(const LAS f32x4*)(am + 1736); t36 -= av[0] * t25; t37 -= av[1] * t25; t38 -= av[2] * t25; t39 -= av[3] * t25; } { const f32x4 av = *(const LAS f32x4*)(am + 1740); t40 -= av[0] * t25; t41 -= av[1] * t25; t42 -= av[2] * t25; t43 -= av[3] * t25; } { const f32x4 av = *(const LAS f32x4*)(am + 1744); t44 -= av[0] * t25; t45 -= av[1] * t25; t46 -= av[2] * t25; t47 -= av[3] * t25; } { const f32x4 av = *(const LAS f32x4*)(am + 1748); t48 -= av[0] * t25; t49 -= av[1] * t25; t50 -= av[2] * t25; t51 -= av[3] * t25; } { const f32x4 av = *(const LAS f32x4*)(am + 1752); t52 -= av[0] * t25; t53 -= av[1] * t25; t54 -= av[2] * t25; t55 -= av[3] * t25; } { const f32x4 av = *(const LAS f32x4*)(am + 1756); t56 -= av[0] * t25; t57 -= av[1] * t25; t58 -= av[2] * t25; t59 -= av[3] * t25; } { const f32x4 av = *(const LAS f32x4*)(am + 1760); t60 -= av[0] * t25; t61 -= av[1] * t25; t62 -= av[2] * t25; t63 -= av[3] * t25; } } asm volatile("" ::: "memory");
        { { const f32x4 av = *(const LAS f32x4*)(am + 1792); t27 -= av[3] * t26; } { const f32x4 av = *(const LAS f32x4*)(am + 1796); t28 -= av[0] * t26; t29 -= av[1] * t26; t30 -= av[2] * t26; t31 -= av[3] * t26; } { const f32x4 av = *(const LAS f32x4*)(am + 1800); t32 -= av[0] * t26; t33 -= av[1] * t26; t34 -= av[2] * t26; t35 -= av[3] * t26; } { const f32x4 av = *(const LAS f32x4*)(am + 1804); t36 -= av[0] * t26; t37 -= av[1] * t26; t38 -= av[2] * t26; t39 -= av[3] * t26; } { const f32x4 av = *(const LAS f32x4*)(am + 1808); t40 -= av[0] * t26; t41 -= av[1] * t26; t42 -= av[2] * t26; t43 -= av[3] * t26; } { const f32x4 av = *(const LAS f32x4*)(am + 1812); t44 -= av[0] * t26; t45 -= av[1] * t26; t46 -= av[2] * t26; t47 -= av[3] * t26; } { const f32x4 av = *(const LAS f32x4*)(am + 1816); t48 -= av[0] * t26; t49 -= av[1] * t26; t50 -= av[2] * t26; t51 -= av[3] * t26; } { const f32x4 av = *(const LAS f32x4*)(am + 1820); t52 -= av[0] * t26; t53 -= av[1] * t26; t54 -= av[2] * t26; t55 -= av[3] * t26; } { const f32x4 av = *(const LAS f32x4*)(am + 1824); t56 -= av[0] * t26; t57 -= av[1] * t26; t58 -= av[2] * t26; t59 -= av[3] * t26; } { const f32x4 av = *(const LAS f32x4*)(am + 1828); t60 -= av[0] * t26; t61 -= av[1] * t26; t62 -= av[2] * t26; t63 -= av[3] * t26; } } asm volatile("" ::: "memory");
        { { const f32x4 av = *(const LAS f32x4*)(am + 1864); t28 -= av[0] * t27; t29 -= av[1] * t27; t30 -= av[2] * t27; t31 -= av[3] * t27; } { const f32x4 av = *(const LAS f32x4*)(am + 1868); t32 -= av[0] * t27; t33 -= av[1] * t27; t34 -= av[2] * t27; t35 -= av[3] * t27; } { const f32x4 av = *(const LAS f32x4*)(am + 1872); t36 -= av[0] * t27; t37 -= av[1] * t27; t38 -= av[2] * t27; t39 -= av[3] * t27; } { const f32x4 av = *(const LAS f32x4*)(am + 1876); t40 -= av[0] * t27; t41 -= av[1] * t27; t42 -= av[2] * t27; t43 -= av[3] * t27; } { const f32x4 av = *(const LAS f32x4*)(am + 1880); t44 -= av[0] * t27; t45 -= av[1] * t27; t46 -= av[2] * t27; t47 -= av[3] * t27; } { const f32x4 av = *(const LAS f32x4*)(am + 1884); t48 -= av[0] * t27; t49 -= av[1] * t27; t50 -= av[2] * t27; t51 -= av[3] * t27; } { const f32x4 av = *(const LAS f32x4*)(am + 1888); t52 -= av[0] * t27; t53 -= av[1] * t27; t54 -= av[2] * t27; t55 -= av[3] * t27; } { const f32x4 av = *(const LAS f32x4*)(am + 1892); t56 -= av[0] * t27; t57 -= av[1] * t27; t58 -= av[2] * t27; t59 -= av[3] * t27; } { const f32x4 av = *(const LAS f32x4*)(am + 1896); t60 -= av[0] * t27; t61 -= av[1] * t27; t62 -= av[2] * t27; t63 -= av[3] * t27; } } asm volatile("" ::: "memory");
        { { const f32x4 av = *(const LAS f32x4*)(am + 1932); t29 -= av[1] * t28; t30 -= av[2] * t28; t31 -= av[3] * t28; } { const f32x4 av = *(const LAS f32x4*)(am + 1936); t32 -= av[0] * t28; t33 -= av[1] * t28; t34 -= av[2] * t28; t35 -= av[3] * t28; } { const f32x4 av = *(const LAS f32x4*)(am + 1940); t36 -= av[0] * t28; t37 -= av[1] * t28; t38 -= av[2] * t28; t39 -= av[3] * t28; } { const f32x4 av = *(const LAS f32x4*)(am + 1944); t40 -= av[0] * t28; t41 -= av[1] * t28; t42 -= av[2] * t28; t43 -= av[3] * t28; } { const f32x4 av = *(const LAS f32x4*)(am + 1948); t44 -= av[0] * t28; t45 -= av[1] * t28; t46 -= av[2] * t28; t47 -= av[3] * t28; } { const f32x4 av = *(const LAS f32x4*)(am + 1952); t48 -= av[0] * t28; t49 -= av[1] * t28; t50 -= av[2] * t28; t51 -= av[3] * t28; } { const f32x4 av = *(const LAS f32x4*)(am + 1956); t52 -= av[0] * t28; t53 -= av[1] * t28; t54 -= av[2] * t28; t55 -= av[3] * t28; } { const f32x4 av = *(const LAS f32x4*)(am + 1960); t56 -= av[0] * t28; t57 -= av[1] * t28; t58 -= av[2] * t28; t59 -= av[3] * t28; } { const f32x4 av = *(const LAS f32x4*)(am + 1964); t60 -= av[0] * t28; t61 -= av[1] * t28; t62 -= av[2] * t28; t63 -= av[3] * t28; } } asm volatile("" ::: "memory");
        { { const f32x4 av = *(const LAS f32x4*)(am + 2000); t30 -= av[2] * t29; t31 -= av[3] * t29; } { const f32x4 av = *(const LAS f32x4*)(am + 2004); t32 -= av[0] * t29; t33 -= av[1] * t29; t34 -= av[2] * t29; t35 -= av[3] * t29; } { const f32x4 av = *(const LAS f32x4*)(am + 2008); t36 -= av[0] * t29; t37 -= av[1] * t29; t38 -= av[2] * t29; t39 -= av[3] * t29; } { const f32x4 av = *(const LAS f32x4*)(am + 2012); t40 -= av[0] * t29; t41 -= av[1] * t29; t42 -= av[2] * t29; t43 -= av[3] * t29; } { const f32x4 av = *(const LAS f32x4*)(am + 2016); t44 -= av[0] * t29; t45 -= av[1] * t29; t46 -= av[2] * t29; t47 -= av[3] * t29; } { const f32x4 av = *(const LAS f32x4*)(am + 2020); t48 -= av[0] * t29; t49 -= av[1] * t29; t50 -= av[2] * t29; t51 -= av[3] * t29; } { const f32x4 av = *(const LAS f32x4*)(am + 2024); t52 -= av[0] * t29; t53 -= av[1] * t29; t54 -= av[2] * t29; t55 -= av[3] * t29; } { const f32x4 av = *(const LAS f32x4*)(am + 2028); t56 -= av[0] * t29; t57 -= av[1] * t29; t58 -= av[2] * t29; t59 -= av[3] * t29; } { const f32x4 av = *(const LAS f32x4*)(am + 2032); t60 -= av[0] * t29; t61 -= av[1] * t29; t62 -= av[2] * t29; t63 -= av[3] * t29; } } asm volatile("" ::: "memory");
        { { const f32x4 av = *(const LAS f32x4*)(am + 2068); t31 -= av[3] * t30; } { const f32x4 av = *(const LAS f32x4*)(am + 2072); t32 -= av[0] * t30; t33 -= av[1] * t30; t34 -= av[2] * t30; t35 -= av[3] * t30; } { const f32x4 av = *(const LAS f32x4*)(am + 2076); t36 -= av[0] * t30; t37 -= av[1] * t30; t38 -= av[2] * t30; t39 -= av[3] * t30; } { const f32x4 av = *(const LAS f32x4*)(am + 2080); t40 -= av[0] * t30; t41 -= av[1] * t30; t42 -= av[2] * t30; t43 -= av[3] * t30; } { const f32x4 av = *(const LAS f32x4*)(am + 2084); t44 -= av[0] * t30; t45 -= av[1] * t30; t46 -= av[2] * t30; t47 -= av[3] * t30; } { const f32x4 av = *(const LAS f32x4*)(am + 2088); t48 -= av[0] * t30; t49 -= av[1] * t30; t50 -= av[2] * t30; t51 -= av[3] * t30; } { const f32x4 av = *(const LAS f32x4*)(am + 2092); t52 -= av[0] * t30; t53 -= av[1] * t30; t54 -= av[2] * t30; t55 -= av[3] * t30; } { const f32x4 av = *(const LAS f32x4*)(am + 2096); t56 -= av[0] * t30; t57 -= av[1] * t30; t58 -= av[2] * t30; t59 -= av[3] * t30; } { const f32x4 av = *(const LAS f32x4*)(am + 2100); t60 -= av[0] * t30; t61 -= av[1] * t30; t62 -= av[2] * t30; t63 -= av[3] * t30; } } asm volatile("" ::: "memory");
        { { const f32x4 av = *(const LAS f32x4*)(am + 2140); t32 -= av[0] * t31; t33 -= av[1] * t31; t34 -= av[2] * t31; t35 -= av[3] * t31; } { const f32x4 av = *(const LAS f32x4*)(am + 2144); t36 -= av[0] * t31; t37 -= av[1] * t31; t38 -= av[2] * t31; t39 -= av[3] * t31; } { const f32x4 av = *(const LAS f32x4*)(am + 2148); t40 -= av[0] * t31; t41 -= av[1] * t31; t42 -= av[2] * t31; t43 -= av[3] * t31; } { const f32x4 av = *(const LAS f32x4*)(am + 2152); t44 -= av[0] * t31; t45 -= av[1] * t31; t46 -= av[2] * t31; t47 -= av[3] * t31; } { const f32x4 av = *(const LAS f32x4*)(am + 2156); t48 -= av[0] * t31; t49 -= av[1] * t31; t50 -= av[2] * t31; t51 -= av[3] * t31; } { const f32x4 av = *(const LAS f32x4*)(am + 2160); t52 -= av[0] * t31; t53 -= av[1] * t31; t54 -= av[2] * t31; t55 -= av[3] * t31; } { const f32x4 av = *(const LAS f32x4*)(am + 2164); t56 -= av[0] * t31; t57 -= av[1] * t31; t58 -= av[2] * t31; t59 -= av[3] * t31; } { const f32x4 av = *(const LAS f32x4*)(am + 2168); t60 -= av[0] * t31; t61 -= av[1] * t31; t62 -= av[2] * t31; t63 -= av[3] * t31; } } asm volatile("" ::: "memory");
        { { const f32x4 av = *(const LAS f32x4*)(am + 2208); t33 -= av[1] * t32; t34 -= av[2] * t32; t35 -= av[3] * t32; } { const f32x4 av = *(const LAS f32x4*)(am + 2212); t36 -= av[0] * t32; t37 -= av[1] * t32; t38 -= av[2] * t32; t39 -= av[3] * t32; } { const f32x4 av = *(const LAS f32x4*)(am + 2216); t40 -= av[0] * t32; t41 -= av[1] * t32; t42 -= av[2] * t32; t43 -= av[3] * t32; } { const f32x4 av = *(const LAS f32x4*)(am + 2220); t44 -= av[0] * t32; t45 -= av[1] * t32; t46 -= av[2] * t32; t47 -= av[3] * t32; } { const f32x4 av = *(const LAS f32x4*)(am + 2224); t48 -= av[0] * t32; t49 -= av[1] * t32; t50 -= av[2] * t32; t51 -= av[3] * t32; } { const f32x4 av = *(const LAS f32x4*)(am + 2228); t52 -= av[0] * t32; t53 -= av[1] * t32; t54 -= av[2] * t32; t55 -= av[3] * t32; } { const f32x4 av = *(const LAS f32x4*)(am + 2232); t56 -= av[0] * t32; t57 -= av[1] * t32; t58 -= av[2] * t32; t59 -= av[3] * t32; } { const f32x4 av = *(const LAS f32x4*)(am + 2236); t60 -= av[0] * t32; t61 -= av[1] * t32; t62 -= av[2] * t32; t63 -= av[3] * t32; } } asm volatile("" ::: "memory");
        { { const f32x4 av = *(const LAS f32x4*)(am + 2276); t34 -= av[2] * t33; t35 -= av[3] * t33; } { const f32x4 av = *(const LAS f32x4*)(am + 2280); t36 -= av[0] * t33; t37 -= av[1] * t33; t38 -= av[2] * t33; t39 -= av[3] * t33; } { const f32x4 av = *(const LAS f32x4*)(am + 2284); t40 -= av[0] * t33; t41 -= av[1] * t33; t42 -= av[2] * t33; t43 -= av[3] * t33; } { const f32x4 av = *(const LAS f32x4*)(am + 2288); t44 -= av[0] * t33; t45 -= av[1] * t33; t46 -= av[2] * t33; t47 -= av[3] * t33; } { const f32x4 av = *(const LAS f32x4*)(am + 2292); t48 -= av[0] * t33; t49 -= av[1] * t33; t50 -= av[2] * t33; t51 -= av[3] * t33; } { const f32x4 av = *(const LAS f32x4*)(am + 2296); t52 -= av[0] * t33; t53 -= av[1] * t33; t54 -= av[2] * t33; t55 -= av[3] * t33; } { const f32x4 av = *(const LAS f32x4*)(am + 2300); t56 -= av[0] * t33; t57 -= av[1] * t33; t58 -= av[2] * t33; t59 -= av[3] * t33; } { const f32x4 av = *(const LAS f32x4*)(am + 2304); t60 -= av[0] * t33; t61 -= av[1] * t33; t62 -= av[2] * t33; t63 -= av[3] * t33; } } asm volatile("" ::: "memory");
        { { const f32x4 av = *(const LAS f32x4*)(am + 2344); t35 -= av[3] * t34; } { const f32x4 av = *(const LAS f32x4*)(am + 2348); t36 -= av[0] * t34; t37 -= av[1] * t34; t38 -= av[2] * t34; t39 -= av[3] * t34; } { const f32x4 av = *(const LAS f32x4*)(am + 2352); t40 -= av[0] * t34; t41 -= av[1] * t34; t42 -= av[2] * t34; t43 -= av[3] * t34; } { const f32x4 av = *(const LAS f32x4*)(am + 2356); t44 -= av[0] * t34; t45 -= av[1] * t34; t46 -= av[2] * t34; t47 -= av[3] * t34; } { const f32x4 av = *(const LAS f32x4*)(am + 2360); t48 -= av[0] * t34; t49 -= av[1] * t34; t50 -= av[2] * t34; t51 -= av[3] * t34; } { const f32x4 av = *(const LAS f32x4*)(am + 2364); t52 -= av[0] * t34; t53 -= av[1] * t34; t54 -= av[2] * t34; t55 -= av[3] * t34; } { const f32x4 av = *(const LAS f32x4*)(am + 2368); t56 -= av[0] * t34; t57 -= av[1] * t34; t58 -= av[2] * t34; t59 -= av[3] * t34; } { const f32x4 av = *(const LAS f32x4*)(am + 2372); t60 -= av[0] * t34; t61 -= av[1] * t34; t62 -= av[2] * t34; t63 -= av[3] * t34; } } asm volatile("" ::: "memory");
        { { const f32x4 av = *(const LAS f32x4*)(am + 2416); t36 -= av[0] * t35; t37 -= av[1] * t35; t38 -= av[2] * t35; t39 -= av[3] * t35; } { const f32x4 av = *(const LAS f32x4*)(am + 2420); t40 -= av[0] * t35; t41 -= av[1] * t35; t42 -= av[2] * t35; t43 -= av[3] * t35; } { const f32x4 av = *(const LAS f32x4*)(am + 2424); t44 -= av[0] * t35; t45 -= av[1] * t35; t46 -= av[2] * t35; t47 -= av[3] * t35; } { const f32x4 av = *(const LAS f32x4*)(am + 2428); t48 -= av[0] * t35; t49 -= av[1] * t35; t50 -= av[2] * t35; t51 -= av[3] * t35; } { const f32x4 av = *(const LAS f32x4*)(am + 2432); t52 -= av[0] * t35; t53 -= av[1] * t35; t54 -= av[2] * t35; t55 -= av[3] * t35; } { const f32x4 av = *(const LAS f32x4*)(am + 2436); t56 -= av[0] * t35; t57 -= av[1] * t35; t58 -= av[2] * t35; t59 -= av[3] * t35; } { const f32x4 av = *(const LAS f32x4*)(am + 2440); t60 -= av[0] * t35; t61 -= av[1] * t35; t62 -= av[2] * t35; t63 -= av[3] * t35; } } asm volatile("" ::: "memory");
        { { const f32x4 av = *(const LAS f32x4*)(am + 2484); t37 -= av[1] * t36; t38 -= av[2] * t36; t39 -= av[3] * t36; } { const f32x4 av = *(const LAS f32x4*)(am + 2488); t40 -= av[0] * t36; t41 -= av[1] * t36; t42 -= av[2] * t36; t43 -= av[3] * t36; } { const f32x4 av = *(const LAS f32x4*)(am + 2492); t44 -= av[0] * t36; t45 -= av[1] * t36; t46 -= av[2] * t36; t47 -= av[3] * t36; } { const f32x4 av = *(const LAS f32x4*)(am + 2496); t48 -= av[0] * t36; t49 -= av[1] * t36; t50 -= av[2] * t36; t51 -= av[3] * t36; } { const f32x4 av = *(const LAS f32x4*)(am + 2500); t52 -= av[0] * t36; t53 -= av[1] * t36; t54 -= av[2] * t36; t55 -= av[3] * t36; } { const f32x4 av = *(const LAS f32x4*)(am + 2504); t56 -= av[0] * t36; t57 -= av[1] * t36; t58 -= av[2] * t36; t59 -= av[3] * t36; } { const f32x4 av = *(const LAS f32x4*)(am + 2508); t60 -= av[0] * t36; t61 -= av[1] * t36; t62 -= av[2] * t36; t63 -= av[3] * t36; } } asm volatile("" ::: "memory");
        { { const f32x4 av = *(const LAS f32x4*)(am + 2552); t38 -= av[2] * t37; t39 -= av[3] * t37; } { const f32x4 av = *(const LAS f32x4*)(am + 2556); t40 -= av[0] * t37; t41 -= av[1] * t37; t42 -= av[2] * t37; t43 -= av[3] * t37; } { const f32x4 av = *(const LAS f32x4*)(am + 2560); t44 -= av[0] * t37; t45 -= av[1] * t37; t46 -= av[2] * t37; t47 -= av[3] * t37; } { const f32x4 av = *(const LAS f32x4*)(am + 2564); t48 -= av[0] * t37; t49 -= av[1] * t37; t50 -= av[2] * t37; t51 -= av[3] * t37; } { const f32x4 av = *(const LAS f32x4*)(am + 2568); t52 -= av[0] * t37; t53 -= av[1] * t37; t54 -= av[2] * t37; t55 -= av[3] * t37; } { const f32x4 av = *(const LAS f32x4*)(am + 2572); t56 -= av[0] * t37; t57 -= av[1] * t37; t58 -= av[2] * t37; t59 -= av[3] * t37; } { const f32x4 av = *(const LAS f32x4*)(am + 2576); t60 -= av[0] * t37; t61 -= av[1] * t37; t62 -= av[2] * t37; t63 -= av[3] * t37; } } asm volatile("" ::: "memory");
        { { const f32x4 av = *(const LAS f32x4*)(am + 2620); t39 -= av[3] * t38; } { const f32x4 av = *(const LAS f32x4*)(am + 2624); t40 -= av[0] * t38; t41 -= av[1] * t38; t42 -= av[2] * t38; t43 -= av[3] * t38; } { const f32x4 av = *(const LAS f32x4*)(am + 2628); t44 -= av[0] * t38; t45 -= av[1] * t38; t46 -= av[2] * t38; t47 -= av[3] * t38; } { const f32x4 av = *(const LAS f32x4*)(am + 2632); t48 -= av[0] * t38; t49 -= av[1] * t38; t50 -= av[2] * t38; t51 -= av[3] * t38; } { const f32x4 av = *(const LAS f32x4*)(am + 2636); t52 -= av[0] * t38; t53 -= av[1] * t38; t54 -= av[2] * t38; t55 -= av[3] * t38; } { const f32x4 av = *(const LAS f32x4*)(am + 2640); t56 -= av[0] * t38; t57 -= av[1] * t38; t58 -= av[2] * t38; t59 -= av[3] * t38; } { const f32x4 av = *(const LAS f32x4*)(am + 2644); t60 -= av[0] * t38; t61 -= av[1] * t38; t62 -= av[2] * t38; t63 -= av[3] * t38; } } asm volatile("" ::: "memory");
        { { const f32x4 av = *(const LAS f32x4*)(am + 2692); t40 -= av[0] * t39; t41 -= av[1] * t39; t42 -= av[2] * t39; t43 -= av[3] * t39; } { const f32x4 av = *(const LAS f32x4*)(am + 2696); t44 -= av[0] * t39; t45 -= av[1] * t39; t46 -= av[2] * t39; t47 -= av[3] * t39; } { const f32x4 av = *(const LAS f32x4*)(am + 2700); t48 -= av[0] * t39; t49 -= av[1] * t39; t50 -= av[2] * t39; t51 -= av[3] * t39; } { const f32x4 av = *(const LAS f32x4*)(am + 2704); t52 -= av[0] * t39; t53 -= av[1] * t39; t54 -= av[2] * t39; t55 -= av[3] * t39; } { const f32x4 av = *(const LAS f32x4*)(am + 2708); t56 -= av[0] * t39; t57 -= av[1] * t39; t58 -= av[2] * t39; t59 -= av[3] * t39; } { const f32x4 av = *(const LAS f32x4*)(am + 2712); t60 -= av[0] * t39; t61 -= av[1] * t39; t62 -= av[2] * t39; t63 -= av[3] * t39; } } asm volatile("" ::: "memory");
        { { const f32x4 av = *(const LAS f32x4*)(am + 2760); t41 -= av[1] * t40; t42 -= av[2] * t40; t43 -= av[3] * t40; } { const f32x4 av = *(const LAS f32x4*)(am + 2764); t44 -= av[0] * t40; t45 -= av[1] * t40; t46 -= av[2] * t40; t47 -= av[3] * t40; } { const f32x4 av = *(const LAS f32x4*)(am + 2768); t48 -= av[0] * t40; t49 -= av[1] * t40; t50 -= av[2] * t40; t51 -= av[3] * t40; } { const f32x4 av = *(const LAS f32x4*)(am + 2772); t52 -= av[0] * t40; t53 -= av[1] * t40; t54 -= av[2] * t40; t55 -= av[3] * t40; } { const f32x4 av = *(const LAS f32x4*)(am + 2776); t56 -= av[0] * t40; t57 -= av[1] * t40; t58 -= av[2] * t40; t59 -= av[3] * t40; } { const f32x4 av = *(const LAS f32x4*)(am + 2780); t60 -= av[0] * t40; t61 -= av[1] * t40; t62 -= av[2] * t40; t63 -= av[3] * t40; } } asm volatile("" ::: "memory");
        { { const f32x4 av = *(const LAS f32x4*)(am + 2828); t42 -= av[2] * t41; t43 -= av[3] * t41; } { const f32x4 av = *(const LAS f32x4*)(am + 2832); t44 -= av[0] * t41; t45 -= av[1] * t41; t46 -= av[2] * t41; t47 -= av[3] * t41; } { const f32x4 av = *(const LAS f32x4*)(am + 2836); t48 -= av[0] * t41; t49 -= av[1] * t41; t50 -= av[2] * t41; t51 -= av[3] * t41; } { const f32x4 av = *(const LAS f32x4*)(am + 2840); t52 -= av[0] * t41; t53 -= av[1] * t41; t54 -= av[2] * t41; t55 -= av[3] * t41; } { const f32x4 av = *(const LAS f32x4*)(am + 2844); t56 -= av[0] * t41; t57 -= av[1] * t41; t58 -= av[2] * t41; t59 -= av[3] * t41; } { const f32x4 av = *(const LAS f32x4*)(am + 2848); t60 -= av[0] * t41; t61 -= av[1] * t41; t62 -= av[2] * t41; t63 -= av[3] * t41; } } asm volatile("" ::: "memory");
        { { const f32x4 av = *(const LAS f32x4*)(am + 2896); t43 -= av[3] * t42; } { const f32x4 av = *(const LAS f32x4*)(am + 2900); t44 -= av[0] * t42; t45 -= av[1] * t42; t46 -= av[2] * t42; t47 -= av[3] * t42; } { const f32x4 av = *(const LAS f32x4*)(am + 2904); t48 -= av[0] * t42; t49 -= av[1] * t42; t50 -= av[2] * t42; t51 -= av[3] * t42; } { const f32x4 av = *(const LAS f32x4*)(am + 2908); t52 -= av[0] * t42; t53 -= av[1] * t42; t54 -= av[2] * t42; t55 -= av[3] * t42; } { const f32x4 av = *(const LAS f32x4*)(am + 2912); t56 -= av[0] * t42; t57 -= av[1] * t42; t58 -= av[2] * t42; t59 -= av[3] * t42; } { const f32x4 av = *(const LAS f32x4*)(am + 2916); t60 -= av[0] * t42; t61 -= av[1] * t42; t62 -= av[2] * t42; t63 -= av[3] * t42; } } asm volatile("" ::: "memory");
        { { const f32x4 av = *(const LAS f32x4*)(am + 2968); t44 -= av[0] * t43; t45 -= av[1] * t43; t46 -= av[2] * t43; t47 -= av[3] * t43; } { const f32x4 av = *(const LAS f32x4*)(am + 2972); t48 -= av[0] * t43; t49 -= av[1] * t43; t50 -= av[2] * t43; t51 -= av[3] * t43; } { const f32x4 av = *(const LAS f32x4*)(am + 2976); t52 -= av[0] * t43; t53 -= av[1] * t43; t54 -= av[2] * t43; t55 -= av[3] * t43; } { const f32x4 av = *(const LAS f32x4*)(am + 2980); t56 -= av[0] * t43; t57 -= av[1] * t43; t58 -= av[2] * t43; t59 -= av[3] * t43; } { const f32x4 av = *(const LAS f32x4*)(am + 2984); t60 -= av[0] * t43; t61 -= av[1] * t43; t62 -= av[2] * t43; t63 -= av[3] * t43; } } asm volatile("" ::: "memory");
        { { const f32x4 av = *(const LAS f32x4*)(am + 3036); t45 -= av[1] * t44; t46 -= av[2] * t44; t47 -= av[3] * t44; } { const f32x4 av = *(const LAS f32x4*)(am + 3040); t48 -= av[0] * t44; t49 -= av[1] * t44; t50 -= av[2] * t44; t51 -= av[3] * t44; } { const f32x4 av = *(const LAS f32x4*)(am + 3044); t52 -= av[0] * t44; t53 -= av[1] * t44; t54 -= av[2] * t44; t55 -= av[3] * t44; } { const f32x4 av = *(const LAS f32x4*)(am + 3048); t56 -= av[0] * t44; t57 -= av[1] * t44; t58 -= av[2] * t44; t59 -= av[3] * t44; } { const f32x4 av = *(const LAS f32x4*)(am + 3052); t60 -= av[0] * t44; t61 -= av[1] * t44; t62 -= av[2] * t44; t63 -= av[3] * t44; } } asm volatile("" ::: "memory");
        { { const f32x4 av = *(const LAS f32x4*)(am + 3104); t46 -= av[2] * t45; t47 -= av[3] * t45; } { const f32x4 av = *(const LAS f32x4*)(am + 3108); t48 -= av[0] * t45; t49 -= av[1] * t45; t50 -= av[2] * t45; t51 -= av[3] * t45; } { const f32x4 av = *(const LAS f32x4*)(am + 3112); t52 -= av[0] * t45; t53 -= av[1] * t45; t54 -= av[2] * t45; t55 -= av[3] * t45; } { const f32x4 av = *(const LAS f32x4*)(am + 3116); t56 -= av[0] * t45; t57 -= av[1] * t45; t58 -= av[2] * t45; t59 -= av[3] * t45; } { const f32x4 av = *(const LAS f32x4*)(am + 3120); t60 -= av[0] * t45; t61 -= av[1] * t45; t62 -= av[2] * t45; t63 -= av[3] * t45; } } asm volatile("" ::: "memory");
        { { const f32x4 av = *(const LAS f32x4*)(am + 3172); t47 -= av[3] * t46; } { const f32x4 av = *(const LAS f32x4*)(am + 3176); t48 -= av[0] * t46; t49 -= av[1] * t46; t50 -= av[2] * t46; t51 -= av[3] * t46; } { const f32x4 av = *(const LAS f32x4*)(am + 3180); t52 -= av[0] * t46; t53 -= av[1] * t46; t54 -= av[2] * t46; t55 -= av[3] * t46; } { const f32x4 av = *(const LAS f32x4*)(am + 3184); t56 -= av[0] * t46; t57 -= av[1] * t46; t58 -= av[2] * t46; t59 -= av[3] * t46; } { const f32x4 av = *(const LAS f32x4*)(am + 3188); t60 -= av[0] * t46; t61 -= av[1] * t46; t62 -= av[2] * t46; t63 -= av[3] * t46; } } asm volatile("" ::: "memory");
        { { const f32x4 av = *(const LAS f32x4*)(am + 3244); t48 -= av[0] * t47; t49 -= av[1] * t47; t50 -= av[2] * t47; t51 -= av[3] * t47; } { const f32x4 av = *(const LAS f32x4*)(am + 3248); t52 -= av[0] * t47; t53 -= av[1] * t47; t54 -= av[2] * t47; t55 -= av[3] * t47; } { const f32x4 av = *(const LAS f32x4*)(am + 3252); t56 -= av[0] * t47; t57 -= av[1] * t47; t58 -= av[2] * t47; t59 -= av[3] * t47; } { const f32x4 av = *(const LAS f32x4*)(am + 3256); t60 -= av[0] * t47; t61 -= av[1] * t47; t62 -= av[2] * t47; t63 -= av[3] * t47; } } asm volatile("" ::: "memory");
        { { const f32x4 av = *(const LAS f32x4*)(am + 3312); t49 -= av[1] * t48; t50 -= av[2] * t48; t51 -= av[3] * t48; } { const f32x4 av = *(const LAS f32x4*)(am + 3316); t52 -= av[0] * t48; t53 -= av[1] * t48; t54 -= av[2] * t48; t55 -= av[3] * t48; } { const f32x4 av = *(const LAS f32x4*)(am + 3320); t56 -= av[0] * t48; t57 -= av[1] * t48; t58 -= av[2] * t48; t59 -= av[3] * t48; } { const f32x4 av = *(const LAS f32x4*)(am + 3324); t60 -= av[0] * t48; t61 -= av[1] * t48; t62 -= av[2] * t48; t63 -= av[3] * t48; } } asm volatile("" ::: "memory");
        { { const f32x4 av = *(const LAS f32x4*)(am + 3380); t50 -= av[2] * t49; t51 -= av[3] * t49; } { const f32x4 av = *(const LAS f32x4*)(am + 3384); t52 -= av[0] * t49; t53 -= av[1] * t49; t54 -= av[2] * t49; t55 -= av[3] * t49; } { const f32x4 av = *(const LAS f32x4*)(am + 3388); t56 -= av[0] * t49; t57 -= av[1] * t49; t58 -= av[2] * t49; t59 -= av[3] * t49; } { const f32x4 av = *(const LAS f32x4*)(am + 3392); t60 -= av[0] * t49; t61 -= av[1] * t49; t62 -= av[2] * t49; t63 -= av[3] * t49; } } asm volatile("" ::: "memory");
        { { const f32x4 av = *(const LAS f32x4*)(am + 3448); t51 -= av[3] * t50; } { const f32x4 av = *(const LAS f32x4*)(am + 3452); t52 -= av[0] * t50; t53 -= av[1] * t50; t54 -= av[2] * t50; t55 -= av[3] * t50; } { const f32x4 av = *(const LAS f32x4*)(am + 3456); t56 -= av[0] * t50; t57 -= av[1] * t50; t58 -= av[2] * t50; t59 -= av[3] * t50; } { const f32x4 av = *(const LAS f32x4*)(am + 3460); t60 -= av[0] * t50; t61 -= av[1] * t50; t62 -= av[2] * t50; t63 -= av[3] * t50; } } asm volatile("" ::: "memory");
        { { const f32x4 av = *(const LAS f32x4*)(am + 3520); t52 -= av[0] * t51; t53 -= av[1] * t51; t54 -= av[2] * t51; t55 -= av[3] * t51; } { const f32x4 av = *(const LAS f32x4*)(am + 3524); t56 -= av[0] * t51; t57 -= av[1] * t51; t58 -= av[2] * t51; t59 -= av[3] * t51; } { const f32x4 av = *(const LAS f32x4*)(am + 3528); t60 -= av[0] * t51; t61 -= av[1] * t51; t62 -= av[2] * t51; t63 -= av[3] * t51; } } asm volatile("" ::: "memory");
        { { const f32x4 av = *(const LAS f32x4*)(am + 3588); t53 -= av[1] * t52; t54 -= av[2] * t52; t55 -= av[3] * t52; } { const f32x4 av = *(const LAS f32x4*)(am + 3592); t56 -= av[0] * t52; t57 -= av[1] * t52; t58 -= av[2] * t52; t59 -= av[3] * t52; } { const f32x4 av = *(const LAS f32x4*)(am + 3596); t60 -= av[0] * t52; t61 -= av[1] * t52; t62 -= av[2] * t52; t63 -= av[3] * t52; } } asm volatile("" ::: "memory");
        { { const f32x4 av = *(const LAS f32x4*)(am + 3656); t54 -= av[2] * t53; t55 -= av[3] * t53; } { const f32x4 av = *(const LAS f32x4*)(am + 3660); t56 -= av[0] * t53; t57 -= av[1] * t53; t58 -= av[2] * t53; t59 -= av[3] * t53; } { const f32x4 av = *(const LAS f32x4*)(am + 3664); t60 -= av[0] * t53; t61 -= av[1] * t53; t62 -= av[2] * t53; t63 -= av[3] * t53; } } asm volatile("" ::: "memory");
        { { const f32x4 av = *(const LAS f32x4*)(am + 3724); t55 -= av[3] * t54; } { const f32x4 av = *(const LAS f32x4*)(am + 3728); t56 -= av[0] * t54; t57 -= av[1] * t54; t58 -= av[2] * t54; t59 -= av[3] * t54; } { const f32x4 av = *(const LAS f32x4*)(am + 3732); t60 -= av[0] * t54; t61 -= av[1] * t54; t62 -= av[2] * t54; t63 -= av[3] * t54; } } asm volatile("" ::: "memory");
        { { const f32x4 av = *(const LAS f32x4*)(am + 3796); t56 -= av[0] * t55; t57 -= av[1] * t55; t58 -= av[2] * t55; t59 -= av[3] * t55; } { const f32x4 av = *(const LAS f32x4*)(am + 3800); t60 -= av[0] * t55; t61 -= av[1] * t55; t62 -= av[2] * t55; t63 -= av[3] * t55; } } asm volatile("" ::: "memory");
        { { const f32x4 av = *(const LAS f32x4*)(am + 3864); t57 -= av[1] * t56; t58 -= av[2] * t56; t59 -= av[3] * t56; } { const f32x4 av = *(const LAS f32x4*)(am + 3868); t60 -= av[0] * t56; t61 -= av[1] * t56; t62 -= av[2] * t56; t63 -= av[3] * t56; } } asm volatile("" ::: "memory");
        { { const f32x4 av = *(const LAS f32x4*)(am + 3932); t58 -= av[2] * t57; t59 -= av[3] * t57; } { const f32x4 av = *(const LAS f32x4*)(am + 3936); t60 -= av[0] * t57; t61 -= av[1] * t57; t62 -= av[2] * t57; t63 -= av[3] * t57; } } asm volatile("" ::: "memory");
        { { const f32x4 av = *(const LAS f32x4*)(am + 4000); t59 -= av[3] * t58; } { const f32x4 av = *(const LAS f32x4*)(am + 4004); t60 -= av[0] * t58; t61 -= av[1] * t58; t62 -= av[2] * t58; t63 -= av[3] * t58; } } asm volatile("" ::: "memory");
        { { const f32x4 av = *(const LAS f32x4*)(am + 4072); t60 -= av[0] * t59; t61 -= av[1] * t59; t62 -= av[2] * t59; t63 -= av[3] * t59; } } asm volatile("" ::: "memory");
        { { const f32x4 av = *(const LAS f32x4*)(am + 4140); t61 -= av[1] * t60; t62 -= av[2] * t60; t63 -= av[3] * t60; } } asm volatile("" ::: "memory");
        { { const f32x4 av = *(const LAS f32x4*)(am + 4208); t62 -= av[2] * t61; t63 -= av[3] * t61; } } asm volatile("" ::: "memory");
        { { const f32x4 av = *(const LAS f32x4*)(am + 4276); t63 -= av[3] * t62; } } asm volatile("" ::: "memory");
        const float bc = tab[192 + lane], bec = bc * tab[64 + lane];
        unsigned tpb = (unsigned)(uintptr_t)(lds + GA_TP) + lane * 2; asm volatile("" : "+v"(tpb));
        *(LAS bf16*)(uintptr_t)(tpb + 0) = (bf16)f2bf(t0 * bc); *(LAS bf16*)(uintptr_t)(tpb + 9216) = (bf16)f2bf(t0 * bec);
        *(LAS bf16*)(uintptr_t)(tpb + 144) = (bf16)f2bf(t1 * bc); *(LAS bf16*)(uintptr_t)(tpb + 9360) = (bf16)f2bf(t1 * bec);
        *(LAS bf16*)(uintptr_t)(tpb + 288) = (bf16)f2bf(t2 * bc); *(LAS bf16*)(uintptr_t)(tpb + 9504) = (bf16)f2bf(t2 * bec);
        *(LAS bf16*)(uintptr_t)(tpb + 432) = (bf16)f2bf(t3 * bc); *(LAS bf16*)(uintptr_t)(tpb + 9648) = (bf16)f2bf(t3 * bec);
        *(LAS bf16*)(uintptr_t)(tpb + 576) = (bf16)f2bf(t4 * bc); *(LAS bf16*)(uintptr_t)(tpb + 9792) = (bf16)f2bf(t4 * bec);
        *(LAS bf16*)(uintptr_t)(tpb + 720) = (bf16)f2bf(t5 * bc); *(LAS bf16*)(uintptr_t)(tpb + 9936) = (bf16)f2bf(t5 * bec);
        *(LAS bf16*)(uintptr_t)(tpb + 864) = (bf16)f2bf(t6 * bc); *(LAS bf16*)(uintptr_t)(tpb + 10080) = (bf16)f2bf(t6 * bec);
        *(LAS bf16*)(uintptr_t)(tpb + 1008) = (bf16)f2bf(t7 * bc); *(LAS bf16*)(uintptr_t)(tpb + 10224) = (bf16)f2bf(t7 * bec);
        *(LAS bf16*)(uintptr_t)(tpb + 1152) = (bf16)f2bf(t8 * bc); *(LAS bf16*)(uintptr_t)(tpb + 10368) = (bf16)f2bf(t8 * bec);
        *(LAS bf16*)(uintptr_t)(tpb + 1296) = (bf16)f2bf(t9 * bc); *(LAS bf16*)(uintptr_t)(tpb + 10512) = (bf16)f2bf(t9 * bec);
        *(LAS bf16*)(uintptr_t)(tpb + 1440) = (bf16)f2bf(t10 * bc); *(LAS bf16*)(uintptr_t)(tpb + 10656) = (bf16)f2bf(t10 * bec);
        *(LAS bf16*)(uintptr_t)(tpb + 1584) = (bf16)f2bf(t11 * bc); *(LAS bf16*)(uintptr_t)(tpb + 10800) = (bf16)f2bf(t11 * bec);
        *(LAS bf16*)(uintptr_t)(tpb + 1728) = (bf16)f2bf(t12 * bc); *(LAS bf16*)(uintptr_t)(tpb + 10944) = (bf16)f2bf(t12 * bec);
        *(LAS bf16*)(uintptr_t)(tpb + 1872) = (bf16)f2bf(t13 * bc); *(LAS bf16*)(uintptr_t)(tpb + 11088) = (bf16)f2bf(t13 * bec);
        *(LAS bf16*)(uintptr_t)(tpb + 2016) = (bf16)f2bf(t14 * bc); *(LAS bf16*)(uintptr_t)(tpb + 11232) = (bf16)f2bf(t14 * bec);
        *(LAS bf16*)(uintptr_t)(tpb + 2160) = (bf16)f2bf(t15 * bc); *(LAS bf16*)(uintptr_t)(tpb + 11376) = (bf16)f2bf(t15 * bec);
        *(LAS bf16*)(uintptr_t)(tpb + 2304) = (bf16)f2bf(t16 * bc); *(LAS bf16*)(uintptr_t)(tpb + 11520) = (bf16)f2bf(t16 * bec);
        *(LAS bf16*)(uintptr_t)(tpb + 2448) = (bf16)f2bf(t17 * bc); *(LAS bf16*)(uintptr_t)(tpb + 11664) = (bf16)f2bf(t17 * bec);
        *(LAS bf16*)(uintptr_t)(tpb + 2592) = (bf16)f2bf(t18 * bc); *(LAS bf16*)(uintptr_t)(tpb + 11808) = (bf16)f2bf(t18 * bec);
        *(LAS bf16*)(uintptr_t)(tpb + 2736) = (bf16)f2bf(t19 * bc); *(LAS bf16*)(uintptr_t)(tpb + 11952) = (bf16)f2bf(t19 * bec);
        *(LAS bf16*)(uintptr_t)(tpb + 2880) = (bf16)f2bf(t20 * bc); *(LAS bf16*)(uintptr_t)(tpb + 12096) = (bf16)f2bf(t20 * bec);
        *(LAS bf16*)(uintptr_t)(tpb + 3024) = (bf16)f2bf(t21 * bc); *(LAS bf16*)(uintptr_t)(tpb + 12240) = (bf16)f2bf(t21 * bec);
        *(LAS bf16*)(uintptr_t)(tpb + 3168) = (bf16)f2bf(t22 * bc); *(LAS bf16*)(uintptr_t)(tpb + 12384) = (bf16)f2bf(t22 * bec);
        *(LAS bf16*)(uintptr_t)(tpb + 3312) = (bf16)f2bf(t23 * bc); *(LAS bf16*)(uintptr_t)(tpb + 12528) = (bf16)f2bf(t23 * bec);
        *(LAS bf16*)(uintptr_t)(tpb + 3456) = (bf16)f2bf(t24 * bc); *(LAS bf16*)(uintptr_t)(tpb + 12672) = (bf16)f2bf(t24 * bec);
        *(LAS bf16*)(uintptr_t)(tpb + 3600) = (bf16)f2bf(t25 * bc); *(LAS bf16*)(uintptr_t)(tpb + 12816) = (bf16)f2bf(t25 * bec);
        *(LAS bf16*)(uintptr_t)(tpb + 3744) = (bf16)f2bf(t26 * bc); *(LAS bf16*)(uintptr_t)(tpb + 12960) = (bf16)f2bf(t26 * bec);
        *(LAS bf16*)(uintptr_t)(tpb + 3888) = (bf16)f2bf(t27 * bc); *(LAS bf16*)(uintptr_t)(tpb + 13104) = (bf16)f2bf(t27 * bec);
        *(LAS bf16*)(uintptr_t)(tpb + 4032) = (bf16)f2bf(t28 * bc); *(LAS bf16*)(uintptr_t)(tpb + 13248) = (bf16)f2bf(t28 * bec);
        *(LAS bf16*)(uintptr_t)(tpb + 4176) = (bf16)f2bf(t29 * bc); *(LAS bf16*)(uintptr_t)(tpb + 13392) = (bf16)f2bf(t29 * bec);
        *(LAS bf16*)(uintptr_t)(tpb + 4320) = (bf16)f2bf(t30 * bc); *(LAS bf16*)(uintptr_t)(tpb + 13536) = (bf16)f2bf(t30 * bec);
        *(LAS bf16*)(uintptr_t)(tpb + 4464) = (bf16)f2bf(t31 * bc); *(LAS bf16*)(uintptr_t)(tpb + 13680) = (bf16)f2bf(t31 * bec);
        *(LAS bf16*)(uintptr_t)(tpb + 4608) = (bf16)f2bf(t32 * bc); *(LAS bf16*)(uintptr_t)(tpb + 13824) = (bf16)f2bf(t32 * bec);
        *(LAS bf16*)(uintptr_t)(tpb + 4752) = (bf16)f2bf(t33 * bc); *(LAS bf16*)(uintptr_t)(tpb + 13968) = (bf16)f2bf(t33 * bec);
        *(LAS bf16*)(uintptr_t)(tpb + 4896) = (bf16)f2bf(t34 * bc); *(LAS bf16*)(uintptr_t)(tpb + 14112) = (bf16)f2bf(t34 * bec);
        *(LAS bf16*)(uintptr_t)(tpb + 5040) = (bf16)f2bf(t35 * bc); *(LAS bf16*)(uintptr_t)(tpb + 14256) = (bf16)f2bf(t35 * bec);
        *(LAS bf16*)(uintptr_t)(tpb + 5184) = (bf16)f2bf(t36 * bc); *(LAS bf16*)(uintptr_t)(tpb + 14400) = (bf16)f2bf(t36 * bec);
        *(LAS bf16*)(uintptr_t)(tpb + 5328) = (bf16)f2bf(t37 * bc); *(LAS bf16*)(uintptr_t)(tpb + 14544) = (bf16)f2bf(t37 * bec);
        *(LAS bf16*)(uintptr_t)(tpb + 5472) = (bf16)f2bf(t38 * bc); *(LAS bf16*)(uintptr_t)(tpb + 14688) = (bf16)f2bf(t38 * bec);
        *(LAS bf16*)(uintptr_t)(tpb + 5616) = (bf16)f2bf(t39 * bc); *(LAS bf16*)(uintptr_t)(tpb + 14832) = (bf16)f2bf(t39 * bec);
        *(LAS bf16*)(uintptr_t)(tpb + 5760) = (bf16)f2bf(t40 * bc); *(LAS bf16*)(uintptr_t)(tpb + 14976) = (bf16)f2bf(t40 * bec);
        *(LAS bf16*)(uintptr_t)(tpb + 5904) = (bf16)f2bf(t41 * bc); *(LAS bf16*)(uintptr_t)(tpb + 15120) = (bf16)f2bf(t41 * bec);
        *(LAS bf16*)(uintptr_t)(tpb + 6048) = (bf16)f2bf(t42 * bc); *(LAS bf16*)(uintptr_t)(tpb + 15264) = (bf16)f2bf(t42 * bec);
        *(LAS bf16*)(uintptr_t)(tpb + 6192) = (bf16)f2bf(t43 * bc); *(LAS bf16*)(uintptr_t)(tpb + 15408) = (bf16)f2bf(t43 * bec);
        *(LAS bf16*)(uintptr_t)(tpb + 6336) = (bf16)f2bf(t44 * bc); *(LAS bf16*)(uintptr_t)(tpb + 15552) = (bf16)f2bf(t44 * bec);
        *(LAS bf16*)(uintptr_t)(tpb + 6480) = (bf16)f2bf(t45 * bc); *(LAS bf16*)(uintptr_t)(tpb + 15696) = (bf16)f2bf(t45 * bec);
        *(LAS bf16*)(uintptr_t)(tpb + 6624) = (bf16)f2bf(t46 * bc); *(LAS bf16*)(uintptr_t)(tpb + 15840) = (bf16)f2bf(t46 * bec);
        *(LAS bf16*)(uintptr_t)(tpb + 6768) = (bf16)f2bf(t47 * bc); *(LAS bf16*)(uintptr_t)(tpb + 15984) = (bf16)f2bf(t47 * bec);
        *(LAS bf16*)(uintptr_t)(tpb + 6912) = (bf16)f2bf(t48 * bc); *(LAS bf16*)(uintptr_t)(tpb + 16128) = (bf16)f2bf(t48 * bec);
        *(LAS bf16*)(uintptr_t)(tpb + 7056) = (bf16)f2bf(t49 * bc); *(LAS bf16*)(uintptr_t)(tpb + 16272) = (bf16)f2bf(t49 * bec);
        *(LAS bf16*)(uintptr_t)(tpb + 7200) = (bf16)f2bf(t50 * bc); *(LAS bf16*)(uintptr_t)(tpb + 16416) = (bf16)f2bf(t50 * bec);
        *(LAS bf16*)(uintptr_t)(tpb + 7344) = (bf16)f2bf(t51 * bc); *(LAS bf16*)(uintptr_t)(tpb + 16560) = (bf16)f2bf(t51 * bec);
        *(LAS bf16*)(uintptr_t)(tpb + 7488) = (bf16)f2bf(t52 * bc); *(LAS bf16*)(uintptr_t)(tpb + 16704) = (bf16)f2bf(t52 * bec);
        *(LAS bf16*)(uintptr_t)(tpb + 7632) = (bf16)f2bf(t53 * bc); *(LAS bf16*)(uintptr_t)(tpb + 16848) = (bf16)f2bf(t53 * bec);
        *(LAS bf16*)(uintptr_t)(tpb + 7776) = (bf16)f2bf(t54 * bc); *(LAS bf16*)(uintptr_t)(tpb + 16992) = (bf16)f2bf(t54 * bec);
        *(LAS bf16*)(uintptr_t)(tpb + 7920) = (bf16)f2bf(t55 * bc); *(LAS bf16*)(uintptr_t)(tpb + 17136) = (bf16)f2bf(t55 * bec);
        *(LAS bf16*)(uintptr_t)(tpb + 8064) = (bf16)f2bf(t56 * bc); *(LAS bf16*)(uintptr_t)(tpb + 17280) = (bf16)f2bf(t56 * bec);
        *(LAS bf16*)(uintptr_t)(tpb + 8208) = (bf16)f2bf(t57 * bc); *(LAS bf16*)(uintptr_t)(tpb + 17424) = (bf16)f2bf(t57 * bec);
        *(LAS bf16*)(uintptr_t)(tpb + 8352) = (bf16)f2bf(t58 * bc); *(LAS bf16*)(uintptr_t)(tpb + 17568) = (bf16)f2bf(t58 * bec);
        *(LAS bf16*)(uintptr_t)(tpb + 8496) = (bf16)f2bf(t59 * bc); *(LAS bf16*)(uintptr_t)(tpb + 17712) = (bf16)f2bf(t59 * bec);
        *(LAS bf16*)(uintptr_t)(tpb + 8640) = (bf16)f2bf(t60 * bc); *(LAS bf16*)(uintptr_t)(tpb + 17856) = (bf16)f2bf(t60 * bec);
        *(LAS bf16*)(uintptr_t)(tpb + 8784) = (bf16)f2bf(t61 * bc); *(LAS bf16*)(uintptr_t)(tpb + 18000) = (bf16)f2bf(t61 * bec);
        *(LAS bf16*)(uintptr_t)(tpb + 8928) = (bf16)f2bf(t62 * bc); *(LAS bf16*)(uintptr_t)(tpb + 18144) = (bf16)f2bf(t62 * bec);
        *(LAS bf16*)(uintptr_t)(tpb + 9072) = (bf16)f2bf(t63 * bc); *(LAS bf16*)(uintptr_t)(tpb + 18288) = (bf16)f2bf(t63 * bec);
    } else {
        for (int f = F.wave - 1; f < 40; f += 7) {
            if (f < 16) {
                const int m = f >> 2, s4 = f & 3, i = 16 * m + x; const float sc = tab[64 + i];
                const LAS unsigned char* rp = lds + GA_QI + i * GA_RS + (32 * s4 + 4 * g) * 2;
                const unsigned long long lo = *(const LAS unsigned long long*)rp, hi = *(const LAS unsigned long long*)(rp + 32);
                v4u w; w.x = mul_pk((unsigned)lo, sc, sc); w.y = mul_pk((unsigned)(lo >> 32), sc, sc); w.z = mul_pk((unsigned)hi, sc, sc); w.w = mul_pk((unsigned)(hi >> 32), sc, sc);
                *(GAS v4u*)(blob + GB_QD + (size_t)(f * 64 + lane) * 16) = w;
            } else if (f < 32) {
                const int ff = f - 16, m = ff >> 1, s2 = ff & 1;
                const int r0 = 32 * s2 + 4 * g;
                LAS unsigned char* ap = lds + GA_KI + (r0 + (x >> 2)) * GA_RS + (16 * m + 4 * (x & 3)) * 2;
                const s16x4_t lo = lds_tr16p(ap), hi = lds_tr16p(ap + 16 * GA_RS);
                const f32x4 s_lo = *(const LAS f32x4*)(tab + 128 + r0), s_hi = *(const LAS f32x4*)(tab + 128 + r0 + 16);
                v4u w;
                w.x = pk2(bf2f((bf16)lo[0]) * s_lo[0], bf2f((bf16)lo[1]) * s_lo[1]); w.y = pk2(bf2f((bf16)lo[2]) * s_lo[2], bf2f((bf16)lo[3]) * s_lo[3]);
                w.z = pk2(bf2f((bf16)hi[0]) * s_hi[0], bf2f((bf16)hi[1]) * s_hi[1]); w.w = pk2(bf2f((bf16)hi[2]) * s_hi[2], bf2f((bf16)hi[3]) * s_hi[3]);
                *(GAS v4u*)(blob + GB_KDT + (size_t)(ff * 64 + lane) * 16) = w;
            } else {
                const int ff = f - 32, m = ff >> 1, s2 = ff & 1, i = 16 * m + x;
                const LAS unsigned char* rp = lds + GA_ATI + i * GA_TS + (32 * s2 + 4 * g) * 2;
                const unsigned long long lo = *(const LAS unsigned long long*)rp, hi = *(const LAS unsigned long long*)(rp + 32);
                v4u w; w.x = (unsigned)lo; w.y = (unsigned)(lo >> 32); w.z = (unsigned)hi; w.w = (unsigned)(hi >> 32);
                *(GAS v4u*)(blob + GB_ATT + (size_t)(ff * 64 + lane) * 16) = w;
            }
        }
    }
    __syncthreads();
    {
        const int n = F.wave;
#pragma unroll
        for (int which = 0; which < 2; ++which) {
            const int timg = which == 0 ? GA_TP : GA_TPP, bimg = which == 0 ? GA_VI : GA_KI;
            bf16x8 bfr[2];
#pragma unroll
            for (int s2 = 0; s2 < 2; ++s2) {
                LAS unsigned char* ap = lds + bimg + (32 * s2 + 8 * g + (x >> 2)) * GA_RS + (16 * n + 4 * (x & 3)) * 2;
                const s16x4_t lo = lds_tr16p(ap), hi = lds_tr16p(ap + 4 * GA_RS);
                bfr[s2] = (bf16x8){lo[0], lo[1], lo[2], lo[3], hi[0], hi[1], hi[2], hi[3]};
            }
#pragma unroll
            for (int m = 0; m < 4; ++m) {
                f32x4 acc = {0.f, 0.f, 0.f, 0.f};
#pragma unroll
                for (int s2 = 0; s2 < 2; ++s2) {
                    const bf16x8 af = *(const LAS bf16x8*)(lds + timg + (16 * m + x) * GA_TS + (32 * s2 + 8 * g) * 2);
                    acc = __builtin_amdgcn_mfma_f32_16x16x32_bf16(af, bfr[s2], acc, 0, 0, 0);
                }
                if (which == 0) {
                    const unsigned long long w = (unsigned long long)pk2(acc[0], acc[1]) | ((unsigned long long)pk2(acc[2], acc[3]) << 32);
                    *(GAS unsigned long long*)(blob + GB_U + (size_t)((n * 4 + m) * 64 + lane) * 8) = w;
                } else {
#pragma unroll
                    for (int e = 0; e < 4; ++e) ((LAS bf16*)(lds + GA_WI))[(16 * m + 4 * g + e) * 136 + 16 * n + x] = (bf16)f2bf(acc[e]);
                }
            }
        }
    }
    __syncthreads();
#pragma unroll
    for (int q2 = 0; q2 < 2; ++q2) {
        const int f = F.wave * 2 + q2, m = f >> 2, s4 = f & 3, i = 16 * m + x;
        const LAS unsigned char* rp = lds + GA_WI + i * GA_RS + (32 * s4 + 4 * g) * 2;
        const unsigned long long lo = *(const LAS unsigned long long*)rp, hi = *(const LAS unsigned long long*)(rp + 32);
        v4u w; w.x = (unsigned)lo; w.y = (unsigned)(lo >> 32); w.z = (unsigned)hi; w.w = (unsigned)(hi >> 32);
        *(GAS v4u*)(blob + GB_W + (size_t)(f * 64 + lane) * 16) = w;
    }
}
__device__ __forceinline__ void ph_gdn_prep(Frame& F, const Args& A) {
    for (int cu = (int)blockIdx.x; cu < 2048; cu += F.G) { gdn_prep_chunk(F, A, cu); __syncthreads(); }
}
__device__ __forceinline__ void ph_gdn_scan(Frame& F, const Args& A, int bh) {
    const int b = bh >> 2, h = bh & 3, lane = F.lane, x = lane & 15, g = lane >> 4, n = F.wave;
    LAS unsigned char* lds = F.lds + RING_OFF;
    const unsigned char* blob0 = F.ws + WS_GDN + (size_t)(bh * 64) * GDN_BLOB;
    const float* GE = (const float*)(F.ws + WS_GE) + bh * 64;
    f32x4 Sacc[8];
#pragma unroll
    for (int t = 0; t < 8; ++t) Sacc[t] = (f32x4){0.f, 0.f, 0.f, 0.f};
    v4u st[7]; unsigned long long un[4]; float ge_n;
#pragma unroll
    for (int i = 0; i < 7; ++i) st[i] = *(const GAS v4u*)(blob0 + (size_t)(n * 7 + i) * 1024 + lane * 16);
#pragma unroll
    for (int m = 0; m < 4; ++m) un[m] = *(const GAS unsigned long long*)(blob0 + GB_U + (size_t)((n * 4 + m) * 64 + lane) * 8);
    ge_n = GE[0];
#pragma unroll
    for (int i = 0; i < 7; ++i) *(LAS v4u*)(lds + (n * 7 + i) * 1024 + lane * 16) = st[i];
    __syncthreads();
    for (int c = 0; c < 64; ++c) {
        LAS unsigned char* cur = lds + (c & 1) * GB_SHARED;
        LAS unsigned char* nxt = lds + ((c + 1) & 1) * GB_SHARED;
        unsigned long long uc[4]; const float ge = ge_n;
#pragma unroll
        for (int m = 0; m < 4; ++m) uc[m] = un[m];
        if (c + 1 < 64) {
            const unsigned char* bl = blob0 + (size_t)(c + 1) * GDN_BLOB;
#pragma unroll
            for (int i = 0; i < 7; ++i) st[i] = *(const GAS v4u*)(bl + (size_t)(n * 7 + i) * 1024 + lane * 16);
#pragma unroll
            for (int m = 0; m < 4; ++m) un[m] = *(const GAS unsigned long long*)(bl + GB_U + (size_t)((n * 4 + m) * 64 + lane) * 8);
            ge_n = GE[c + 1];
        }
        bf16x8 Sb[4];
#pragma unroll
        for (int s4 = 0; s4 < 4; ++s4) {
            v4u w; w.x = pk2(Sacc[2 * s4][0], Sacc[2 * s4][1]); w.y = pk2(Sacc[2 * s4][2], Sacc[2 * s4][3]); w.z = pk2(Sacc[2 * s4 + 1][0], Sacc[2 * s4 + 1][1]); w.w = pk2(Sacc[2 * s4 + 1][2], Sacc[2 * s4 + 1][3]);
            Sb[s4] = __builtin_bit_cast(bf16x8, w);
        }
        f32x4 vn[4], o[4];
#pragma unroll
        for (int m = 0; m < 4; ++m) {
            f32x4 ws = {0.f, 0.f, 0.f, 0.f}, qs = {0.f, 0.f, 0.f, 0.f};
#pragma unroll
            for (int s4 = 0; s4 < 4; ++s4) {
                const bf16x8 wf = *(const LAS bf16x8*)(cur + GB_W + ((m * 4 + s4) * 64 + lane) * 16);
                const bf16x8 qf = *(const LAS bf16x8*)(cur + GB_QD + ((m * 4 + s4) * 64 + lane) * 16);
                ws = __builtin_amdgcn_mfma_f32_16x16x32_bf16(wf, Sb[s4], ws, 0, 0, 0);
                qs = __builtin_amdgcn_mfma_f32_16x16x32_bf16(qf, Sb[s4], qs, 0, 0, 0);
            }
            const unsigned ulo = (unsigned)uc[m], uhi = (unsigned)(uc[m] >> 32);
            vn[m][0] = __builtin_bit_cast(float, ulo << 16) - ws[0]; vn[m][1] = __builtin_bit_cast(float, ulo & 0xffff0000u) - ws[1];
            vn[m][2] = __builtin_bit_cast(float, uhi << 16) - ws[2]; vn[m][3] = __builtin_bit_cast(float, uhi & 0xffff0000u) - ws[3];
            o[m] = qs;
        }
        bf16x8 Vb[2];
#pragma unroll
        for (int s2 = 0; s2 < 2; ++s2) {
            v4u w; w.x = pk2(vn[2 * s2][0], vn[2 * s2][1]); w.y = pk2(vn[2 * s2][2], vn[2 * s2][3]); w.z = pk2(vn[2 * s2 + 1][0], vn[2 * s2 + 1][1]); w.w = pk2(vn[2 * s2 + 1][2], vn[2 * s2 + 1][3]);
            Vb[s2] = __builtin_bit_cast(bf16x8, w);
        }
        const size_t orow = (size_t)b * SEQ + (size_t)c * 64;
#pragma unroll
        for (int m = 0; m < 4; ++m) {
#pragma unroll
            for (int s2 = 0; s2 < 2; ++s2) {
                const bf16x8 af = *(const LAS bf16x8*)(cur + GB_ATT + ((m * 2 + s2) * 64 + lane) * 16);
                o[m] = __builtin_amdgcn_mfma_f32_16x16x32_bf16(af, Vb[s2], o[m], 0, 0, 0);
            }
#pragma unroll
            for (int e = 0; e < 4; ++e) W_ORAW[(orow + 16 * m + 4 * g + e) * 512 + h * 128 + 16 * n + x] = o[m][e];
        }
#pragma unroll
        for (int t = 0; t < 8; ++t) {
            f32x4 acc = Sacc[t] * ge;
#pragma unroll
            for (int s2 = 0; s2 < 2; ++s2) {
                const bf16x8 kf = *(const LAS bf16x8*)(cur + GB_KDT + ((t * 2 + s2) * 64 + lane) * 16);
                acc = __builtin_amdgcn_mfma_f32_16x16x32_bf16(kf, Vb[s2], acc, 0, 0, 0);
            }
            Sacc[t] = acc;
        }
        if (c + 1 < 64) {
#pragma unroll
            for (int i = 0; i < 7; ++i) *(LAS v4u*)(nxt + (n * 7 + i) * 1024 + lane * 16) = st[i];
        }
        __syncthreads();
    }
}

__device__ __forceinline__ void ph_gdn_out(Frame& F, const Args& A) {
    const int gw = F.vcu * NWAVES + F.wave, NGW = F.G * NWAVES;
    const bf16* GA = W_PROJ + (size_t)3 * M * 512;
    for (int it = gw; it < M * 4; it += NGW) {
        const int m = it >> 2, h = it & 3;
        const size_t o0 = (size_t)m * 512 + h * 128 + F.lane;
        const float a = W_ORAW[o0], b = W_ORAW[o0 + 64];
        const float s = wave_sum(a * a + b * b);
        const float r = rsqrtf(s * (1.f / 128.f) + EPS);
        W_MIXO[(size_t)m * D + h * 128 + F.lane] = (bf16)f2bf(a * r * A_onorm_g[F.lane] * siluf(bf2f(GA[o0])));
        W_MIXO[(size_t)m * D + h * 128 + F.lane + 64] = (bf16)f2bf(b * r * A_onorm_g[F.lane + 64] * siluf(bf2f(GA[o0 + 64])));
    }
}
typedef short s16x4 __attribute__((ext_vector_type(4)));
constexpr int SWA_TASKS = 64 * 48;
constexpr int SWA_KOFF = 0, SWA_VOFF = 49152, SWA_TB = 98304;
__device__ __forceinline__ s16x4 lds_tr16(unsigned addr) { return __builtin_bit_cast(s16x4, __builtin_amdgcn_ds_read_tr16_b64_v4i16((LAS s16x4*)(uintptr_t)addr)); }
__device__ __forceinline__ void swa_task(Frame& F, const Args& A, int tk) {
    const int bh = tk / 48, rem = tk % 48, p = rem >> 4, idx = rem & 15;
    const int b = bh >> 3, h = bh & 7;
    const int dil = p == 0 ? 1 : (p == 1 ? 4 : 16), nblk = 16 / dil, r = idx / nblk, m0 = 256 * (idx % nblk);
    const bf16* QB = W_PROJ + (size_t)4 * M * 512; const bf16* KB = W_PROJ + (size_t)5 * M * 512; const bf16* VB = W_PROJ + (size_t)6 * M * 512;
    bf16* OP = (bf16*)(F.ws + (p == 0 ? WS_SO1 : (p == 1 ? WS_SO2 : WS_SO3)));
    float* LSE = (float*)(F.ws + WS_LSE) + (size_t)p * M * 8;
    const size_t rowb = (size_t)b * SEQ;
    LAS unsigned char* lds = F.lds + RING_OFF;
    {
        v4u tmp[12];
#pragma unroll
        for (int i = 0; i < 12; ++i) {
            const int e = F.tid + 512 * i, which = e / 3072, rm = e % 3072, row = rm >> 3, c = rm & 7;
            int sp = m0 - 128 + row; sp = sp < 0 ? 0 : sp;
            const bf16* src = (which ? VB : KB) + (rowb + (size_t)sp * dil + r) * 512 + h * 64 + c * 8;
            tmp[i] = *(const GAS v4u*)src;
        }
#pragma unroll
        for (int i = 0; i < 12; ++i) {
            const int e = F.tid + 512 * i, which = e / 3072, rm = e % 3072, row = rm >> 3, c = rm & 7;
            *(LAS v4u*)(lds + which * SWA_VOFF + row * 128 + ((c ^ (row & 7)) << 4)) = tmp[i];
        }
        if (F.tid < 129) ((LAS float*)(lds + SWA_TB))[F.tid] = A_rel_bias[c_bkt[p][F.tid] * 8 + h];
    }
    __syncthreads();
    const int lane = F.lane, q = lane & 15, g = lane >> 4;
    const LAS float* tb = (const LAS float*)(lds + SWA_TB);
#pragma unroll 1
    for (int qi = 0; qi < 2; ++qi) {
        const int qt = F.wave * 2 + qi;
        const size_t qtok = rowb + (size_t)(m0 + 16 * qt + q) * dil + r;
        const bf16x8 qf0 = *(const GAS bf16x8*)(QB + qtok * 512 + h * 64 + 8 * g);
        const bf16x8 qf1 = *(const GAS bf16x8*)(QB + qtok * 512 + h * 64 + 32 + 8 * g);
        float sc[9][4];
        float mx = -INFINITY;
#pragma unroll
        for (int jt = 0; jt < 9; ++jt) {
            const int kt = qt + jt, krow = 16 * kt + q;
            const bf16x8 kf0 = *(const LAS bf16x8*)(lds + SWA_KOFF + krow * 128 + (((g) ^ (krow & 7)) << 4));
            const bf16x8 kf1 = *(const LAS bf16x8*)(lds + SWA_KOFF + krow * 128 + (((g + 4) ^ (krow & 7)) << 4));
            f32x4 acc = {0.f, 0.f, 0.f, 0.f};
            acc = __builtin_amdgcn_mfma_f32_16x16x32_bf16(kf0, qf0, acc, 0, 0, 0);
            acc = __builtin_amdgcn_mfma_f32_16x16x32_bf16(kf1, qf1, acc, 0, 0, 0);
#pragma unroll
            for (int e = 0; e < 4; ++e) {
                const int kx = 4 * g + e, rel = 128 - 16 * jt + q - kx, spk = m0 - 128 + 16 * kt + kx;
                const bool valid = (rel >= 0) && (rel <= 128) && (spk >= 0);
                const int relc = rel < 0 ? 0 : (rel > 128 ? 128 : rel);
                const float v = acc[e] * 0.125f + tb[relc];
                sc[jt][e] = valid ? v : -INFINITY;
                mx = fmaxf(mx, sc[jt][e]);
            }
        }
        mx = fmaxf(mx, __shfl_xor(mx, 16)); mx = fmaxf(mx, __shfl_xor(mx, 32));
        float l = 0.f;
#pragma unroll
        for (int jt = 0; jt < 9; ++jt)
#pragma unroll
            for (int e = 0; e < 4; ++e) { sc[jt][e] = __expf(sc[jt][e] - mx); l += sc[jt][e]; }
        l += __shfl_xor(l, 16); l += __shfl_xor(l, 32);
        bf16x8 pf[5];
#pragma unroll
        for (int s2 = 0; s2 < 5; ++s2) {
            v4u w;
            w.x = pk2(sc[2 * s2][0], sc[2 * s2][1]); w.y = pk2(sc[2 * s2][2], sc[2 * s2][3]);
            if (s2 < 4) { w.z = pk2(sc[2 * s2 + 1][0], sc[2 * s2 + 1][1]); w.w = pk2(sc[2 * s2 + 1][2], sc[2 * s2 + 1][3]); } else { w.z = 0u; w.w = 0u; }
            pf[s2] = __builtin_bit_cast(bf16x8, w);
        }
        const float rl = 1.0f / l;
        const unsigned vbase = (unsigned)(uintptr_t)(lds + SWA_VOFF);
#pragma unroll
        for (int mt = 0; mt < 4; ++mt) {
            f32x4 o = {0.f, 0.f, 0.f, 0.f};
#pragma unroll
            for (int s2 = 0; s2 < 5; ++s2) {
                const int row0 = 16 * (qt + 2 * s2) + 4 * g + (q >> 2), c = 2 * mt + ((q & 3) >> 1);
                const s16x4 lo = lds_tr16(vbase + row0 * 128 + ((c ^ (row0 & 7)) << 4) + 8 * (q & 1));
                s16x4 hi = {0, 0, 0, 0};
                if (s2 < 4) { const int row1 = row0 + 16; hi = lds_tr16(vbase + row1 * 128 + ((c ^ (row1 & 7)) << 4) + 8 * (q & 1)); }
                const bf16x8 vf = {lo[0], lo[1], lo[2], lo[3], hi[0], hi[1], hi[2], hi[3]};
                o = __builtin_amdgcn_mfma_f32_16x16x32_bf16(vf, pf[s2], o, 0, 0, 0);
            }
            unsigned long long w = (unsigned long long)pk2(o[0] * rl, o[1] * rl) | ((unsigned long long)pk2(o[2] * rl, o[3] * rl) << 32);
            *(GAS unsigned long long*)(OP + qtok * 512 + h * 64 + 16 * mt + 4 * g) = w;
        }
        if (g == 0) LSE[qtok * 8 + h] = mx + __logf(l);
    }
    __syncthreads();
}
__device__ __forceinline__ void ph_swa(Frame& F, const Args& A, int widx, int nw) {
    const int lo = (int)(((long)widx * SWA_TASKS) / nw), hi = (int)(((long)(widx + 1) * SWA_TASKS) / nw);
    for (int tk = lo; tk < hi; ++tk) swa_task(F, A, tk);
}
__device__ __forceinline__ void ph_swa_merge(Frame& F) {
    const int gw = F.vcu * NWAVES + F.wave, NGW = F.G * NWAVES;
    const float* LSE = (const float*)(F.ws + WS_LSE);
    const bf16* O1 = (const bf16*)(F.ws + WS_SO1); const bf16* O2 = (const bf16*)(F.ws + WS_SO2); const bf16* O3 = (const bf16*)(F.ws + WS_SO3);
    for (int it = gw; it < M * 8; it += NGW) {
        const int m = it >> 3, h = it & 7;
        const float l1 = LSE[(size_t)m * 8 + h], l2 = LSE[(size_t)M * 8 + (size_t)m * 8 + h], l3 = LSE[(size_t)2 * M * 8 + (size_t)m * 8 + h];
        const float mx = fmaxf(l1, fmaxf(l2, l3));
        const float w1 = __expf(l1 - mx), w2 = __expf(l2 - mx), w3 = __expf(l3 - mx);
        const size_t o = (size_t)m * 512 + h * 64 + F.lane;
        const float v = (w1 * bf2f(O1[o]) + w2 * bf2f(O2[o]) + w3 * bf2f(O3[o])) / (w1 + w2 + w3);
        W_MIXO[(size_t)m * D + 512 + h * 64 + F.lane] = (bf16)f2bf(v);
    }
}
__device__ __forceinline__ void ph_norm_res(Frame& F, const float* y, const float* g1, const float* base, float* out, const float* g2, bf16* hn) {
    const int gw = F.vcu * NWAVES + F.wave, NGW = F.G * NWAVES;
    for (int m = gw; m < M; m += NGW) {
        const GAS f32x4* yr = (const GAS f32x4*)(y + (size_t)m * D) + F.lane;
        const GAS f32x4* br = (const GAS f32x4*)(base + (size_t)m * D) + F.lane;
        GAS f32x4* orow = (GAS f32x4*)(out + (size_t)m * D) + F.lane;
        f32x4 v[4]; float s = 0.f;
#pragma unroll
        for (int j = 0; j < 4; ++j) { v[j] = yr[64 * j]; s += (v[j].x * v[j].x + v[j].y * v[j].y) + (v[j].z * v[j].z + v[j].w * v[j].w); }
        const float r = rsqrtf(wave_sum(s) * (1.f / D) + EPS);
        float s2 = 0.f;
#pragma unroll
        for (int j = 0; j < 4; ++j) { const f32x4 g = ((const GAS f32x4*)g1)[F.lane + 64 * j]; v[j] = br[64 * j] + v[j] * r * g; orow[64 * j] = v[j];
            s2 += (v[j].x * v[j].x + v[j].y * v[j].y) + (v[j].z * v[j].z + v[j].w * v[j].w); }
        if (hn) {
            const float r2 = rsqrtf(wave_sum(s2) * (1.f / D) + EPS);
            GAS unsigned long long* o8 = (GAS unsigned long long*)(hn + (size_t)m * D) + F.lane;
#pragma unroll
            for (int j = 0; j < 4; ++j) { const f32x4 g = ((const GAS f32x4*)g2)[F.lane + 64 * j]; const f32x4 w = v[j] * r2 * g;
                o8[64 * j] = (unsigned long long)pk2(w.x, w.y) | ((unsigned long long)pk2(w.z, w.w) << 32); }
        }
    }
}

constexpr int N_PHASES = 10;
#ifndef MK_PER_PHASE
#define MK_PER_PHASE 0
#endif
__global__ void __launch_bounds__(NWAVES * 64, 2) mk_fwd(Args args) {
    extern __shared__ __attribute__((aligned(16))) unsigned char lds[];
    Frame F;
    F.lds = (LAS unsigned char*)lds;
    F.MISC = (volatile LAS unsigned*)(F.lds + MISC_OFF);
    F.tid = threadIdx.x; F.lane = F.tid & 63; F.wave = __builtin_amdgcn_readfirstlane(F.tid >> 6);
    F.G = gridDim.x; { const int bx = blockIdx.x; F.vcu = (F.G % 8 == 0) ? (bx % 8) * (F.G / 8) + bx / 8 : bx; }
    unsigned char* ws = args.ws;
    F.ctl = (gu32*)(ws + WS_CTL);
    F.ws = ws; const Args& A = args;
    for (int u = F.tid; u < (LDS_BYTES - LDSCTL_OFF) / 4; u += NWAVES * 64) ((LAS unsigned*)(F.lds + LDSCTL_OFF))[u] = 0u;
    __syncthreads();
    XcdBarrier bar; bar.bar = (unsigned*)(F.ctl + CW_BAR); bar.x = 0; bar.st = nullptr;
    if (!MK_PER_PHASE) bar = xcd_barrier_post((unsigned*)(F.ctl + CW_BAR), F.MISC + 8);
    const int lo = args.ph_lo, hi = args.ph_hi;
#ifndef PHMASK
#define PHMASK 0xFFFF
#endif
#define IN(k) (((PHMASK >> (k)) & 1) && lo <= (k) && (k) < hi)
#define SEAM(k) do { if (IN(k) && IN((k) + 1)) xcd_barrier(bar); } while (0)

    if (IN(0)) { ph_prologue(F, args); } SEAM(0);
    if (IN(1)) {
        pg8::Gemm g{W_XN, W_WIN, M, NIN, D}; pg8::StaticOrder S; S.init(M, NIN, F.G, (int)blockIdx.x);
        pg8::EpiBf16<0> E{W_PROJ, 512, nullptr, 512, (size_t)M * 512, 1.f};
        pg8::gemm_phase<pg8::EpiBf16<0>, pg8::StaticOrder, true, true>(F.lds + RING_OFF, g, S, E);
    } SEAM(1);
    if (IN(2)) { ph_gdn_prep(F, args); } SEAM(2);
    if (IN(3)) {
        if (blockIdx.x < 32) ph_gdn_scan(F, args, (int)blockIdx.x);
        else ph_swa(F, args, (int)blockIdx.x - 32, F.G - 32);
    } SEAM(3);
    if (IN(4)) { ph_gdn_out(F, args); ph_swa_merge(F); } SEAM(4);
    if (IN(5)) {
        pg8::Gemm g{W_MIXO, W_WO, M, D, D}; pg8::StaticOrder S; S.init(M, D, F.G, (int)blockIdx.x);
        pg8::EpiF32 E{W_Y, D};
        pg8::gemm_phase<pg8::EpiF32, pg8::StaticOrder, true, true>(F.lds + RING_OFF, g, S, E);
    } SEAM(5);
    if (IN(6)) { ph_norm_res(F, W_Y, A_g_mix_post, A_x, A.out, A_g_ffn_pre, W_XN2); } SEAM(6);
    if (IN(7)) {
        pg8::Gemm g{W_XN2, W_WGU, M, NGU, D}; pg8::StaticOrder S; S.init(M, NGU, F.G, (int)blockIdx.x);
        pg8::EpiSwiGLU E{W_HID, DFF};
        pg8::gemm_phase<pg8::EpiSwiGLU, pg8::StaticOrder, true, true>(F.lds + RING_OFF, g, S, E);
    } SEAM(7);
    if (IN(8)) {
        pg8::Gemm g{W_HID, W_WD, M, D, DFF}; pg8::StaticOrder S; S.init(M, D, F.G, (int)blockIdx.x);
        pg8::EpiF32 E{W_Y, D};
        pg8::gemm_phase<pg8::EpiF32, pg8::StaticOrder, true, true>(F.lds + RING_OFF, g, S, E);
    } SEAM(8);
    if (IN(9)) { ph_norm_res(F, W_Y, A_g_ffn_post, A.out, A.out, nullptr, nullptr); }
#undef IN
#undef SEAM
}

extern "C" void kernel_launch(void* const* d_in, const int* in_sizes, int n_in, void* d_out, int out_size, void* d_ws, size_t ws_size, hipStream_t stream) {
    static int grid = 0;
    if (grid == 0) {
        if (n_in != 15 || in_sizes[0] != M * D || out_size != M * D || ws_size < WS_END) {
            fprintf(stderr, "kernel_launch: unexpected shapes/workspace: n_in %d in0 %d out %d ws %zu (need %zu); nothing launched\n", n_in, n_in > 0 ? in_sizes[0] : -1, out_size, ws_size, (size_t)WS_END); grid = -1; return; }
        int dev = 0, cus = 0, per_cu = 0;
        if (hipGetDevice(&dev) != hipSuccess || hipDeviceGetAttribute(&cus, hipDeviceAttributeMultiprocessorCount, dev) != hipSuccess) { fprintf(stderr, "kernel_launch: device query failed\n"); grid = -1; return; }
        if (hipFuncSetAttribute((const void*)mk_fwd, hipFuncAttributeMaxDynamicSharedMemorySize, LDS_BYTES) != hipSuccess) { fprintf(stderr, "kernel_launch: hipFuncSetAttribute failed\n"); grid = -1; return; }
        if (hipOccupancyMaxActiveBlocksPerMultiprocessor(&per_cu, (const void*)mk_fwd, NWAVES * 64, LDS_BYTES) != hipSuccess || per_cu < 1) {
            fprintf(stderr, "kernel_launch: occupancy query reports %d workgroups per CU; nothing launched\n", per_cu); (void)hipGetLastError(); grid = -1; return; }
        (void)hipGetLastError();
        grid = cus;
    }
    if (grid < 0) return;
    if (hipMemsetAsync((char*)d_ws + WS_CTL, 0, CTL_ZERO_BYTES, stream) != hipSuccess) { fprintf(stderr, "kernel_launch: memset failed\n"); return; }
    Args a{};
    for (int i = 0; i < 15; ++i) a.in[i] = (const float*)d_in[i];
    a.out = (float*)d_out; a.ws = (unsigned char*)d_ws;
#if MK_PER_PHASE
    for (int p = 0; p < N_PHASES; ++p) { a.ph_lo = p; a.ph_hi = p + 1; hipLaunchKernelGGL(mk_fwd, dim3(grid), dim3(NWAVES * 64), LDS_BYTES, stream, a); }
#else
    a.ph_lo = 0; a.ph_hi = N_PHASES;
    hipLaunchKernelGGL(mk_fwd, dim3(grid), dim3(NWAVES * 64), LDS_BYTES, stream, a);
#endif
    const hipError_t le = hipPeekAtLastError();
    if (le != hipSuccess) fprintf(stderr, "kernel_launch: launch failed: %s\n", hipGetErrorName(le));
}
```

```cpp
#include <hip/hip_runtime.h>
#include <cstdio>
#include <cstdint>
#include <cmath>
namespace pg8 {
#define PG8_LAS __attribute__((address_space(3)))
typedef unsigned short bf16_t;
typedef short bf16x8 __attribute__((ext_vector_type(8)));
typedef float f32x4 __attribute__((ext_vector_type(4)));
typedef unsigned u32x4 __attribute__((ext_vector_type(4)));
constexpr int BM = 256, BK = 64, HALF = 128, HTB = HALF * BK * 2  , STAGE_BYTES = 8 * HTB, NXCD = 8, WGM = 8;

__host__ __device__ __forceinline__ int lds_byte(int r, int c) { const int st = (r >> 4) * 2 + (c >> 5), rr = r & 15, cc = c & 31, ob = rr * 64 + cc * 2; return st * 1024 + (ob ^ (((ob >> 9) & 1) << 5)); }
__host__ __device__ __forceinline__ void stage_rc(int b, int& R, int& C) { const int st = b / 1024, sb = b % 1024, swz = sb ^ (((sb >> 9) & 1) << 5); R = (st >> 1) * 16 + swz / 64; C = (st & 1) * 32 + (swz % 64) / 2; }
__host__ __device__ __forceinline__ int perm32(int rho) { const int n = rho >> 4, i = rho & 15; return 8 * (i >> 2) + 4 * n + (i & 3); }

struct Unit { int pm, pn; };
struct Gemm { const bf16_t* A; const bf16_t* Bt; int M, N, K; };

struct StaticOrder {
    int nM, nN, nwg, G, c;
    __host__ __device__ void init(int M, int N, int G_, int c_) { nM = M / BM; nN = N / BM; nwg = nM * nN; G = G_; c = c_; }
    __host__ __device__ bool next(int i, Unit& u) const {
        const long L = (long)i * G + c; if (L >= nwg) return false;
        int wgid = (int)L; { const int q = nwg / NXCD, r = nwg % NXCD, xcd = wgid % NXCD, off = wgid / NXCD; wgid = (xcd < r ? xcd * (q + 1) : r * (q + 1) + (xcd - r) * q) + off; }
        const int nig = WGM * nN, gid = wgid / nig, fm = gid * WGM, gsz = (nM - fm) < WGM ? (nM - fm) : WGM;
        u.pm = fm + ((wgid % nig) % gsz); u.pn = (wgid % nig) / gsz; return true;
    }
    __device__ __forceinline__ void a_ready(const Unit&) const {}
    __device__ __forceinline__ void done(const Unit&) const {}
};

__device__ __forceinline__ unsigned cvt_pk_bf16(float lo, float hi) { unsigned r; asm volatile("v_cvt_pk_bf16_f32 %0, %1, %2" : "=v"(r) : "v"(lo), "v"(hi)); return r; }
typedef float f32x2 __attribute__((ext_vector_type(2)));
__device__ __forceinline__ f32x2 gelu_pk(f32x2 v) {
    const f32x2 av = __builtin_elementwise_abs(v), d = av * 0.2316418882f + 1.0f;
    f32x2 t; t.x = __builtin_amdgcn_rcpf(d.x); t.y = __builtin_amdgcn_rcpf(d.y);
    f32x2 q = t * 0.5307027145f + (-0.7265760135f); q = q * t + 0.7107068705f; q = q * t + (-0.142248368f); q = q * t + 0.127414796f; q = q * t;
    const f32x2 s = (v * v) * (-0.72134752044f);
    f32x2 e; e.x = __builtin_amdgcn_exp2f(s.x); e.y = __builtin_amdgcn_exp2f(s.y);
    const f32x2 m = v * (q * e), r = v - m;
    f32x2 o; o.x = v.x < 0.f ? m.x : r.x; o.y = v.y < 0.f ? m.y : r.y; return o;
}

template <int ACT  > struct EpiBf16 {
    static constexpr bool PERM = true, AFTER_DRAIN = false; static_assert(ACT == 0 || ACT == 1, "EpiBf16: ACT is 0 (none) or 1 (gelu_pk)");
    bf16_t* O; int ldc; const float* bias; int split_cols; size_t split_stride; float scale0;
    __device__ __forceinline__ void operator()(const f32x4 (&acc)[2][2][4][2], const Unit& u, int wr, int wc, int fr, int fq) const {
        const int row0 = u.pm * BM + wr * 64 + fr; int colt = u.pn * BM; bf16_t* base = O;
        float sc = 1.f; if (split_cols) { const int t = colt / split_cols; base += (size_t)t * split_stride; colt -= t * split_cols; if (t == 0) sc = scale0; }
        const int col0 = colt + wc * 32 + 8 * fq, bcol0 = u.pn * BM + wc * 32 + 8 * fq;
        f32x4 bv[2][2];
#pragma unroll
        for (int bj = 0; bj < 2; ++bj)
#pragma unroll
            for (int n = 0; n < 2; ++n) bv[bj][n] = bias ? *(const f32x4*)(bias + bcol0 + bj * HALF + 4 * n) : (f32x4){0.f, 0.f, 0.f, 0.f};
#pragma unroll
        for (int ai = 0; ai < 2; ++ai)
#pragma unroll
            for (int m = 0; m < 4; ++m) { bf16_t* rowp = base + (size_t)(row0 + ai * HALF + m * 16) * ldc + col0;
#pragma unroll
                for (int bj = 0; bj < 2; ++bj) { f32x4 v0 = acc[ai][bj][m][0] + bv[bj][0], v1 = acc[ai][bj][m][1] + bv[bj][1];
                    if (ACT == 1) { f32x2 a = gelu_pk((f32x2){v0[0], v0[1]}), b = gelu_pk((f32x2){v0[2], v0[3]}), c = gelu_pk((f32x2){v1[0], v1[1]}), d = gelu_pk((f32x2){v1[2], v1[3]});
                        v0 = (f32x4){a.x, a.y, b.x, b.y}; v1 = (f32x4){c.x, c.y, d.x, d.y}; }
                    v0 = v0 * sc; v1 = v1 * sc; u32x4 w; w.x = cvt_pk_bf16(v0[0], v0[1]); w.y = cvt_pk_bf16(v0[2], v0[3]); w.z = cvt_pk_bf16(v1[0], v1[1]); w.w = cvt_pk_bf16(v1[2], v1[3]);
                    *(u32x4*)(rowp + bj * HALF) = w; } }
    }
};

struct PanelStats {
    unsigned* xbuf;
    unsigned* cnt;
    unsigned* tmo;
    int ntn; float eps;
    unsigned code;
    __device__ __forceinline__ bool run(const f32x4 (&v)[2][2][4][2], const Unit& u, int wr, int wc, int fr, int fq, PG8_LAS unsigned char* lds, int wid, int lane) const {
        typedef float f32x2v __attribute__((ext_vector_type(2)));
        PG8_LAS f32x2v* P = (PG8_LAS f32x2v*)lds;
        PG8_LAS f32x2v* S = (PG8_LAS f32x2v*)(lds + 8192);
        PG8_LAS unsigned* flag = (PG8_LAS unsigned*)(lds + 8192 + 2048);
#pragma unroll
        for (int ai = 0; ai < 2; ++ai)
#pragma unroll
            for (int m = 0; m < 4; ++m) {
                float s = 0.f;
#pragma unroll
                for (int bj = 0; bj < 2; ++bj)
#pragma unroll
                    for (int n = 0; n < 2; ++n) { const f32x4 x = v[ai][bj][m][n]; s += (x[0] + x[1]) + (x[2] + x[3]); }
                s += __shfl_xor(s, 16); s += __shfl_xor(s, 32);
                const float mw = s * (1.0f / 64.0f); float q = 0.f;
#pragma unroll
                for (int bj = 0; bj < 2; ++bj)
#pragma unroll
                    for (int n = 0; n < 2; ++n) { const f32x4 d = v[ai][bj][m][n] - mw; q += (d[0] * d[0] + d[1] * d[1]) + (d[2] * d[2] + d[3] * d[3]); }
                q += __shfl_xor(q, 16); q += __shfl_xor(q, 32);
                if (fq == 0) P[(ai * HALF + wr * 64 + m * 16 + fr) * 4 + wc] = (f32x2v){mw, q};
            }
        asm volatile("s_waitcnt lgkmcnt(0)" ::: "memory"); __builtin_amdgcn_s_barrier(); asm volatile("" ::: "memory");
#if defined(BROKEN_EXCHANGE_NO_WAIT)
#warning BROKEN CONTROL BUILD: the row-statistics exchange does not wait; results are wrong by design
        if (blockIdx.x >= 64) { const long long t0_ = clock64(); while (clock64() - t0_ < 60000) __builtin_amdgcn_s_sleep(8); }
#endif
        const int row = wid * 32 + (lane & 31);
        if (lane < 32) {
            const f32x2v a = P[row * 4 + 0], b = P[row * 4 + 1], c = P[row * 4 + 2], d = P[row * 4 + 3];
            const float mt = (a.x + b.x + c.x + d.x) * 0.25f;
            const float da = a.x - mt, db = b.x - mt, dc = c.x - mt, dd = d.x - mt;
            const float m2 = (a.y + b.y) + (c.y + d.y) + 64.0f * ((da * da + db * db) + (dc * dc + dd * dd));
            unsigned long long* slot = (unsigned long long*)xbuf + ((size_t)(u.pm * BM + row) * 4 + u.pn);
            __hip_atomic_store(slot, ((unsigned long long)__float_as_uint(m2) << 32) | __float_as_uint(mt), __ATOMIC_RELAXED, __HIP_MEMORY_SCOPE_AGENT);
        }
        asm volatile("s_waitcnt vmcnt(0)" ::: "memory");
        if (lane == 0) __hip_atomic_fetch_add(cnt + 64 * u.pm, 1u, __ATOMIC_RELAXED, __HIP_MEMORY_SCOPE_AGENT);
        if (wid == 0) {
            bool dead = false; const unsigned long long t0 = __builtin_amdgcn_s_memrealtime(); const unsigned want = 8u * (unsigned)ntn;
            for (;;) {
#if defined(BROKEN_EXCHANGE_NO_WAIT)
                break;
#endif
                if ((unsigned)__builtin_amdgcn_readfirstlane(__hip_atomic_load(cnt + 64 * u.pm, __ATOMIC_RELAXED, __HIP_MEMORY_SCOPE_AGENT)) >= want) break;
                if (__builtin_amdgcn_s_memrealtime() - t0 > 2000000ull) {
                    if (lane == 0) { unsigned expect = 0u; __hip_atomic_compare_exchange_strong(tmo + 1, &expect, code | (unsigned)(u.pm & 0xff), __ATOMIC_RELAXED, __ATOMIC_RELAXED, __HIP_MEMORY_SCOPE_AGENT);
                                     __hip_atomic_store(tmo, 1u, __ATOMIC_RELAXED, __HIP_MEMORY_SCOPE_AGENT); }
                    dead = true; break; }
                __builtin_amdgcn_s_sleep(2);
            }
            __builtin_amdgcn_fence(__ATOMIC_ACQUIRE, "agent");
            if (lane == 0) flag[0] = dead ? 1u : 0u;
        }
        asm volatile("s_waitcnt vmcnt(0) lgkmcnt(0)" ::: "memory"); __builtin_amdgcn_s_barrier(); asm volatile("" ::: "memory");
        const bool bad = flag[0] != 0u;
        if (lane < 32) {
            const unsigned long long* slot = (const unsigned long long*)xbuf + (size_t)(u.pm * BM + row) * 4; float mt[4], m2[4]; float ms = 0.f;
#pragma unroll
            for (int t = 0; t < 4; ++t) { if (t < ntn) { const unsigned long long w = __hip_atomic_load(slot + t, __ATOMIC_RELAXED, __HIP_MEMORY_SCOPE_AGENT); mt[t] = __uint_as_float((unsigned)w); m2[t] = __uint_as_float((unsigned)(w >> 32)); } else { mt[t] = 0.f; m2[t] = 0.f; } ms += mt[t]; }
            const float mean = ms / (float)ntn; float q = 0.f;
#pragma unroll
            for (int t = 0; t < 4; ++t) if (t < ntn) { const float dm = mt[t] - mean; q += m2[t] + 256.0f * dm * dm; }
            S[row] = (f32x2v){mean, 1.0f / sqrtf(q / (256.0f * (float)ntn) + eps)};
        }
        asm volatile("s_waitcnt lgkmcnt(0)" ::: "memory"); __builtin_amdgcn_s_barrier(); asm volatile("" ::: "memory");
        return bad;
    }
};
struct EpiLnRes {
    static constexpr bool PERM = false, AFTER_DRAIN = true;
    const float* base; float* out; int ldc; const float* bias; PanelStats st; unsigned poison;
    __device__ __forceinline__ void fused(f32x4 (&acc)[2][2][4][2], const Unit& u, int wr, int wc, int fr, int fq, PG8_LAS unsigned char* lds, int wid, int lane) const {
        typedef float f32x2v __attribute__((ext_vector_type(2)));
        const PG8_LAS f32x2v* S = (const PG8_LAS f32x2v*)(lds + 8192);
        const int col0 = u.pn * BM + wc * 32 + 4 * fq;
#pragma unroll
        for (int bj = 0; bj < 2; ++bj)
#pragma unroll
            for (int n = 0; n < 2; ++n) { const f32x4 bv = bias ? *(const f32x4*)(bias + col0 + bj * HALF + n * 16) : (f32x4){0.f, 0.f, 0.f, 0.f};
#pragma unroll
                for (int ai = 0; ai < 2; ++ai)
#pragma unroll
                    for (int m = 0; m < 4; ++m) acc[ai][bj][m][n] += bv; }
        f32x4 pre[4][2][2];
#pragma unroll
        for (int m = 0; m < 4; ++m) { const size_t off = (size_t)(u.pm * BM + wr * 64 + m * 16 + fr) * ldc + col0;
#pragma unroll
            for (int bj = 0; bj < 2; ++bj)
#pragma unroll
                for (int n = 0; n < 2; ++n) pre[m][bj][n] = *(const f32x4*)(base + off + bj * HALF + n * 16); }
        const bool bad = st.run(acc, u, wr, wc, fr, fq, lds, wid, lane) || poison != 0u;
        const float qnan = __builtin_nanf("");
#pragma unroll
        for (int ai = 0; ai < 2; ++ai)
#pragma unroll
            for (int m = 0; m < 4; ++m) { const int r = ai * HALF + wr * 64 + m * 16 + fr; const f32x2v sr = S[r]; const size_t off = (size_t)(u.pm * BM + r) * ldc + col0;
#pragma unroll
                for (int bj = 0; bj < 2; ++bj)
#pragma unroll
                    for (int n = 0; n < 2; ++n) { const f32x4 bs = ai == 0 ? pre[m][bj][n] : *(const f32x4*)(base + off + bj * HALF + n * 16); f32x4 o = bs + (acc[ai][bj][m][n] - sr.x) * sr.y;
                        if (bad) o = (f32x4){qnan, qnan, qnan, qnan}; *(f32x4*)(out + off + bj * HALF + n * 16) = o; }
                if (m & 1) asm volatile("" ::: "memory"); }
    }
};
struct EpiLnResLn {
    static constexpr bool PERM = false, AFTER_DRAIN = true;
    const float* base; float* out; bf16_t* xn; int ldc; const float* bias; PanelStats st1, st2; unsigned poison;
    __device__ __forceinline__ void fused(f32x4 (&acc)[2][2][4][2], const Unit& u, int wr, int wc, int fr, int fq, PG8_LAS unsigned char* lds, int wid, int lane) const {
        typedef float f32x2v __attribute__((ext_vector_type(2))); typedef unsigned u32x2v __attribute__((ext_vector_type(2)));
        const PG8_LAS f32x2v* S = (const PG8_LAS f32x2v*)(lds + 8192);
        const int col0 = u.pn * BM + wc * 32 + 4 * fq;
#pragma unroll
        for (int bj = 0; bj < 2; ++bj)
#pragma unroll
            for (int n = 0; n < 2; ++n) { const f32x4 bv = bias ? *(const f32x4*)(bias + col0 + bj * HALF + n * 16) : (f32x4){0.f, 0.f, 0.f, 0.f};
#pragma unroll
                for (int ai = 0; ai < 2; ++ai)
#pragma unroll
                    for (int m = 0; m < 4; ++m) acc[ai][bj][m][n] += bv; }
        bool bad = st1.run(acc, u, wr, wc, fr, fq, lds, wid, lane) || poison != 0u;
        const float qnan = __builtin_nanf("");
#pragma unroll
        for (int ai = 0; ai < 2; ++ai)
#pragma unroll
            for (int m = 0; m < 4; ++m) { const int r = ai * HALF + wr * 64 + m * 16 + fr; const f32x2v sr = S[r]; const size_t off = (size_t)(u.pm * BM + r) * ldc + col0;
#pragma unroll
                for (int bj = 0; bj < 2; ++bj)
#pragma unroll
                    for (int n = 0; n < 2; ++n) { const f32x4 bs = *(const f32x4*)(base + off + bj * HALF + n * 16); acc[ai][bj][m][n] = bs + (acc[ai][bj][m][n] - sr.x) * sr.y; }
                asm volatile("" : "+v"(acc[ai][0][m][0]), "+v"(acc[ai][0][m][1]), "+v"(acc[ai][1][m][0]), "+v"(acc[ai][1][m][1]));
                if (m & 1) asm volatile("" ::: "memory"); }
        const bool bad1 = bad;
        bad = st2.run(acc, u, wr, wc, fr, fq, lds, wid, lane) || bad;
#pragma unroll
        for (int ai = 0; ai < 2; ++ai)
#pragma unroll
            for (int m = 0; m < 4; ++m) { const int r = ai * HALF + wr * 64 + m * 16 + fr; const f32x2v sr = S[r]; const size_t off = (size_t)(u.pm * BM + r) * ldc + col0;
#pragma unroll
                for (int bj = 0; bj < 2; ++bj)
#pragma unroll
                    for (int n = 0; n < 2; ++n) { const f32x4 x1 = acc[ai][bj][m][n]; *(f32x4*)(out + off + bj * HALF + n * 16) = bad1 ? (f32x4){qnan, qnan, qnan, qnan} : x1;
                        const f32x4 o = (x1 - sr.x) * sr.y; u32x2v w; w.x = cvt_pk_bf16(o[0], o[1]); w.y = cvt_pk_bf16(o[2], o[3]);
                        if (bad) { w.x = 0x7fc07fc0u; w.y = 0x7fc07fc0u; } *(u32x2v*)(xn + off + bj * HALF + n * 16) = w; }
                asm volatile("" ::: "memory"); }
    }
};

template <class Epi, class Sched, bool ALIGN_EPI = false, bool SP2 = false>
__device__ __forceinline__ void gemm_phase(PG8_LAS unsigned char* lds, const Gemm g, const Sched& S, const Epi& E) {
    const int tid = threadIdx.x, wid = __builtin_amdgcn_readfirstlane(tid >> 6), lane = tid & 63, wr = wid >> 2, wc = wid & 3, fr = lane & 15, fq = lane >> 4;
    const int K = g.K, nt = K / BK;
    unsigned voffA[2], voffB[2];
#pragma unroll
    for (int i = 0; i < 2; ++i) { int R, C; stage_rc(tid * 16 + i * 8192, R, C); const int Rb = Epi::PERM ? ((R & ~31) + perm32(R & 31)) : R;
        voffA[i] = (unsigned)(R * K + C) * 2u; voffB[i] = (unsigned)(Rb * K + C) * 2u; }
    const size_t kstep = (size_t)(BK * 2);
    const size_t hstep = (size_t)HALF * K * 2;
    const size_t tstep = 2 * hstep;
    const unsigned ldsw = (unsigned)wid * 1024u;
    const int aoff = lds_byte(wr * 64 + fr, fq * 8), boff = lds_byte(wc * 32 + fr, fq * 8);
#define PG8_SA(b, h) (((b) * 2 + (h)) * HTB)
#define PG8_SB(b, h) ((4 + (b) * 2 + (h)) * HTB)
#define PG8_STAGE(bufoff, gbase, voff) do { _Pragma("unroll") for (int _i = 0; _i < 2; ++_i) \
        __builtin_amdgcn_global_load_lds((const unsigned*)((const char*)(gbase) + (voff)[_i]), (PG8_LAS unsigned*)(lds + (bufoff) + ldsw + _i * 8192), 16, 0, 0); } while (0)
#define PG8_LDA(dst, b, h) do { _Pragma("unroll") for (int m = 0; m < 4; ++m) _Pragma("unroll") for (int k = 0; k < 2; ++k) dst[m][k] = *(const PG8_LAS bf16x8*)(lds + PG8_SA(b, h) + aoff + m * 2048 + k * 1024); } while (0)
#define PG8_LDB(dst, b, h) do { _Pragma("unroll") for (int n = 0; n < 2; ++n) _Pragma("unroll") for (int k = 0; k < 2; ++k) dst[n][k] = *(const PG8_LAS bf16x8*)(lds + PG8_SB(b, h) + boff + n * 2048 + k * 1024); } while (0)
#define PG8_MMA(ai, bj, At, Bt) do { __builtin_amdgcn_s_setprio(1); _Pragma("unroll") for (int m = 0; m < 4; ++m) _Pragma("unroll") for (int n = 0; n < 2; ++n) _Pragma("unroll") for (int k = 0; k < 2; ++k) \
        acc[ai][bj][m][n] = __builtin_amdgcn_mfma_f32_16x16x32_bf16(Bt[n][k], At[m][k], acc[ai][bj][m][n], 0, 0, 0); __builtin_amdgcn_s_setprio(0); } while (0)
#define PG8_WAIT_V(n) asm volatile("s_waitcnt vmcnt(" #n ")" ::: "memory")
#define PG8_WAIT_L(n) asm volatile("s_waitcnt lgkmcnt(" #n ")" ::: "memory")
#define PG8_BAR __builtin_amdgcn_s_barrier()
#define PG8_SCHED __builtin_amdgcn_sched_barrier(0)
    Unit cur, nxt; int ui = 0;
    if (!S.next(0, cur)) return;
    f32x4 acc[2][2][4][2];
#pragma unroll
    for (int a = 0; a < 2; ++a)
#pragma unroll
        for (int b = 0; b < 2; ++b)
#pragma unroll
            for (int m = 0; m < 4; ++m)
#pragma unroll
                for (int n = 0; n < 2; ++n) acc[a][b][m][n] = (f32x4){0.f, 0.f, 0.f, 0.f};
    bf16x8 At[4][2], B0[2][2], B1[2][2];
    const char* cA = (const char*)g.A + (size_t)cur.pm * tstep; const char* cB = (const char*)g.Bt + (size_t)cur.pn * tstep;
    S.a_ready(cur);
    if constexpr (SP2) {
        PG8_STAGE(PG8_SB(0, 0), cB, voffB); PG8_STAGE(PG8_SB(0, 1), cB + hstep, voffB); PG8_STAGE(PG8_SA(0, 0), cA, voffA); PG8_STAGE(PG8_SA(0, 1), cA + hstep, voffA);
        if (wr == 1) PG8_BAR;
        PG8_WAIT_V(2); PG8_BAR;
        PG8_STAGE(PG8_SB(1, 0), cB + kstep, voffB); PG8_STAGE(PG8_SA(1, 0), cA + kstep, voffA); PG8_STAGE(PG8_SB(1, 1), cB + hstep + kstep, voffB);
        PG8_WAIT_V(6); PG8_BAR;
    } else {
        PG8_STAGE(PG8_SB(0, 0), cB, voffB); PG8_STAGE(PG8_SA(0, 0), cA, voffA); PG8_STAGE(PG8_SB(0, 1), cB + hstep, voffB); PG8_STAGE(PG8_SA(0, 1), cA + hstep, voffA);
        if (wr == 1) PG8_BAR;
        PG8_WAIT_V(4); PG8_BAR;
        PG8_STAGE(PG8_SB(1, 0), cB + kstep, voffB); PG8_STAGE(PG8_SA(1, 0), cA + kstep, voffA); PG8_STAGE(PG8_SB(1, 1), cB + hstep + kstep, voffB);
        PG8_WAIT_V(6); PG8_BAR;
    }
    for (;;) {
        const bool has_next = S.next(ui + 1, nxt);
        const char* nA = has_next ? (const char*)g.A + (size_t)nxt.pm * tstep : cA; const char* nB = has_next ? (const char*)g.Bt + (size_t)nxt.pn * tstep : cB;
        for (int t = 0; t < nt; t += 2) {
            const bool last = (t == nt - 2);
            const char* a1 = cA + (size_t)(t + 1) * kstep;
            const char* a2 = last ? nA : cA + (size_t)(t + 2) * kstep; const char* b2 = last ? nB : cB + (size_t)(t + 2) * kstep;
            const char* a3 = a2 + kstep; const char* b3 = b2 + kstep;
            if (last && has_next) S.a_ready(nxt);
            if constexpr (SP2) {
            PG8_LDB(B0, 0, 0); PG8_LDB(B1, 0, 1); PG8_SCHED; PG8_LDA(At, 0, 0); PG8_STAGE(PG8_SA(1, 1), a1 + hstep, voffA);
            PG8_WAIT_V(8); PG8_WAIT_L(0); PG8_BAR; PG8_MMA(0, 0, At, B0); PG8_MMA(0, 1, At, B1); PG8_BAR; PG8_SCHED;
            PG8_LDA(At, 0, 1); PG8_STAGE(PG8_SB(0, 0), b2, voffB); PG8_STAGE(PG8_SB(0, 1), b2 + hstep, voffB); PG8_STAGE(PG8_SA(0, 0), a2, voffA);
            PG8_WAIT_V(8); PG8_WAIT_L(0); PG8_BAR; PG8_MMA(1, 0, At, B0); PG8_MMA(1, 1, At, B1); PG8_BAR; PG8_SCHED;
            PG8_LDB(B0, 1, 0); PG8_LDB(B1, 1, 1); PG8_SCHED; PG8_LDA(At, 1, 0); PG8_STAGE(PG8_SA(0, 1), a2 + hstep, voffA);
            PG8_WAIT_V(8); PG8_WAIT_L(0); PG8_BAR; PG8_MMA(0, 0, At, B0); PG8_MMA(0, 1, At, B1); PG8_BAR; PG8_SCHED;
            PG8_LDA(At, 1, 1); PG8_STAGE(PG8_SB(1, 0), b3, voffB); PG8_STAGE(PG8_SB(1, 1), b3 + hstep, voffB); PG8_STAGE(PG8_SA(1, 0), a3, voffA);
            PG8_WAIT_V(8); PG8_WAIT_L(0); PG8_BAR; PG8_MMA(1, 0, At, B0); PG8_MMA(1, 1, At, B1); PG8_BAR; PG8_SCHED;
            } else {
            PG8_LDB(B0, 0, 0); PG8_SCHED; PG8_LDA(At, 0, 0); PG8_STAGE(PG8_SA(1, 1), a1 + hstep, voffA);
            PG8_WAIT_L(8); PG8_BAR; PG8_WAIT_L(0); PG8_MMA(0, 0, At, B0); PG8_BAR; PG8_SCHED;
            PG8_LDB(B1, 0, 1); PG8_STAGE(PG8_SB(0, 0), b2, voffB);
            PG8_BAR; PG8_WAIT_L(0); PG8_MMA(0, 1, At, B1); PG8_BAR;
            PG8_LDA(At, 0, 1); PG8_STAGE(PG8_SA(0, 0), a2, voffA);
            PG8_BAR; PG8_WAIT_L(0); PG8_MMA(1, 0, At, B0); PG8_BAR; PG8_SCHED;
            PG8_STAGE(PG8_SB(0, 1), b2 + hstep, voffB);
            PG8_WAIT_V(6); PG8_BAR; PG8_MMA(1, 1, At, B1); PG8_BAR;
            PG8_LDB(B0, 1, 0); PG8_SCHED; PG8_LDA(At, 1, 0); PG8_STAGE(PG8_SA(0, 1), a2 + hstep, voffA);
            PG8_WAIT_L(8); PG8_BAR; PG8_WAIT_L(0); PG8_MMA(0, 0, At, B0); PG8_BAR; PG8_SCHED;
            PG8_LDB(B1, 1, 1); PG8_STAGE(PG8_SB(1, 0), b3, voffB);
            PG8_BAR; PG8_WAIT_L(0); PG8_MMA(0, 1, At, B1); PG8_BAR;
            PG8_LDA(At, 1, 1); PG8_STAGE(PG8_SA(1, 0), a3, voffA);
            PG8_BAR; PG8_WAIT_L(0); PG8_MMA(1, 0, At, B0); PG8_BAR; PG8_SCHED;
            PG8_STAGE(PG8_SB(1, 1), b3 + hstep, voffB);
            PG8_WAIT_V(6); PG8_BAR; PG8_MMA(1, 1, At, B1); PG8_BAR;
            }
        }
        if constexpr (ALIGN_EPI) { if (wr == 0) PG8_BAR; }
        if constexpr (!Epi::AFTER_DRAIN) { E(acc, cur, wr, wc, fr, fq); S.done(cur); }
        if (!has_next) break;
#pragma unroll
        for (int a = 0; a < 2; ++a)
#pragma unroll
            for (int b = 0; b < 2; ++b)
#pragma unroll
                for (int m = 0; m < 4; ++m)
#pragma unroll
                    for (int n = 0; n < 2; ++n) acc[a][b][m][n] = (f32x4){0.f, 0.f, 0.f, 0.f};
        cur = nxt; cA = nA; cB = nB; ++ui;
        if constexpr (ALIGN_EPI) { if (wr == 1) PG8_BAR; }
    }
    PG8_WAIT_V(0);
    if constexpr (!ALIGN_EPI) { if (wr == 0) PG8_BAR; }
    PG8_BAR;
    if constexpr (Epi::AFTER_DRAIN) { E.fused(acc, cur, wr, wc, fr, fq, lds, wid, lane); S.done(cur); }
#undef PG8_SA
#undef PG8_SB
#undef PG8_STAGE
#undef PG8_LDA
#undef PG8_LDB
#undef PG8_MMA
#undef PG8_WAIT_V
#undef PG8_WAIT_L
#undef PG8_BAR
#undef PG8_SCHED
}
}

#ifndef PG8_SP2
#define PG8_SP2 true
#endif
#ifndef PG8_ALIGN
#define PG8_ALIGN true
#endif
namespace pg8 {
__device__ __forceinline__ float silu_f(float x) { return x * __builtin_amdgcn_rcpf(1.0f + __expf(-x)); }
struct EpiSwiGLU {
    static constexpr bool PERM = true, AFTER_DRAIN = false;
    bf16_t* O; int ldc;
    __device__ __forceinline__ void operator()(const f32x4 (&acc)[2][2][4][2], const Unit& u, int wr, int wc, int fr, int fq) const {
        const int row0 = u.pm * BM + wr * 64 + fr, col0 = u.pn * HALF + wc * 32 + 8 * fq;
#pragma unroll
        for (int ai = 0; ai < 2; ++ai)
#pragma unroll
            for (int m = 0; m < 4; ++m) {
                bf16_t* rowp = O + (size_t)(row0 + ai * HALF + m * 16) * ldc + col0;
                const f32x4 g0 = acc[ai][0][m][0], g1 = acc[ai][0][m][1], u0 = acc[ai][1][m][0], u1 = acc[ai][1][m][1];
                u32x4 w;
                w.x = cvt_pk_bf16(silu_f(g0[0]) * u0[0], silu_f(g0[1]) * u0[1]); w.y = cvt_pk_bf16(silu_f(g0[2]) * u0[2], silu_f(g0[3]) * u0[3]);
                w.z = cvt_pk_bf16(silu_f(g1[0]) * u1[0], silu_f(g1[1]) * u1[1]); w.w = cvt_pk_bf16(silu_f(g1[2]) * u1[2], silu_f(g1[3]) * u1[3]);
                *(u32x4*)rowp = w;
            }
    }
};
struct EpiF32 {
    static constexpr bool PERM = false, AFTER_DRAIN = false;
    float* O; int ldc;
    __device__ __forceinline__ void operator()(const f32x4 (&acc)[2][2][4][2], const Unit& u, int wr, int wc, int fr, int fq) const {
        const int row0 = u.pm * BM + wr * 64 + fr, col0 = u.pn * BM + wc * 32 + 4 * fq;
#pragma unroll
        for (int ai = 0; ai < 2; ++ai)
#pragma unroll
            for (int m = 0; m < 4; ++m) {
                float* rowp = O + (size_t)(row0 + ai * HALF + m * 16) * ldc + col0;
#pragma unroll
                for (int bj = 0; bj < 2; ++bj)
#pragma unroll
                    for (int n = 0; n < 2; ++n) *(f32x4*)(rowp + bj * HALF + n * 16) = acc[ai][bj][m][n];
            }
    }
};
}
#define GAS __attribute__((address_space(1)))
#define LAS __attribute__((address_space(3)))
typedef unsigned short bf16;
typedef unsigned v4u __attribute__((ext_vector_type(4)));
typedef float f32x4 __attribute__((ext_vector_type(4)));
typedef short bf16x8 __attribute__((ext_vector_type(8)));
typedef GAS unsigned gu32;
typedef GAS unsigned long long gu64;
#define RLX_AGENT __ATOMIC_RELAXED, __HIP_MEMORY_SCOPE_AGENT
#define LDS_WAIT() asm volatile("s_waitcnt lgkmcnt(0)" ::: "memory")
#define VM_WAIT() asm volatile("s_waitcnt vmcnt(0)" ::: "memory")
__device__ __forceinline__ unsigned long long rt() { return __builtin_amdgcn_s_memrealtime(); }
__device__ __forceinline__ unsigned f2bf(float f) { unsigned u = __builtin_bit_cast(unsigned, f); return (u + 0x7fffu + ((u >> 16) & 1u)) >> 16; }
__device__ __forceinline__ unsigned pk2(float lo, float hi) { return f2bf(lo) | (f2bf(hi) << 16); }

#define XB_TMO      128
#define XB_XCNT(j)  (256  + 64 * (j))
#define XB_XSUB(j)  (1280 + 64 * (j))
#define XB_XGEN(j)  (2304 + 64 * (j))
#define XB_TOP      3328
#define XB_TOPGEN   3392
#define XCD_BAR_WORDS 3456
#define XB_SPIN_CAP (1u << 18)

__device__ __forceinline__ unsigned xb_ld(unsigned* p)              { return __hip_atomic_load(p, __ATOMIC_RELAXED, __HIP_MEMORY_SCOPE_AGENT); }
__device__ __forceinline__ unsigned xb_add(unsigned* p, unsigned v) { return __hip_atomic_fetch_add(p, v, __ATOMIC_RELAXED, __HIP_MEMORY_SCOPE_AGENT); }
__device__ __forceinline__ unsigned xb_xcc_id() { return (unsigned)__builtin_amdgcn_s_getreg((3 << 11) | 20) & 0xFu; }
#define XB_SPIN(cond, bar) do { unsigned _sp = 0; while (cond) { __builtin_amdgcn_s_sleep(1); \
    if ((++_sp & 255u) == 0u) { if (xb_ld(&(bar)[XB_TMO])) break; if (_sp > XB_SPIN_CAP) { atomicAdd(&(bar)[XB_TMO], 1u); break; } } } } while (0)

struct XcdBarrier {
    unsigned* bar; unsigned x;
    volatile LAS unsigned* st;
};

__device__ __forceinline__ XcdBarrier xcd_barrier_post(unsigned* bar, volatile LAS unsigned* st) {
    XcdBarrier b; b.bar = bar; b.x = xb_xcc_id(); b.st = st;
    if (threadIdx.x == 0) (void)xb_add(&bar[XB_XCNT(b.x)], 1u);
    return b;
}
__device__ __forceinline__ void xcd_barrier_complete(unsigned* bar, unsigned x, unsigned& nloc, unsigned& nx) {
    const unsigned G = gridDim.x * gridDim.y * gridDim.z;
    unsigned sum, cnt, mine, sp = 0u;
    for (;;) {
        sum = 0u; cnt = 0u; mine = 0u;
#pragma unroll
        for (unsigned j = 0; j < 16; ++j) { const unsigned c = xb_ld(&bar[XB_XCNT(j)]); sum += c; cnt += (c > 0u) ? 1u : 0u; mine = (j == x) ? c : mine; }
        if (sum == G) break;
        __builtin_amdgcn_s_sleep(1);
        if ((++sp & 255u) == 0u) { if (xb_ld(&bar[XB_TMO])) break; if (sp > XB_SPIN_CAP) { atomicAdd(&bar[XB_TMO], 1u); break; } }
    }
    nloc = mine > 0u ? mine : 1u; nx = cnt > 0u ? cnt : 1u;
}

__device__ __forceinline__ void xcd_barrier(const XcdBarrier& b) {
    asm volatile("s_waitcnt vmcnt(0)" ::: "memory");
    __syncthreads();
    if (threadIdx.x == 0) {
        unsigned* bar = b.bar;
        __builtin_amdgcn_s_waitcnt(0);
        unsigned nloc = b.st[0], nx = b.st[1];
        if (nloc == 0u) { xcd_barrier_complete(bar, b.x, nloc, nx); b.st[0] = nloc; b.st[1] = nx; }
        const unsigned old = xb_add(&bar[XB_XSUB(b.x)], 1u);
        const unsigned gen = old / nloc;
        if (old + 1u == (gen + 1u) * nloc) {
            __builtin_amdgcn_fence(__ATOMIC_RELEASE, "agent");
            asm volatile("s_waitcnt vmcnt(0)" ::: "memory");
            const unsigned og = xb_add(&bar[XB_TOP], 1u);
            const unsigned tg = og / nx;
            if (og + 1u == (tg + 1u) * nx) xb_add(&bar[XB_TOPGEN], 1u);
            else XB_SPIN(xb_ld(&bar[XB_TOPGEN]) == tg, bar);
            __builtin_amdgcn_fence(__ATOMIC_ACQUIRE, "agent");
            xb_add(&bar[XB_XGEN(b.x)], 1u);
            asm volatile("s_waitcnt vmcnt(0)" ::: "memory");
        } else {
            XB_SPIN(xb_ld(&bar[XB_XGEN(b.x)]) == gen, bar);
            __builtin_amdgcn_fence(__ATOMIC_ACQUIRE, "agent");
            asm volatile("s_waitcnt vmcnt(0)" ::: "memory");
        }
    }
    __syncthreads();
}

constexpr int NWAVES = 8;
constexpr int BATCH = 8, SEQ = 4096, D = 1024, M = BATCH * SEQ;
constexpr int NC_IN = 3592, C_BETA = 2048, C_QB = 2056;
constexpr int NIN = 3584;
constexpr int DFF = 2816, NGU = 2 * DFF;
constexpr float EPS = 1e-6f;
constexpr size_t MiB = 1u << 20;
constexpr size_t WS_CTL = 0, CTL_ZERO_BYTES = 1 * MiB;
constexpr size_t WS_WIN = 1 * MiB, WS_WO = 8 * MiB, WS_WGU = 10 * MiB, WS_WD = 21 * MiB, WS_BG = 27 * MiB;
constexpr size_t WS_XN = 32 * MiB;
constexpr size_t WS_PROJ = 96 * MiB;
constexpr size_t SEG = 32 * MiB;
constexpr size_t WS_ORAW = 96 * MiB;
constexpr size_t WS_Y = 320 * MiB;
constexpr size_t WS_XN2 = 448 * MiB;
constexpr size_t WS_HID = 96 * MiB;
constexpr size_t WS_SO1 = 32 * MiB, WS_SO2 = 64 * MiB, WS_SO3 = 480 * MiB;
constexpr size_t WS_LSE = 28 * MiB;
constexpr size_t WS_MIXO = 224 * MiB;
constexpr size_t WS_GDN = 320 * MiB;
constexpr size_t GDN_BLOB = 73728, GB_W = 0, GB_QD = 16384, GB_KDT = 32768, GB_ATT = 49152, GB_U = 57344, GB_SHARED = 57344;
constexpr size_t WS_GE = 31 * MiB;
constexpr size_t WS_END = 512 * MiB;
constexpr int CW_BAR = 4096;
constexpr int RING_OFF = 0, RING_BYTES = 131072;
constexpr int LDSCTL_OFF = RING_BYTES, MISC_OFF = LDSCTL_OFF + 320;
constexpr int LDS_BYTES = 147456;

__constant__ int c_bkt[3][129] = {
 {0, 1, 2, 3, 4, 5, 6, 7, 8, 9, 10, 11, 12, 13, 14, 15, 16, 16, 16, 16, 16, 16, 17, 17, 17, 17, 17, 17, 17, 17, 18, 18, 18, 18, 18, 18, 18, 18, 18, 18, 19, 19, 19, 19, 19, 19, 19, 19, 19, 19, 19, 19, 19, 19, 20, 20, 20, 20, 20, 20, 20, 20, 20, 20, 20, 20, 20, 20, 20, 20, 20, 20, 20, 21, 21, 21, 21, 21, 21, 21, 21, 21, 21, 21, 21, 21, 21, 21, 21, 21, 21, 21, 21, 21, 21, 21, 21, 21, 21, 22, 22, 22, 22, 22, 22, 22, 22, 22, 22, 22, 22, 22, 22, 22, 22, 22, 22, 22, 22, 22, 22, 22, 22, 22, 22, 22, 22, 22, 22},
 {0, 4, 8, 12, 16, 16, 17, 17, 18, 18, 19, 19, 19, 19, 20, 20, 20, 20, 20, 21, 21, 21, 21, 21, 21, 22, 22, 22, 22, 22, 22, 22, 22, 22, 23, 23, 23, 23, 23, 23, 23, 23, 23, 23, 23, 23, 24, 24, 24, 24, 24, 24, 24, 24, 24, 24, 24, 24, 24, 24, 24, 24, 25, 25, 25, 25, 25, 25, 25, 25, 25, 25, 25, 25, 25, 25, 25, 25, 25, 25, 25, 25, 25, 26, 26, 26, 26, 26, 26, 26, 26, 26, 26, 26, 26, 26, 26, 26, 26, 26, 26, 26, 26, 26, 26, 26, 26, 26, 26, 26, 26, 26, 26, 27, 27, 27, 27, 27, 27, 27, 27, 27, 27, 27, 27, 27, 27, 27, 27},
 {0, 16, 18, 19, 20, 21, 21, 22, 22, 23, 23, 23, 24, 24, 24, 24, 25, 25, 25, 25, 25, 26, 26, 26, 26, 26, 26, 26, 26, 27, 27, 27, 27, 27, 27, 27, 27, 27, 27, 28, 28, 28, 28, 28, 28, 28, 28, 28, 28, 28, 28, 28, 29, 29, 29, 29, 29, 29, 29, 29, 29, 29, 29, 29, 29, 29, 29, 29, 29, 29, 30, 30, 30, 30, 30, 30, 30, 30, 30, 30, 30, 30, 30, 30, 30, 30, 30, 30, 30, 30, 30, 30, 30, 30, 30, 31, 31, 31, 31, 31, 31, 31, 31, 31, 31, 31, 31, 31, 31, 31, 31, 31, 31, 31, 31, 31, 31, 31, 31, 31, 31, 31, 31, 31, 31, 31, 31, 31, 31}};

struct Frame {
    LAS unsigned char* lds;
    volatile LAS unsigned* MISC;
    gu32* ctl;
    int tid, lane, wave, vcu, G;
    unsigned char* ws;
};
struct Args { const float* in[15]; float* out; unsigned char* ws; int ph_lo, ph_hi; };
#define A_x          (A.in[0])
#define A_w_in       (A.in[1])
#define A_conv_w     (A.in[2])
#define A_a_log      (A.in[3])
#define A_dt_bias    (A.in[4])
#define A_onorm_g    (A.in[5])
#define A_rel_bias   (A.in[6])
#define A_w_out      (A.in[7])
#define A_g_mix_pre  (A.in[8])
#define A_g_mix_post (A.in[9])
#define A_w_gate     (A.in[10])
#define A_w_up       (A.in[11])
#define A_w_down     (A.in[12])
#define A_g_ffn_pre  (A.in[13])
#define A_g_ffn_post (A.in[14])
#define W_WIN  ((bf16*)(F.ws + WS_WIN))
#define W_WO   ((bf16*)(F.ws + WS_WO))
#define W_WGU  ((bf16*)(F.ws + WS_WGU))
#define W_WD   ((bf16*)(F.ws + WS_WD))
#define W_BG   ((float*)(F.ws + WS_BG))
#define W_XN   ((bf16*)(F.ws + WS_XN))
#define W_PROJ ((bf16*)(F.ws + WS_PROJ))
#define W_MIXO ((bf16*)(F.ws + WS_MIXO))
#define W_XN2  ((bf16*)(F.ws + WS_XN2))
#define W_HID  ((bf16*)(F.ws + WS_HID))
#define W_ORAW ((float*)(F.ws + WS_ORAW))
#define W_Y    ((float*)(F.ws + WS_Y))
__device__ __forceinline__ float wave_sum(float v) {
#pragma unroll
    for (int o = 1; o < 64; o <<= 1) v += __shfl_xor(v, o);
    return v;
}
__device__ __forceinline__ float bf2f(bf16 b) { return __builtin_bit_cast(float, (unsigned)b << 16); }
__device__ __forceinline__ float siluf(float x) { return x / (1.f + __expf(-x)); }

__device__ __forceinline__ void p0_transpose_item(const float* W, int ldw, int col0, int K, bf16* WT, int dst_row0, int k0, LAS float* scr, int lane) {
#pragma unroll 8
    for (int i = 0; i < 32; ++i) { const int kk = 2 * i + (lane >> 5); scr[kk * 33 + (lane & 31)] = W[(size_t)(k0 + kk) * ldw + col0 + (lane & 31)]; }
    LDS_WAIT(); asm volatile("" ::: "memory");
    const int c = lane & 7;
#pragma unroll
    for (int j = 0; j < 4; ++j) { const int n = (lane >> 3) + 8 * j; const LAS float* s = scr + (8 * c) * 33 + n;
        v4u o; o.x = pk2(s[0 * 33], s[1 * 33]); o.y = pk2(s[2 * 33], s[3 * 33]); o.z = pk2(s[4 * 33], s[5 * 33]); o.w = pk2(s[6 * 33], s[7 * 33]);
        *(GAS v4u*)(WT + (size_t)(dst_row0 + n) * K + k0 + 8 * c) = o; }
    LDS_WAIT(); asm volatile("" ::: "memory");
}

__device__ __forceinline__ void ph_prologue(Frame& F, const Args& A) {
    LAS float* scr = (LAS float*)(F.lds + RING_OFF + F.wave * 16384);
    const int gw = F.vcu * NWAVES + F.wave, NGW = F.G * NWAVES;
    constexpr int I_A = 16 * 64, I_B = 16 * 48, I_O = 16 * 32, I_G = 16 * 88, I_D = 44 * 32;
    constexpr int NITEMS = I_A + I_B + I_O + 2 * I_G + I_D;
    for (int it = gw; it < NITEMS; it += NGW) {
        int r = it;
        if (r < I_A) { const int kb = r / 64, nb = r % 64; p0_transpose_item(A_w_in, NC_IN, 32 * nb, D, W_WIN, 32 * nb, 64 * kb, scr, F.lane); continue; } r -= I_A;
        if (r < I_B) { const int kb = r / 48, nb = r % 48; p0_transpose_item(A_w_in, NC_IN, C_QB + 32 * nb, D, W_WIN, 2048 + 32 * nb, 64 * kb, scr, F.lane); continue; } r -= I_B;
        if (r < I_O) { const int kb = r / 32, nb = r % 32; p0_transpose_item(A_w_out, D, 32 * nb, D, W_WO, 32 * nb, 64 * kb, scr, F.lane); continue; } r -= I_O;
        if (r < I_G) { const int kb = r / 88, nb = r % 88, n0 = 32 * nb; p0_transpose_item(A_w_gate, DFF, n0, D, W_WGU, 256 * (n0 >> 7) + (n0 & 127), 64 * kb, scr, F.lane); continue; } r -= I_G;
        if (r < I_G) { const int kb = r / 88, nb = r % 88, n0 = 32 * nb; p0_transpose_item(A_w_up, DFF, n0, D, W_WGU, 256 * (n0 >> 7) + 128 + (n0 & 127), 64 * kb, scr, F.lane); continue; } r -= I_G;
        { const int kb = r / 32, nb = r % 32; p0_transpose_item(A_w_down, D, 32 * nb, DFF, W_WD, 32 * nb, 64 * kb, scr, F.lane); }
    }
    __syncthreads();
    LAS float* wba = (LAS float*)(F.lds + RING_OFF);
    for (int e = F.tid; e < 8 * D; e += NWAVES * 64) { const int k = e >> 3, c = e & 7; wba[c * D + k] = A_w_in[(size_t)k * NC_IN + C_BETA + c]; }
    __syncthreads();
    for (int m = gw; m < M; m += NGW) {
        const GAS f32x4* xr = (const GAS f32x4*)(A_x + (size_t)m * D) + F.lane;
        const GAS f32x4* gr = (const GAS f32x4*)A_g_mix_pre + F.lane;
        f32x4 v[4]; float s = 0.f;
#pragma unroll
        for (int j = 0; j < 4; ++j) { v[j] = xr[64 * j]; s += (v[j].x * v[j].x + v[j].y * v[j].y) + (v[j].z * v[j].z + v[j].w * v[j].w); }
        const float rstd = rsqrtf(wave_sum(s) * (1.f / D) + EPS);
        GAS unsigned long long* o8 = (GAS unsigned long long*)(W_XN + (size_t)m * D) + F.lane;
        float acc[8];
#pragma unroll
        for (int c = 0; c < 8; ++c) acc[c] = 0.f;
#pragma unroll
        for (int j = 0; j < 4; ++j) {
            const f32x4 g = gr[64 * j]; v[j] = v[j] * rstd * g;
            o8[64 * j] = (unsigned long long)pk2(v[j].x, v[j].y) | ((unsigned long long)pk2(v[j].z, v[j].w) << 32);
#pragma unroll
            for (int c = 0; c < 8; ++c) { const f32x4 w = *((const LAS f32x4*)(wba + c * D) + F.lane + 64 * j); acc[c] += (v[j].x * w.x + v[j].y * w.y) + (v[j].z * w.z + v[j].w * w.w); }
        }
#pragma unroll
        for (int c = 0; c < 8; ++c) acc[c] = wave_sum(acc[c]);
        if (F.lane < 4) {
            const int h = F.lane;
            const float bl = h == 0 ? acc[0] : h == 1 ? acc[1] : h == 2 ? acc[2] : acc[3];
            const float al = h == 0 ? acc[4] : h == 1 ? acc[5] : h == 2 ? acc[6] : acc[7];
            const float beta = 1.f / (1.f + expf(-bl));
            const float xx = al + A_dt_bias[h];
            const float sp = fmaxf(xx, 0.f) + log1pf(expf(-fabsf(xx)));
            W_BG[(size_t)m * 8 + h] = beta;
            W_BG[(size_t)m * 8 + 4 + h] = -expf(A_a_log[h]) * sp;
        }
    }
}


typedef short s16x4_t __attribute__((ext_vector_type(4)));
constexpr int GA_QI = 0, GA_KI = 17408, GA_VI = 34816, GA_AM = 52224, GA_TP = 69632, GA_TPP = 78848, GA_WI = 88064, GA_ATI = 105472, GA_TAB = 114688;
constexpr int GA_RS = 272, GA_TS = 144;
__device__ __forceinline__ s16x4_t lds_tr16p(LAS unsigned char* p) { return __builtin_bit_cast(s16x4_t, __builtin_amdgcn_ds_read_tr16_b64_v4i16((LAS s16x4_t*)p)); }
__device__ __forceinline__ unsigned mul_pk(unsigned w, float s0, float s1) {
    return pk2(__builtin_bit_cast(float, w << 16) * s0, __builtin_bit_cast(float, w & 0xffff0000u) * s1);
}
constexpr int GA_CW = 115712;
constexpr int GA_RAW = 52224, GA_RAWS = 784;
__device__ __forceinline__ void gdn_raw_load(Frame& F, int cu, int tid, v4u (&pre)[7]) {
    const int bh = cu >> 6, c = cu & 63, b = bh >> 2, h = bh & 3;
    const long rowm3 = (long)b * SEQ + (long)c * 64 - 3;
#pragma unroll
    for (int k = 0; k < 7; ++k) {
        const int e = tid + 512 * k, row = e / 48, pc = e % 48, sgm = pc >> 4, c16 = pc & 15;
        pre[k] = (v4u){0u, 0u, 0u, 0u};
        if (e < 67 * 48 && (c * 64 - 3 + row) >= 0)
            pre[k] = *(const GAS v4u*)(W_PROJ + (size_t)sgm * M * 512 + (size_t)(rowm3 + row) * 512 + h * 128 + c16 * 8);
    }
}
__device__ __forceinline__ void gdn_prep_chunk(Frame& F, const Args& A, int cu, int cu_next, v4u (&pre)[7]) {
    const int bh = cu >> 6, c = cu & 63, b = bh >> 2, h = bh & 3;
    const size_t row0 = (size_t)b * SEQ + (size_t)c * 64;
    LAS unsigned char* lds = F.lds + RING_OFF;
    LAS float* tab = (LAS float*)(lds + GA_TAB);
    unsigned char* blob = F.ws + WS_GDN + (size_t)cu * GDN_BLOB;
    int tid = F.tid; asm volatile("" : "+v"(tid));
    const int lane = tid & 63, x = lane & 15, g = lane >> 4;
#pragma unroll
    for (int k = 0; k < 7; ++k) {
        const int e = tid + 512 * k, row = e / 48, pc = e % 48;
        if (e < 67 * 48) *(LAS v4u*)(lds + GA_RAW + row * GA_RAWS + pc * 16) = pre[k];
    }
    __syncthreads();
    if (cu_next < 2048) gdn_raw_load(F, cu_next, tid, pre);
    {
        const int i = tid >> 3, cc = tid & 7;
#pragma unroll
        for (int sgm = 0; sgm < 3; ++sgm) {
            float a[16];
#pragma unroll
            for (int e = 0; e < 16; ++e) a[e] = 0.f;
#pragma unroll
            for (int tap = 0; tap < 4; ++tap) {
                const LAS unsigned char* rp = lds + GA_RAW + (i + tap) * GA_RAWS + sgm * 256 + cc * 32;
                const v4u r0 = *(const LAS v4u*)rp, r1 = *(const LAS v4u*)(rp + 16);
                const LAS f32x4* cw = (const LAS f32x4*)(lds + GA_CW + ((sgm * 4 + tap) * 128 + cc * 16) * 4);
                const f32x4 c0 = cw[0], c1 = cw[1], c2 = cw[2], c3 = cw[3];
                a[0] += c0[0] * __builtin_bit_cast(float, r0.x << 16); a[1] += c0[1] * __builtin_bit_cast(float, r0.x & 0xffff0000u);
                a[2] += c0[2] * __builtin_bit_cast(float, r0.y << 16); a[3] += c0[3] * __builtin_bit_cast(float, r0.y & 0xffff0000u);
                a[4] += c1[0] * __builtin_bit_cast(float, r0.z << 16); a[5] += c1[1] * __builtin_bit_cast(float, r0.z & 0xffff0000u);
                a[6] += c1[2] * __builtin_bit_cast(float, r0.w << 16); a[7] += c1[3] * __builtin_bit_cast(float, r0.w & 0xffff0000u);
                a[8] += c2[0] * __builtin_bit_cast(float, r1.x << 16); a[9] += c2[1] * __builtin_bit_cast(float, r1.x & 0xffff0000u);
                a[10] += c2[2] * __builtin_bit_cast(float, r1.y << 16); a[11] += c2[3] * __builtin_bit_cast(float, r1.y & 0xffff0000u);
                a[12] += c3[0] * __builtin_bit_cast(float, r1.z << 16); a[13] += c3[1] * __builtin_bit_cast(float, r1.z & 0xffff0000u);
                a[14] += c3[2] * __builtin_bit_cast(float, r1.w << 16); a[15] += c3[3] * __builtin_bit_cast(float, r1.w & 0xffff0000u);
            }
            float ss = 0.f;
#pragma unroll
            for (int e = 0; e < 16; ++e) { a[e] = siluf(a[e]); ss += a[e] * a[e]; }
            float scale = 1.f;
            if (sgm < 2) { ss += __shfl_xor(ss, 1); ss += __shfl_xor(ss, 2); ss += __shfl_xor(ss, 4); scale = rsqrtf(ss + 1e-6f) * (sgm == 0 ? 0.08838834764831845f : 1.f); }
            v4u w0, w1;
            w0.x = pk2(a[0] * scale, a[1] * scale); w0.y = pk2(a[2] * scale, a[3] * scale); w0.z = pk2(a[4] * scale, a[5] * scale); w0.w = pk2(a[6] * scale, a[7] * scale);
            w1.x = pk2(a[8] * scale, a[9] * scale); w1.y = pk2(a[10] * scale, a[11] * scale); w1.z = pk2(a[12] * scale, a[13] * scale); w1.w = pk2(a[14] * scale, a[15] * scale);
            LAS unsigned char* img = lds + (sgm == 0 ? GA_QI : (sgm == 1 ? GA_KI : GA_VI)) + i * GA_RS + cc * 32;
            *(LAS v4u*)img = w0; *(LAS v4u*)(img + 16) = w1;
        }
        if (F.wave == 0) {
            const float beta = W_BG[(row0 + lane) * 8 + h]; float gcs = W_BG[(row0 + lane) * 8 + 4 + h];
#pragma unroll
            for (int o = 1; o < 64; o <<= 1) { const float up = __shfl_up(gcs, o); if (lane >= o) gcs += up; }
            const float gl = __shfl(gcs, 63);
            tab[lane] = gcs; tab[64 + lane] = __expf(gcs); tab[128 + lane] = __expf(gl - gcs); tab[192 + lane] = beta;
            if (lane == 0) ((float*)(F.ws + WS_GE))[cu] = __expf(gl);
        }
    }
    __syncthreads();
    {
        const int mi = F.wave >> 1;
        bf16x8 ak[4], aq[4];
#pragma unroll
        for (int s4 = 0; s4 < 4; ++s4) {
            ak[s4] = *(const LAS bf16x8*)(lds + GA_KI + (16 * mi + x) * GA_RS + (32 * s4 + 8 * g) * 2);
            aq[s4] = *(const LAS bf16x8*)(lds + GA_QI + (16 * mi + x) * GA_RS + (32 * s4 + 8 * g) * 2);
        }
#pragma unroll
        for (int t2 = 0; t2 < 2; ++t2) {
            const int nj = 2 * (F.wave & 1) + t2;
            f32x4 kk = {0.f, 0.f, 0.f, 0.f}, qk = {0.f, 0.f, 0.f, 0.f};
#pragma unroll
            for (int s4 = 0; s4 < 4; ++s4) {
                const bf16x8 bk = *(const LAS bf16x8*)(lds + GA_KI + (16 * nj + x) * GA_RS + (32 * s4 + 8 * g) * 2);
                kk = __builtin_amdgcn_mfma_f32_16x16x32_bf16(ak[s4], bk, kk, 0, 0, 0);
                qk = __builtin_amdgcn_mfma_f32_16x16x32_bf16(aq[s4], bk, qk, 0, 0, 0);
            }
            const int j = 16 * nj + x; const float gcj = tab[j];
#pragma unroll
            for (int e = 0; e < 4; ++e) {
                const int i = 16 * mi + 4 * g + e;
                const float dec = (i >= j) ? __expf(tab[i] - gcj) : 0.f;
                ((LAS float*)(lds + GA_AM))[j * 68 + (i & 7) * 8 + (i >> 3)] = (i > j) ? tab[192 + i] * kk[e] * dec : 0.f;
                ((LAS bf16*)(lds + GA_ATI))[i * 72 + j] = (bf16)f2bf(qk[e] * dec);
            }
        }
    }
    __syncthreads();
    {
        const int cl = lane >> 3, rg = lane & 7, col = 8 * F.wave + cl;
        const LAS float* am = (const LAS float*)(lds + GA_AM) + rg * 8;
        float t[8];
#pragma unroll
        for (int k = 0; k < 8; ++k) t[k] = (rg + 8 * k == col) ? 1.f : 0.f;
        const int jstart = 8 * F.wave;
#pragma unroll
        for (int j = 0; j < 63; ++j) {
            if (j >= jstart) {
                const float tj = __shfl(t[j >> 3], (lane & 56) | (j & 7));
                const f32x4 a0 = *(const LAS f32x4*)(am + j * 68), a1 = *(const LAS f32x4*)(am + j * 68 + 4);
#pragma unroll
                for (int k = 0; k < 8; ++k) if (8 * k + 7 > j) t[k] -= (k < 4 ? a0[k & 3] : a1[k & 3]) * tj;
            }
        }
        const float bc = tab[192 + col], bec = bc * tab[64 + col];
#pragma unroll
        for (int k = 0; k < 8; ++k) {
            ((LAS bf16*)(lds + GA_TP))[(rg + 8 * k) * 72 + col] = (bf16)f2bf(t[k] * bc);
            ((LAS bf16*)(lds + GA_TPP))[(rg + 8 * k) * 72 + col] = (bf16)f2bf(t[k] * bec);
        }
        for (int f = F.wave; f < 40; f += 8) {
            if (f < 16) {
                const int s4 = f & 3, i = 16 * (f >> 2) + x; const float sc = tab[64 + i];
                const LAS unsigned char* rp = lds + GA_QI + i * GA_RS + (32 * s4 + 4 * g) * 2;
                const unsigned long long lo = *(const LAS unsigned long long*)rp, hi = *(const LAS unsigned long long*)(rp + 32);
                v4u w; w.x = mul_pk((unsigned)lo, sc, sc); w.y = mul_pk((unsigned)(lo >> 32), sc, sc); w.z = mul_pk((unsigned)hi, sc, sc); w.w = mul_pk((unsigned)(hi >> 32), sc, sc);
                *(GAS v4u*)(blob + GB_QD + (size_t)(f * 64 + lane) * 16) = w;
            } else if (f < 32) {
                const int ff = f - 16, m = ff >> 1, s2 = ff & 1;
                const int r0 = 32 * s2 + 4 * g;
                LAS unsigned char* ap = lds + GA_KI + (r0 + (x >> 2)) * GA_RS + (16 * m + 4 * (x & 3)) * 2;
                const s16x4_t lo = lds_tr16p(ap), hi = lds_tr16p(ap + 16 * GA_RS);
                const f32x4 s_lo = *(const LAS f32x4*)(tab + 128 + r0), s_hi = *(const LAS f32x4*)(tab + 128 + r0 + 16);
                v4u w;
                w.x = pk2(bf2f((bf16)lo[0]) * s_lo[0], bf2f((bf16)lo[1]) * s_lo[1]); w.y = pk2(bf2f((bf16)lo[2]) * s_lo[2], bf2f((bf16)lo[3]) * s_lo[3]);
                w.z = pk2(bf2f((bf16)hi[0]) * s_hi[0], bf2f((bf16)hi[1]) * s_hi[1]); w.w = pk2(bf2f((bf16)hi[2]) * s_hi[2], bf2f((bf16)hi[3]) * s_hi[3]);
                *(GAS v4u*)(blob + GB_KDT + (size_t)(ff * 64 + lane) * 16) = w;
            } else {
                const int ff = f - 32, s2 = ff & 1, i = 16 * (ff >> 1) + x;
                const LAS unsigned char* rp = lds + GA_ATI + i * GA_TS + (32 * s2 + 4 * g) * 2;
                const unsigned long long lo = *(const LAS unsigned long long*)rp, hi = *(const LAS unsigned long long*)(rp + 32);
                v4u w; w.x = (unsigned)lo; w.y = (unsigned)(lo >> 32); w.z = (unsigned)hi; w.w = (unsigned)(hi >> 32);
                *(GAS v4u*)(blob + GB_ATT + (size_t)(ff * 64 + lane) * 16) = w;
            }
        }
    }
    __syncthreads();
    {
        const int n = F.wave;
#pragma unroll
        for (int which = 0; which < 2; ++which) {
            const int timg = which == 0 ? GA_TP : GA_TPP, bimg = which == 0 ? GA_VI : GA_KI;
            bf16x8 bfr[2];
#pragma unroll
            for (int s2 = 0; s2 < 2; ++s2) {
                LAS unsigned char* ap = lds + bimg + (32 * s2 + 8 * g + (x >> 2)) * GA_RS + (16 * n + 4 * (x & 3)) * 2;
                const s16x4_t lo = lds_tr16p(ap), hi = lds_tr16p(ap + 4 * GA_RS);
                bfr[s2] = (bf16x8){lo[0], lo[1], lo[2], lo[3], hi[0], hi[1], hi[2], hi[3]};
            }
#pragma unroll
            for (int m = 0; m < 4; ++m) {
                f32x4 acc = {0.f, 0.f, 0.f, 0.f};
#pragma unroll
                for (int s2 = 0; s2 < 2; ++s2) {
                    const bf16x8 af = *(const LAS bf16x8*)(lds + timg + (16 * m + x) * GA_TS + (32 * s2 + 8 * g) * 2);
                    acc = __builtin_amdgcn_mfma_f32_16x16x32_bf16(af, bfr[s2], acc, 0, 0, 0);
                }
                if (which == 0) {
                    const unsigned long long w = (unsigned long long)pk2(acc[0], acc[1]) | ((unsigned long long)pk2(acc[2], acc[3]) << 32);
                    *(GAS unsigned long long*)(blob + GB_U + (size_t)((n * 4 + m) * 64 + lane) * 8) = w;
                } else {
#pragma unroll
                    for (int e = 0; e < 4; ++e) ((LAS bf16*)(lds + GA_WI))[(16 * m + 4 * g + e) * 136 + 16 * n + x] = (bf16)f2bf(acc[e]);
                }
            }
        }
    }
    __syncthreads();
#pragma unroll
    for (int q2 = 0; q2 < 2; ++q2) {
        const int f = F.wave * 2 + q2, s4 = f & 3, i = 16 * (f >> 2) + x;
        const LAS unsigned char* rp = lds + GA_WI + i * GA_RS + (32 * s4 + 4 * g) * 2;
        const unsigned long long lo = *(const LAS unsigned long long*)rp, hi = *(const LAS unsigned long long*)(rp + 32);
        v4u w; w.x = (unsigned)lo; w.y = (unsigned)(lo >> 32); w.z = (unsigned)hi; w.w = (unsigned)(hi >> 32);
        *(GAS v4u*)(blob + GB_W + (size_t)(f * 64 + lane) * 16) = w;
    }
}
__device__ __forceinline__ void ph_gdn_prep(Frame& F, const Args& A) {
    int hl = -1; v4u pre[7];
    int cu = (int)blockIdx.x;
    if (cu < 2048) gdn_raw_load(F, cu, F.tid, pre);
    for (; cu < 2048; cu += F.G) {
        const int h = (cu >> 6) & 3;
        if (h != hl) {
            for (int e = F.tid; e < 1536; e += NWAVES * 64) { const int sgm = e >> 9, tap = (e >> 7) & 3, ch = e & 127; ((LAS float*)(F.lds + RING_OFF + GA_CW))[e] = A_conv_w[tap * 1536 + sgm * 512 + h * 128 + ch]; }
            hl = h;
        }
        gdn_prep_chunk(F, A, cu, cu + F.G, pre);
        __syncthreads();
    }
}
__device__ __forceinline__ void ph_gdn_scan(Frame& F, const Args& A, int bh) {
    const int b = bh >> 2, h = bh & 3, lane = F.lane, x = lane & 15, g = lane >> 4, n = F.wave;
    LAS unsigned char* lds = F.lds + RING_OFF;
    const unsigned char* blob0 = F.ws + WS_GDN + (size_t)(bh * 64) * GDN_BLOB;
    const float* GE = (const float*)(F.ws + WS_GE) + bh * 64;
    f32x4 Sacc[8];
#pragma unroll
    for (int t = 0; t < 8; ++t) Sacc[t] = (f32x4){0.f, 0.f, 0.f, 0.f};
    v4u st[7]; unsigned long long un[4]; float ge_n;
#pragma unroll
    for (int i = 0; i < 7; ++i) st[i] = *(const GAS v4u*)(blob0 + (size_t)(n * 7 + i) * 1024 + lane * 16);
#pragma unroll
    for (int m = 0; m < 4; ++m) un[m] = *(const GAS unsigned long long*)(blob0 + GB_U + (size_t)((n * 4 + m) * 64 + lane) * 8);
    ge_n = GE[0];
#pragma unroll
    for (int i = 0; i < 7; ++i) *(LAS v4u*)(lds + (n * 7 + i) * 1024 + lane * 16) = st[i];
    __syncthreads();
    for (int c = 0; c < 64; ++c) {
        LAS unsigned char* cur = lds + (c & 1) * GB_SHARED;
        LAS unsigned char* nxt = lds + ((c + 1) & 1) * GB_SHARED;
        unsigned long long uc[4]; const float ge = ge_n;
#pragma unroll
        for (int m = 0; m < 4; ++m) uc[m] = un[m];
        if (c + 1 < 64) {
            const unsigned char* bl = blob0 + (size_t)(c + 1) * GDN_BLOB;
#pragma unroll
            for (int i = 0; i < 7; ++i) st[i] = *(const GAS v4u*)(bl + (size_t)(n * 7 + i) * 1024 + lane * 16);
#pragma unroll
            for (int m = 0; m < 4; ++m) un[m] = *(const GAS unsigned long long*)(bl + GB_U + (size_t)((n * 4 + m) * 64 + lane) * 8);
            ge_n = GE[c + 1];
        }
        bf16x8 Sb[4];
#pragma unroll
        for (int s4 = 0; s4 < 4; ++s4) {
            v4u w; w.x = pk2(Sacc[2 * s4][0], Sacc[2 * s4][1]); w.y = pk2(Sacc[2 * s4][2], Sacc[2 * s4][3]); w.z = pk2(Sacc[2 * s4 + 1][0], Sacc[2 * s4 + 1][1]); w.w = pk2(Sacc[2 * s4 + 1][2], Sacc[2 * s4 + 1][3]);
            Sb[s4] = __builtin_bit_cast(bf16x8, w);
        }
        f32x4 vn[4], o[4];
#pragma unroll
        for (int m = 0; m < 4; ++m) {
            f32x4 ws = {0.f, 0.f, 0.f, 0.f}, qs = {0.f, 0.f, 0.f, 0.f};
#pragma unroll
            for (int s4 = 0; s4 < 4; ++s4) {
                const bf16x8 wf = *(const LAS bf16x8*)(cur + GB_W + ((m * 4 + s4) * 64 + lane) * 16);
                const bf16x8 qf = *(const LAS bf16x8*)(cur + GB_QD + ((m * 4 + s4) * 64 + lane) * 16);
                ws = __builtin_amdgcn_mfma_f32_16x16x32_bf16(wf, Sb[s4], ws, 0, 0, 0);
                qs = __builtin_amdgcn_mfma_f32_16x16x32_bf16(qf, Sb[s4], qs, 0, 0, 0);
            }
            const unsigned ulo = (unsigned)uc[m], uhi = (unsigned)(uc[m] >> 32);
            vn[m][0] = __builtin_bit_cast(float, ulo << 16) - ws[0]; vn[m][1] = __builtin_bit_cast(float, ulo & 0xffff0000u) - ws[1];
            vn[m][2] = __builtin_bit_cast(float, uhi << 16) - ws[2]; vn[m][3] = __builtin_bit_cast(float, uhi & 0xffff0000u) - ws[3];
            o[m] = qs;
        }
        bf16x8 Vb[2];
#pragma unroll
        for (int s2 = 0; s2 < 2; ++s2) {
            v4u w; w.x = pk2(vn[2 * s2][0], vn[2 * s2][1]); w.y = pk2(vn[2 * s2][2], vn[2 * s2][3]); w.z = pk2(vn[2 * s2 + 1][0], vn[2 * s2 + 1][1]); w.w = pk2(vn[2 * s2 + 1][2], vn[2 * s2 + 1][3]);
            Vb[s2] = __builtin_bit_cast(bf16x8, w);
        }
        const size_t orow = (size_t)b * SEQ + (size_t)c * 64;
#pragma unroll
        for (int m = 0; m < 4; ++m) {
#pragma unroll
            for (int s2 = 0; s2 < 2; ++s2) {
                const bf16x8 af = *(const LAS bf16x8*)(cur + GB_ATT + ((m * 2 + s2) * 64 + lane) * 16);
                o[m] = __builtin_amdgcn_mfma_f32_16x16x32_bf16(af, Vb[s2], o[m], 0, 0, 0);
            }
#pragma unroll
            for (int e = 0; e < 4; ++e) W_ORAW[(orow + 16 * m + 4 * g + e) * 512 + h * 128 + 16 * n + x] = o[m][e];
        }
#pragma unroll
        for (int t = 0; t < 8; ++t) {
            f32x4 acc = Sacc[t] * ge;
#pragma unroll
            for (int s2 = 0; s2 < 2; ++s2) {
                const bf16x8 kf = *(const LAS bf16x8*)(cur + GB_KDT + ((t * 2 + s2) * 64 + lane) * 16);
                acc = __builtin_amdgcn_mfma_f32_16x16x32_bf16(kf, Vb[s2], acc, 0, 0, 0);
            }
            Sacc[t] = acc;
        }
        if (c + 1 < 64) {
#pragma unroll
            for (int i = 0; i < 7; ++i) *(LAS v4u*)(nxt + (n * 7 + i) * 1024 + lane * 16) = st[i];
        }
        __syncthreads();
    }
}

__device__ __forceinline__ void ph_gdn_out(Frame& F, const Args& A) {
    const int gw = F.vcu * NWAVES + F.wave, NGW = F.G * NWAVES;
    const bf16* GA = W_PROJ + (size_t)3 * M * 512;
    for (int it = gw; it < M * 4; it += NGW) {
        const int m = it >> 2, h = it & 3;
        const size_t o0 = (size_t)m * 512 + h * 128 + F.lane;
        const float a = W_ORAW[o0], b = W_ORAW[o0 + 64];
        const float s = wave_sum(a * a + b * b);
        const float r = rsqrtf(s * (1.f / 128.f) + EPS);
        W_MIXO[(size_t)m * D + h * 128 + F.lane] = (bf16)f2bf(a * r * A_onorm_g[F.lane] * siluf(bf2f(GA[o0])));
        W_MIXO[(size_t)m * D + h * 128 + F.lane + 64] = (bf16)f2bf(b * r * A_onorm_g[F.lane + 64] * siluf(bf2f(GA[o0 + 64])));
    }
}
typedef short s16x4 __attribute__((ext_vector_type(4)));
constexpr int SWA_TASKS = 64 * 48;
constexpr int SWA_KOFF = 0, SWA_VOFF = 49152, SWA_TB = 98304;
__device__ __forceinline__ s16x4 lds_tr16(unsigned addr) { return __builtin_bit_cast(s16x4, __builtin_amdgcn_ds_read_tr16_b64_v4i16((LAS s16x4*)(uintptr_t)addr)); }
__device__ __forceinline__ void swa_task(Frame& F, const Args& A, int tk) {
    const int bh = tk / 48, rem = tk % 48, p = rem >> 4, idx = rem & 15;
    const int b = bh >> 3, h = bh & 7;
    const int dil = p == 0 ? 1 : (p == 1 ? 4 : 16), nblk = 16 / dil, r = idx / nblk, m0 = 256 * (idx % nblk);
    const bf16* QB = W_PROJ + (size_t)4 * M * 512; const bf16* KB = W_PROJ + (size_t)5 * M * 512; const bf16* VB = W_PROJ + (size_t)6 * M * 512;
    bf16* OP = (bf16*)(F.ws + (p == 0 ? WS_SO1 : (p == 1 ? WS_SO2 : WS_SO3)));
    float* LSE = (float*)(F.ws + WS_LSE) + (size_t)p * M * 8;
    const size_t rowb = (size_t)b * SEQ;
    LAS unsigned char* lds = F.lds + RING_OFF;
    {
        v4u tmp[12];
#pragma unroll
        for (int i = 0; i < 12; ++i) {
            const int e = F.tid + 512 * i, which = e / 3072, rm = e % 3072, row = rm >> 3, c = rm & 7;
            int sp = m0 - 128 + row; sp = sp < 0 ? 0 : sp;
            const bf16* src = (which ? VB : KB) + (rowb + (size_t)sp * dil + r) * 512 + h * 64 + c * 8;
            tmp[i] = *(const GAS v4u*)src;
        }
#pragma unroll
        for (int i = 0; i < 12; ++i) {
            const int e = F.tid + 512 * i, which = e / 3072, rm = e % 3072, row = rm >> 3, c = rm & 7;
            *(LAS v4u*)(lds + which * SWA_VOFF + row * 128 + ((c ^ (row & 7)) << 4)) = tmp[i];
        }
        if (F.tid < 129) ((LAS float*)(lds + SWA_TB))[F.tid] = A_rel_bias[c_bkt[p][F.tid] * 8 + h];
    }
    __syncthreads();
    const int lane = F.lane, q = lane & 15, g = lane >> 4;
    const LAS float* tb = (const LAS float*)(lds + SWA_TB);
#pragma unroll 1
    for (int qi = 0; qi < 2; ++qi) {
        const int qt = F.wave * 2 + qi;
        const size_t qtok = rowb + (size_t)(m0 + 16 * qt + q) * dil + r;
        const bf16x8 qf0 = *(const GAS bf16x8*)(QB + qtok * 512 + h * 64 + 8 * g);
        const bf16x8 qf1 = *(const GAS bf16x8*)(QB + qtok * 512 + h * 64 + 32 + 8 * g);
        float sc[9][4];
        float mx = -INFINITY;
#pragma unroll
        for (int jt = 0; jt < 9; ++jt) {
            const int kt = qt + jt, krow = 16 * kt + q;
            const bf16x8 kf0 = *(const LAS bf16x8*)(lds + SWA_KOFF + krow * 128 + (((g) ^ (krow & 7)) << 4));
            const bf16x8 kf1 = *(const LAS bf16x8*)(lds + SWA_KOFF + krow * 128 + (((g + 4) ^ (krow & 7)) << 4));
            f32x4 acc = {0.f, 0.f, 0.f, 0.f};
            acc = __builtin_amdgcn_mfma_f32_16x16x32_bf16(kf0, qf0, acc, 0, 0, 0);
            acc = __builtin_amdgcn_mfma_f32_16x16x32_bf16(kf1, qf1, acc, 0, 0, 0);
#pragma unroll
            for (int e = 0; e < 4; ++e) {
                const int kx = 4 * g + e, rel = 128 - 16 * jt + q - kx, spk = m0 - 128 + 16 * kt + kx;
                const bool valid = (rel >= 0) && (rel <= 128) && (spk >= 0);
                const int relc = rel < 0 ? 0 : (rel > 128 ? 128 : rel);
                const float v = acc[e] * 0.125f + tb[relc];
                sc[jt][e] = valid ? v : -INFINITY;
                mx = fmaxf(mx, sc[jt][e]);
            }
        }
        mx = fmaxf(mx, __shfl_xor(mx, 16)); mx = fmaxf(mx, __shfl_xor(mx, 32));
        float l = 0.f;
#pragma unroll
        for (int jt = 0; jt < 9; ++jt)
#pragma unroll
            for (int e = 0; e < 4; ++e) { sc[jt][e] = __expf(sc[jt][e] - mx); l += sc[jt][e]; }
        l += __shfl_xor(l, 16); l += __shfl_xor(l, 32);
        bf16x8 pf[5];
#pragma unroll
        for (int s2 = 0; s2 < 5; ++s2) {
            v4u w;
            w.x = pk2(sc[2 * s2][0], sc[2 * s2][1]); w.y = pk2(sc[2 * s2][2], sc[2 * s2][3]);
            if (s2 < 4) { w.z = pk2(sc[2 * s2 + 1][0], sc[2 * s2 + 1][1]); w.w = pk2(sc[2 * s2 + 1][2], sc[2 * s2 + 1][3]); } else { w.z = 0u; w.w = 0u; }
            pf[s2] = __builtin_bit_cast(bf16x8, w);
        }
        const float rl = 1.0f / l;
        const unsigned vbase = (unsigned)(uintptr_t)(lds + SWA_VOFF);
#pragma unroll
        for (int mt = 0; mt < 4; ++mt) {
            f32x4 o = {0.f, 0.f, 0.f, 0.f};
#pragma unroll
            for (int s2 = 0; s2 < 5; ++s2) {
                const int row0 = 16 * (qt + 2 * s2) + 4 * g + (q >> 2), c = 2 * mt + ((q & 3) >> 1);
                const s16x4 lo = lds_tr16(vbase + row0 * 128 + ((c ^ (row0 & 7)) << 4) + 8 * (q & 1));
                s16x4 hi = {0, 0, 0, 0};
                if (s2 < 4) { const int row1 = row0 + 16; hi = lds_tr16(vbase + row1 * 128 + ((c ^ (row1 & 7)) << 4) + 8 * (q & 1)); }
                const bf16x8 vf = {lo[0], lo[1], lo[2], lo[3], hi[0], hi[1], hi[2], hi[3]};
                o = __builtin_amdgcn_mfma_f32_16x16x32_bf16(vf, pf[s2], o, 0, 0, 0);
            }
            unsigned long long w = (unsigned long long)pk2(o[0] * rl, o[1] * rl) | ((unsigned long long)pk2(o[2] * rl, o[3] * rl) << 32);
            *(GAS unsigned long long*)(OP + qtok * 512 + h * 64 + 16 * mt + 4 * g) = w;
        }
        if (g == 0) LSE[qtok * 8 + h] = mx + __logf(l);
    }
    __syncthreads();
}
__device__ __forceinline__ void ph_swa(Frame& F, const Args& A, int widx, int nw) {
    const int lo = (int)(((long)widx * SWA_TASKS) / nw), hi = (int)(((long)(widx + 1) * SWA_TASKS) / nw);
    for (int tk = lo; tk < hi; ++tk) swa_task(F, A, tk);
}
__device__ __forceinline__ void ph_swa_merge(Frame& F) {
    const int gw = F.vcu * NWAVES + F.wave, NGW = F.G * NWAVES;
    const float* LSE = (const float*)(F.ws + WS_LSE);
    const bf16* O1 = (const bf16*)(F.ws + WS_SO1); const bf16* O2 = (const bf16*)(F.ws + WS_SO2); const bf16* O3 = (const bf16*)(F.ws + WS_SO3);
    for (int it = gw; it < M * 8; it += NGW) {
        const int m = it >> 3, h = it & 7;
        const float l1 = LSE[(size_t)m * 8 + h], l2 = LSE[(size_t)M * 8 + (size_t)m * 8 + h], l3 = LSE[(size_t)2 * M * 8 + (size_t)m * 8 + h];
        const float mx = fmaxf(l1, fmaxf(l2, l3));
        const float w1 = __expf(l1 - mx), w2 = __expf(l2 - mx), w3 = __expf(l3 - mx);
        const size_t o = (size_t)m * 512 + h * 64 + F.lane;
        const float v = (w1 * bf2f(O1[o]) + w2 * bf2f(O2[o]) + w3 * bf2f(O3[o])) / (w1 + w2 + w3);
        W_MIXO[(size_t)m * D + 512 + h * 64 + F.lane] = (bf16)f2bf(v);
    }
}
__device__ __forceinline__ void ph_norm_res(Frame& F, const float* y, const float* g1, const float* base, float* out, const float* g2, bf16* hn) {
    const int gw = F.vcu * NWAVES + F.wave, NGW = F.G * NWAVES;
    for (int m = gw; m < M; m += NGW) {
        const GAS f32x4* yr = (const GAS f32x4*)(y + (size_t)m * D) + F.lane;
        const GAS f32x4* br = (const GAS f32x4*)(base + (size_t)m * D) + F.lane;
        GAS f32x4* orow = (GAS f32x4*)(out + (size_t)m * D) + F.lane;
        f32x4 v[4]; float s = 0.f;
#pragma unroll
        for (int j = 0; j < 4; ++j) { v[j] = yr[64 * j]; s += (v[j].x * v[j].x + v[j].y * v[j].y) + (v[j].z * v[j].z + v[j].w * v[j].w); }
        const float r = rsqrtf(wave_sum(s) * (1.f / D) + EPS);
        float s2 = 0.f;
#pragma unroll
        for (int j = 0; j < 4; ++j) { const f32x4 g = ((const GAS f32x4*)g1)[F.lane + 64 * j]; v[j] = br[64 * j] + v[j] * r * g; orow[64 * j] = v[j];
            s2 += (v[j].x * v[j].x + v[j].y * v[j].y) + (v[j].z * v[j].z + v[j].w * v[j].w); }
        if (hn) {
            const float r2 = rsqrtf(wave_sum(s2) * (1.f / D) + EPS);
            GAS unsigned long long* o8 = (GAS unsigned long long*)(hn + (size_t)m * D) + F.lane;
#pragma unroll
            for (int j = 0; j < 4; ++j) { const f32x4 g = ((const GAS f32x4*)g2)[F.lane + 64 * j]; const f32x4 w = v[j] * r2 * g;
                o8[64 * j] = (unsigned long long)pk2(w.x, w.y) | ((unsigned long long)pk2(w.z, w.w) << 32); }
        }
    }
}

constexpr int N_PHASES = 10;
#ifndef MK_PER_PHASE
#define MK_PER_PHASE 0
#endif
__global__ void __launch_bounds__(NWAVES * 64, 2) mk_fwd(Args args) {
    extern __shared__ __attribute__((aligned(16))) unsigned char lds[];
    Frame F;
    F.lds = (LAS unsigned char*)lds;
    F.MISC = (volatile LAS unsigned*)(F.lds + MISC_OFF);
    F.tid = threadIdx.x; F.lane = F.tid & 63; F.wave = __builtin_amdgcn_readfirstlane(F.tid >> 6);
    F.G = gridDim.x; { const int bx = blockIdx.x; F.vcu = (F.G % 8 == 0) ? (bx % 8) * (F.G / 8) + bx / 8 : bx; }
    unsigned char* ws = args.ws;
    F.ctl = (gu32*)(ws + WS_CTL);
    F.ws = ws; const Args& A = args;
    for (int u = F.tid; u < (LDS_BYTES - LDSCTL_OFF) / 4; u += NWAVES * 64) ((LAS unsigned*)(F.lds + LDSCTL_OFF))[u] = 0u;
    __syncthreads();
    XcdBarrier bar; bar.bar = (unsigned*)(F.ctl + CW_BAR); bar.x = 0; bar.st = nullptr;
    if (!MK_PER_PHASE) bar = xcd_barrier_post((unsigned*)(F.ctl + CW_BAR), F.MISC + 8);
    const int lo = args.ph_lo, hi = args.ph_hi;
#ifndef PHMASK
#define PHMASK 0xFFFF
#endif
#define IN(k) (((PHMASK >> (k)) & 1) && lo <= (k) && (k) < hi)
#define SEAM(k) do { if (IN(k) && IN((k) + 1)) xcd_barrier(bar); } while (0)
#ifndef REPMASK
#define REPMASK 0
#endif
#define REP(k) for (int rep_ = 0; rep_ < 1 + ((REPMASK >> (k)) & 1); ++rep_, (rep_ < 1 + ((REPMASK >> (k)) & 1)) ? xcd_barrier(bar) : (void)0)

    if (IN(0)) REP(0) { ph_prologue(F, args); } SEAM(0);
    if (IN(1)) REP(1) {
        pg8::Gemm g{W_XN, W_WIN, M, NIN, D}; pg8::StaticOrder S; S.init(M, NIN, F.G, (int)blockIdx.x);
        pg8::EpiBf16<0> E{W_PROJ, 512, nullptr, 512, (size_t)M * 512, 1.f};
        pg8::gemm_phase<pg8::EpiBf16<0>, pg8::StaticOrder, true, true>(F.lds + RING_OFF, g, S, E);
    } SEAM(1);
    if (IN(2)) REP(2) { ph_gdn_prep(F, args); } SEAM(2);
    if (IN(3)) REP(3) {
        if (blockIdx.x < 32) ph_gdn_scan(F, args, (int)blockIdx.x);
        else ph_swa(F, args, (int)blockIdx.x - 32, F.G - 32);
    } SEAM(3);
    if (IN(4)) REP(4) { ph_gdn_out(F, args); ph_swa_merge(F); } SEAM(4);
    if (IN(5)) REP(5) {
        pg8::Gemm g{W_MIXO, W_WO, M, D, D}; pg8::StaticOrder S; S.init(M, D, F.G, (int)blockIdx.x);
        pg8::EpiF32 E{W_Y, D};
        pg8::gemm_phase<pg8::EpiF32, pg8::StaticOrder, true, true>(F.lds + RING_OFF, g, S, E);
    } SEAM(5);
    if (IN(6)) REP(6) { ph_norm_res(F, W_Y, A_g_mix_post, A_x, A.out, A_g_ffn_pre, W_XN2); } SEAM(6);
    if (IN(7)) REP(7) {
        pg8::Gemm g{W_XN2, W_WGU, M, NGU, D}; pg8::StaticOrder S; S.init(M, NGU, F.G, (int)blockIdx.x);
        pg8::EpiSwiGLU E{W_HID, DFF};
        pg8::gemm_phase<pg8::EpiSwiGLU, pg8::StaticOrder, true, true>(F.lds + RING_OFF, g, S, E);
    } SEAM(7);
    if (IN(8)) REP(8) {
        pg8::Gemm g{W_HID, W_WD, M, D, DFF}; pg8::StaticOrder S; S.init(M, D, F.G, (int)blockIdx.x);
        pg8::EpiF32 E{W_Y, D};
        pg8::gemm_phase<pg8::EpiF32, pg8::StaticOrder, true, true>(F.lds + RING_OFF, g, S, E);
    } SEAM(8);
    if (IN(9)) REP(9) { ph_norm_res(F, W_Y, A_g_ffn_post, A.out, A.out, nullptr, nullptr); }
#undef IN
#undef SEAM
}

extern "C" void kernel_launch(void* const* d_in, const int* in_sizes, int n_in, void* d_out, int out_size, void* d_ws, size_t ws_size, hipStream_t stream) {
    static int grid = 0;
    if (grid == 0) {
        if (n_in != 15 || in_sizes[0] != M * D || out_size != M * D || ws_size < WS_END) {
            fprintf(stderr, "kernel_launch: unexpected shapes/workspace: n_in %d in0 %d out %d ws %zu (need %zu); nothing launched\n", n_in, n_in > 0 ? in_sizes[0] : -1, out_size, ws_size, (size_t)WS_END); grid = -1; return; }
        int dev = 0, cus = 0, per_cu = 0;
        if (hipGetDevice(&dev) != hipSuccess || hipDeviceGetAttribute(&cus, hipDeviceAttributeMultiprocessorCount, dev) != hipSuccess) { fprintf(stderr, "kernel_launch: device query failed\n"); grid = -1; return; }
        if (hipFuncSetAttribute((const void*)mk_fwd, hipFuncAttributeMaxDynamicSharedMemorySize, LDS_BYTES) != hipSuccess) { fprintf(stderr, "kernel_launch: hipFuncSetAttribute failed\n"); grid = -1; return; }
        if (hipOccupancyMaxActiveBlocksPerMultiprocessor(&per_cu, (const void*)mk_fwd, NWAVES * 64, LDS_BYTES) != hipSuccess || per_cu < 1) {
            fprintf(stderr, "kernel_launch: occupancy query reports %d workgroups per CU; nothing launched\n", per_cu); (void)hipGetLastError(); grid = -1; return; }
        (void)hipGetLastError();
        grid = cus;
    }
    if (grid < 0) return;
    if (hipMemsetAsync((char*)d_ws + WS_CTL, 0, CTL_ZERO_BYTES, stream) != hipSuccess) { fprintf(stderr, "kernel_launch: memset failed\n"); return; }
    Args a{};
    for (int i = 0; i < 15; ++i) a.in[i] = (const float*)d_in[i];
    a.out = (float*)d_out; a.ws = (unsigned char*)d_ws;
#if MK_PER_PHASE
    for (int p = 0; p < N_PHASES; ++p) { a.ph_lo = p; a.ph_hi = p + 1; hipLaunchKernelGGL(mk_fwd, dim3(grid), dim3(NWAVES * 64), LDS_BYTES, stream, a); }
#else
    a.ph_lo = 0; a.ph_hi = N_PHASES;
    hipLaunchKernelGGL(mk_fwd, dim3(grid), dim3(NWAVES * 64), LDS_BYTES, stream, a);
#endif
    const hipError_t le = hipPeekAtLastError();
    if (le != hipSuccess) fprintf(stderr, "kernel_launch: launch failed: %s\n", hipGetErrorName(le));
}
```

```cpp
#include <hip/hip_runtime.h>
#include <cstdio>
#include <cstdint>
#include <cmath>
namespace pg8 {
#define PG8_LAS __attribute__((address_space(3)))
typedef unsigned short bf16_t;
typedef short bf16x8 __attribute__((ext_vector_type(8)));
typedef float f32x4 __attribute__((ext_vector_type(4)));
typedef unsigned u32x4 __attribute__((ext_vector_type(4)));
constexpr int BM = 256, BK = 64, HALF = 128, HTB = HALF * BK * 2  , STAGE_BYTES = 8 * HTB, NXCD = 8, WGM = 8;

__host__ __device__ __forceinline__ int lds_byte(int r, int c) { const int st = (r >> 4) * 2 + (c >> 5), rr = r & 15, cc = c & 31, ob = rr * 64 + cc * 2; return st * 1024 + (ob ^ (((ob >> 9) & 1) << 5)); }
__host__ __device__ __forceinline__ void stage_rc(int b, int& R, int& C) { const int st = b / 1024, sb = b % 1024, swz = sb ^ (((sb >> 9) & 1) << 5); R = (st >> 1) * 16 + swz / 64; C = (st & 1) * 32 + (swz % 64) / 2; }
__host__ __device__ __forceinline__ int perm32(int rho) { const int n = rho >> 4, i = rho & 15; return 8 * (i >> 2) + 4 * n + (i & 3); }

struct Unit { int pm, pn; };
struct Gemm { const bf16_t* A; const bf16_t* Bt; int M, N, K; };

struct StaticOrder {
    int nM, nN, nwg, G, c;
    __host__ __device__ void init(int M, int N, int G_, int c_) { nM = M / BM; nN = N / BM; nwg = nM * nN; G = G_; c = c_; }
    __host__ __device__ bool next(int i, Unit& u) const {
        const long L = (long)i * G + c; if (L >= nwg) return false;
        int wgid = (int)L; { const int q = nwg / NXCD, r = nwg % NXCD, xcd = wgid % NXCD, off = wgid / NXCD; wgid = (xcd < r ? xcd * (q + 1) : r * (q + 1) + (xcd - r) * q) + off; }
        const int nig = WGM * nN, gid = wgid / nig, fm = gid * WGM, gsz = (nM - fm) < WGM ? (nM - fm) : WGM;
        u.pm = fm + ((wgid % nig) % gsz); u.pn = (wgid % nig) / gsz; return true;
    }
    __device__ __forceinline__ void a_ready(const Unit&) const {}
    __device__ __forceinline__ void done(const Unit&) const {}
};

__device__ __forceinline__ unsigned cvt_pk_bf16(float lo, float hi) { unsigned r; asm volatile("v_cvt_pk_bf16_f32 %0, %1, %2" : "=v"(r) : "v"(lo), "v"(hi)); return r; }
typedef float f32x2 __attribute__((ext_vector_type(2)));
__device__ __forceinline__ f32x2 gelu_pk(f32x2 v) {
    const f32x2 av = __builtin_elementwise_abs(v), d = av * 0.2316418882f + 1.0f;
    f32x2 t; t.x = __builtin_amdgcn_rcpf(d.x); t.y = __builtin_amdgcn_rcpf(d.y);
    f32x2 q = t * 0.5307027145f + (-0.7265760135f); q = q * t + 0.7107068705f; q = q * t + (-0.142248368f); q = q * t + 0.127414796f; q = q * t;
    const f32x2 s = (v * v) * (-0.72134752044f);
    f32x2 e; e.x = __builtin_amdgcn_exp2f(s.x); e.y = __builtin_amdgcn_exp2f(s.y);
    const f32x2 m = v * (q * e), r = v - m;
    f32x2 o; o.x = v.x < 0.f ? m.x : r.x; o.y = v.y < 0.f ? m.y : r.y; return o;
}

template <int ACT  > struct EpiBf16 {
    static constexpr bool PERM = true, AFTER_DRAIN = false; static_assert(ACT == 0 || ACT == 1, "EpiBf16: ACT is 0 (none) or 1 (gelu_pk)");
    bf16_t* O; int ldc; const float* bias; int split_cols; size_t split_stride; float scale0;
    __device__ __forceinline__ void operator()(const f32x4 (&acc)[2][2][4][2], const Unit& u, int wr, int wc, int fr, int fq) const {
        const int row0 = u.pm * BM + wr * 64 + fr; int colt = u.pn * BM; bf16_t* base = O;
        float sc = 1.f; if (split_cols) { const int t = colt / split_cols; base += (size_t)t * split_stride; colt -= t * split_cols; if (t == 0) sc = scale0; }
        const int col0 = colt + wc * 32 + 8 * fq, bcol0 = u.pn * BM + wc * 32 + 8 * fq;
        f32x4 bv[2][2];
#pragma unroll
        for (int bj = 0; bj < 2; ++bj)
#pragma unroll
            for (int n = 0; n < 2; ++n) bv[bj][n] = bias ? *(const f32x4*)(bias + bcol0 + bj * HALF + 4 * n) : (f32x4){0.f, 0.f, 0.f, 0.f};
#pragma unroll
        for (int ai = 0; ai < 2; ++ai)
#pragma unroll
            for (int m = 0; m < 4; ++m) { bf16_t* rowp = base + (size_t)(row0 + ai * HALF + m * 16) * ldc + col0;
#pragma unroll
                for (int bj = 0; bj < 2; ++bj) { f32x4 v0 = acc[ai][bj][m][0] + bv[bj][0], v1 = acc[ai][bj][m][1] + bv[bj][1];
                    if (ACT == 1) { f32x2 a = gelu_pk((f32x2){v0[0], v0[1]}), b = gelu_pk((f32x2){v0[2], v0[3]}), c = gelu_pk((f32x2){v1[0], v1[1]}), d = gelu_pk((f32x2){v1[2], v1[3]});
                        v0 = (f32x4){a.x, a.y, b.x, b.y}; v1 = (f32x4){c.x, c.y, d.x, d.y}; }
                    v0 = v0 * sc; v1 = v1 * sc; u32x4 w; w.x = cvt_pk_bf16(v0[0], v0[1]); w.y = cvt_pk_bf16(v0[2], v0[3]); w.z = cvt_pk_bf16(v1[0], v1[1]); w.w = cvt_pk_bf16(v1[2], v1[3]);
                    *(u32x4*)(rowp + bj * HALF) = w; } }
    }
};

struct PanelStats {
    unsigned* xbuf;
    unsigned* cnt;
    unsigned* tmo;
    int ntn; float eps;
    unsigned code;
    __device__ __forceinline__ bool run(const f32x4 (&v)[2][2][4][2], const Unit& u, int wr, int wc, int fr, int fq, PG8_LAS unsigned char* lds, int wid, int lane) const {
        typedef float f32x2v __attribute__((ext_vector_type(2)));
        PG8_LAS f32x2v* P = (PG8_LAS f32x2v*)lds;
        PG8_LAS f32x2v* S = (PG8_LAS f32x2v*)(lds + 8192);
        PG8_LAS unsigned* flag = (PG8_LAS unsigned*)(lds + 8192 + 2048);
#pragma unroll
        for (int ai = 0; ai < 2; ++ai)
#pragma unroll
            for (int m = 0; m < 4; ++m) {
                float s = 0.f;
#pragma unroll
                for (int bj = 0; bj < 2; ++bj)
#pragma unroll
                    for (int n = 0; n < 2; ++n) { const f32x4 x = v[ai][bj][m][n]; s += (x[0] + x[1]) + (x[2] + x[3]); }
                s += __shfl_xor(s, 16); s += __shfl_xor(s, 32);
                const float mw = s * (1.0f / 64.0f); float q = 0.f;
#pragma unroll
                for (int bj = 0; bj < 2; ++bj)
#pragma unroll
                    for (int n = 0; n < 2; ++n) { const f32x4 d = v[ai][bj][m][n] - mw; q += (d[0] * d[0] + d[1] * d[1]) + (d[2] * d[2] + d[3] * d[3]); }
                q += __shfl_xor(q, 16); q += __shfl_xor(q, 32);
                if (fq == 0) P[(ai * HALF + wr * 64 + m * 16 + fr) * 4 + wc] = (f32x2v){mw, q};
            }
        asm volatile("s_waitcnt lgkmcnt(0)" ::: "memory"); __builtin_amdgcn_s_barrier(); asm volatile("" ::: "memory");
#if defined(BROKEN_EXCHANGE_NO_WAIT)
#warning BROKEN CONTROL BUILD: the row-statistics exchange does not wait; results are wrong by design
        if (blockIdx.x >= 64) { const long long t0_ = clock64(); while (clock64() - t0_ < 60000) __builtin_amdgcn_s_sleep(8); }
#endif
        const int row = wid * 32 + (lane & 31);
        if (lane < 32) {
            const f32x2v a = P[row * 4 + 0], b = P[row * 4 + 1], c = P[row * 4 + 2], d = P[row * 4 + 3];
            const float mt = (a.x + b.x + c.x + d.x) * 0.25f;
            const float da = a.x - mt, db = b.x - mt, dc = c.x - mt, dd = d.x - mt;
            const float m2 = (a.y + b.y) + (c.y + d.y) + 64.0f * ((da * da + db * db) + (dc * dc + dd * dd));
            unsigned long long* slot = (unsigned long long*)xbuf + ((size_t)(u.pm * BM + row) * 4 + u.pn);
            __hip_atomic_store(slot, ((unsigned long long)__float_as_uint(m2) << 32) | __float_as_uint(mt), __ATOMIC_RELAXED, __HIP_MEMORY_SCOPE_AGENT);
        }
        asm volatile("s_waitcnt vmcnt(0)" ::: "memory");
        if (lane == 0) __hip_atomic_fetch_add(cnt + 64 * u.pm, 1u, __ATOMIC_RELAXED, __HIP_MEMORY_SCOPE_AGENT);
        if (wid == 0) {
            bool dead = false; const unsigned long long t0 = __builtin_amdgcn_s_memrealtime(); const unsigned want = 8u * (unsigned)ntn;
            for (;;) {
#if defined(BROKEN_EXCHANGE_NO_WAIT)
                break;
#endif
                if ((unsigned)__builtin_amdgcn_readfirstlane(__hip_atomic_load(cnt + 64 * u.pm, __ATOMIC_RELAXED, __HIP_MEMORY_SCOPE_AGENT)) >= want) break;
                if (__builtin_amdgcn_s_memrealtime() - t0 > 2000000ull) {
                    if (lane == 0) { unsigned expect = 0u; __hip_atomic_compare_exchange_strong(tmo + 1, &expect, code | (unsigned)(u.pm & 0xff), __ATOMIC_RELAXED, __ATOMIC_RELAXED, __HIP_MEMORY_SCOPE_AGENT);
                                     __hip_atomic_store(tmo, 1u, __ATOMIC_RELAXED, __HIP_MEMORY_SCOPE_AGENT); }
                    dead = true; break; }
                __builtin_amdgcn_s_sleep(2);
            }
            __builtin_amdgcn_fence(__ATOMIC_ACQUIRE, "agent");
            if (lane == 0) flag[0] = dead ? 1u : 0u;
        }
        asm volatile("s_waitcnt vmcnt(0) lgkmcnt(0)" ::: "memory"); __builtin_amdgcn_s_barrier(); asm volatile("" ::: "memory");
        const bool bad = flag[0] != 0u;
        if (lane < 32) {
            const unsigned long long* slot = (const unsigned long long*)xbuf + (size_t)(u.pm * BM + row) * 4; float mt[4], m2[4]; float ms = 0.f;
#pragma unroll
            for (int t = 0; t < 4; ++t) { if (t < ntn) { const unsigned long long w = __hip_atomic_load(slot + t, __ATOMIC_RELAXED, __HIP_MEMORY_SCOPE_AGENT); mt[t] = __uint_as_float((unsigned)w); m2[t] = __uint_as_float((unsigned)(w >> 32)); } else { mt[t] = 0.f; m2[t] = 0.f; } ms += mt[t]; }
            const float mean = ms / (float)ntn; float q = 0.f;
#pragma unroll
            for (int t = 0; t < 4; ++t) if (t < ntn) { const float dm = mt[t] - mean; q += m2[t] + 256.0f * dm * dm; }
            S[row] = (f32x2v){mean, 1.0f / sqrtf(q / (256.0f * (float)ntn) + eps)};
        }
        asm volatile("s_waitcnt lgkmcnt(0)" ::: "memory"); __builtin_amdgcn_s_barrier(); asm volatile("" ::: "memory");
        return bad;
    }
};
struct EpiLnRes {
    static constexpr bool PERM = false, AFTER_DRAIN = true;
    const float* base; float* out; int ldc; const float* bias; PanelStats st; unsigned poison;
    __device__ __forceinline__ void fused(f32x4 (&acc)[2][2][4][2], const Unit& u, int wr, int wc, int fr, int fq, PG8_LAS unsigned char* lds, int wid, int lane) const {
        typedef float f32x2v __attribute__((ext_vector_type(2)));
        const PG8_LAS f32x2v* S = (const PG8_LAS f32x2v*)(lds + 8192);
        const int col0 = u.pn * BM + wc * 32 + 4 * fq;
#pragma unroll
        for (int bj = 0; bj < 2; ++bj)
#pragma unroll
            for (int n = 0; n < 2; ++n) { const f32x4 bv = bias ? *(const f32x4*)(bias + col0 + bj * HALF + n * 16) : (f32x4){0.f, 0.f, 0.f, 0.f};
#pragma unroll
                for (int ai = 0; ai < 2; ++ai)
#pragma unroll
                    for (int m = 0; m < 4; ++m) acc[ai][bj][m][n] += bv; }
        f32x4 pre[4][2][2];
#pragma unroll
        for (int m = 0; m < 4; ++m) { const size_t off = (size_t)(u.pm * BM + wr * 64 + m * 16 + fr) * ldc + col0;
#pragma unroll
            for (int bj = 0; bj < 2; ++bj)
#pragma unroll
                for (int n = 0; n < 2; ++n) pre[m][bj][n] = *(const f32x4*)(base + off + bj * HALF + n * 16); }
        const bool bad = st.run(acc, u, wr, wc, fr, fq, lds, wid, lane) || poison != 0u;
        const float qnan = __builtin_nanf("");
#pragma unroll
        for (int ai = 0; ai < 2; ++ai)
#pragma unroll
            for (int m = 0; m < 4; ++m) { const int r = ai * HALF + wr * 64 + m * 16 + fr; const f32x2v sr = S[r]; const size_t off = (size_t)(u.pm * BM + r) * ldc + col0;
#pragma unroll
                for (int bj = 0; bj < 2; ++bj)
#pragma unroll
                    for (int n = 0; n < 2; ++n) { const f32x4 bs = ai == 0 ? pre[m][bj][n] : *(const f32x4*)(base + off + bj * HALF + n * 16); f32x4 o = bs + (acc[ai][bj][m][n] - sr.x) * sr.y;
                        if (bad) o = (f32x4){qnan, qnan, qnan, qnan}; *(f32x4*)(out + off + bj * HALF + n * 16) = o; }
                if (m & 1) asm volatile("" ::: "memory"); }
    }
};
struct EpiLnResLn {
    static constexpr bool PERM = false, AFTER_DRAIN = true;
    const float* base; float* out; bf16_t* xn; int ldc; const float* bias; PanelStats st1, st2; unsigned poison;
    __device__ __forceinline__ void fused(f32x4 (&acc)[2][2][4][2], const Unit& u, int wr, int wc, int fr, int fq, PG8_LAS unsigned char* lds, int wid, int lane) const {
        typedef float f32x2v __attribute__((ext_vector_type(2))); typedef unsigned u32x2v __attribute__((ext_vector_type(2)));
        const PG8_LAS f32x2v* S = (const PG8_LAS f32x2v*)(lds + 8192);
        const int col0 = u.pn * BM + wc * 32 + 4 * fq;
#pragma unroll
        for (int bj = 0; bj < 2; ++bj)
#pragma unroll
            for (int n = 0; n < 2; ++n) { const f32x4 bv = bias ? *(const f32x4*)(bias + col0 + bj * HALF + n * 16) : (f32x4){0.f, 0.f, 0.f, 0.f};
#pragma unroll
                for (int ai = 0; ai < 2; ++ai)
#pragma unroll
                    for (int m = 0; m < 4; ++m) acc[ai][bj][m][n] += bv; }
        bool bad = st1.run(acc, u, wr, wc, fr, fq, lds, wid, lane) || poison != 0u;
        const float qnan = __builtin_nanf("");
#pragma unroll
        for (int ai = 0; ai < 2; ++ai)
#pragma unroll
            for (int m = 0; m < 4; ++m) { const int r = ai * HALF + wr * 64 + m * 16 + fr; const f32x2v sr = S[r]; const size_t off = (size_t)(u.pm * BM + r) * ldc + col0;
#pragma unroll
                for (int bj = 0; bj < 2; ++bj)
#pragma unroll
                    for (int n = 0; n < 2; ++n) { const f32x4 bs = *(const f32x4*)(base + off + bj * HALF + n * 16); acc[ai][bj][m][n] = bs + (acc[ai][bj][m][n] - sr.x) * sr.y; }
                asm volatile("" : "+v"(acc[ai][0][m][0]), "+v"(acc[ai][0][m][1]), "+v"(acc[ai][1][m][0]), "+v"(acc[ai][1][m][1]));
                if (m & 1) asm volatile("" ::: "memory"); }
        const bool bad1 = bad;
        bad = st2.run(acc, u, wr, wc, fr, fq, lds, wid, lane) || bad;
#pragma unroll
        for (int ai = 0; ai < 2; ++ai)
#pragma unroll
            for (int m = 0; m < 4; ++m) { const int r = ai * HALF + wr * 64 + m * 16 + fr; const f32x2v sr = S[r]; const size_t off = (size_t)(u.pm * BM + r) * ldc + col0;
#pragma unroll
                for (int bj = 0; bj < 2; ++bj)
#pragma unroll
                    for (int n = 0; n < 2; ++n) { const f32x4 x1 = acc[ai][bj][m][n]; *(f32x4*)(out + off + bj * HALF + n * 16) = bad1 ? (f32x4){qnan, qnan, qnan, qnan} : x1;
                        const f32x4 o = (x1 - sr.x) * sr.y; u32x2v w; w.x = cvt_pk_bf16(o[0], o[1]); w.y = cvt_pk_bf16(o[2], o[3]);
                        if (bad) { w.x = 0x7fc07fc0u; w.y = 0x7fc07fc0u; } *(u32x2v*)(xn + off + bj * HALF + n * 16) = w; }
                asm volatile("" ::: "memory"); }
    }
};

template <class Epi, class Sched, bool ALIGN_EPI = false, bool SP2 = false>
__device__ __forceinline__ void gemm_phase(PG8_LAS unsigned char* lds, const Gemm g, const Sched& S, const Epi& E) {
    const int tid = threadIdx.x, wid = __builtin_amdgcn_readfirstlane(tid >> 6), lane = tid & 63, wr = wid >> 2, wc = wid & 3, fr = lane & 15, fq = lane >> 4;
    const int K = g.K, nt = K / BK;
    unsigned voffA[2], voffB[2];
#pragma unroll
    for (int i = 0; i < 2; ++i) { int R, C; stage_rc(tid * 16 + i * 8192, R, C); const int Rb = Epi::PERM ? ((R & ~31) + perm32(R & 31)) : R;
        voffA[i] = (unsigned)(R * K + C) * 2u; voffB[i] = (unsigned)(Rb * K + C) * 2u; }
    const size_t kstep = (size_t)(BK * 2);
    const size_t hstep = (size_t)HALF * K * 2;
    const size_t tstep = 2 * hstep;
    const unsigned ldsw = (unsigned)wid * 1024u;
    const int aoff = lds_byte(wr * 64 + fr, fq * 8), boff = lds_byte(wc * 32 + fr, fq * 8);
#define PG8_SA(b, h) (((b) * 2 + (h)) * HTB)
#define PG8_SB(b, h) ((4 + (b) * 2 + (h)) * HTB)
#define PG8_STAGE(bufoff, gbase, voff) do { _Pragma("unroll") for (int _i = 0; _i < 2; ++_i) \
        __builtin_amdgcn_global_load_lds((const unsigned*)((const char*)(gbase) + (voff)[_i]), (PG8_LAS unsigned*)(lds + (bufoff) + ldsw + _i * 8192), 16, 0, 0); } while (0)
#define PG8_LDA(dst, b, h) do { _Pragma("unroll") for (int m = 0; m < 4; ++m) _Pragma("unroll") for (int k = 0; k < 2; ++k) dst[m][k] = *(const PG8_LAS bf16x8*)(lds + PG8_SA(b, h) + aoff + m * 2048 + k * 1024); } while (0)
#define PG8_LDB(dst, b, h) do { _Pragma("unroll") for (int n = 0; n < 2; ++n) _Pragma("unroll") for (int k = 0; k < 2; ++k) dst[n][k] = *(const PG8_LAS bf16x8*)(lds + PG8_SB(b, h) + boff + n * 2048 + k * 1024); } while (0)
#define PG8_MMA(ai, bj, At, Bt) do { __builtin_amdgcn_s_setprio(1); _Pragma("unroll") for (int m = 0; m < 4; ++m) _Pragma("unroll") for (int n = 0; n < 2; ++n) _Pragma("unroll") for (int k = 0; k < 2; ++k) \
        acc[ai][bj][m][n] = __builtin_amdgcn_mfma_f32_16x16x32_bf16(Bt[n][k], At[m][k], acc[ai][bj][m][n], 0, 0, 0); __builtin_amdgcn_s_setprio(0); } while (0)
#define PG8_WAIT_V(n) asm volatile("s_waitcnt vmcnt(" #n ")" ::: "memory")
#define PG8_WAIT_L(n) asm volatile("s_waitcnt lgkmcnt(" #n ")" ::: "memory")
#define PG8_BAR __builtin_amdgcn_s_barrier()
#define PG8_SCHED __builtin_amdgcn_sched_barrier(0)
    Unit cur, nxt; int ui = 0;
    if (!S.next(0, cur)) return;
    f32x4 acc[2][2][4][2];
#pragma unroll
    for (int a = 0; a < 2; ++a)
#pragma unroll
        for (int b = 0; b < 2; ++b)
#pragma unroll
            for (int m = 0; m < 4; ++m)
#pragma unroll
                for (int n = 0; n < 2; ++n) acc[a][b][m][n] = (f32x4){0.f, 0.f, 0.f, 0.f};
    bf16x8 At[4][2], B0[2][2], B1[2][2];
    const char* cA = (const char*)g.A + (size_t)cur.pm * tstep; const char* cB = (const char*)g.Bt + (size_t)cur.pn * tstep;
    S.a_ready(cur);
    if constexpr (SP2) {
        PG8_STAGE(PG8_SB(0, 0), cB, voffB); PG8_STAGE(PG8_SB(0, 1), cB + hstep, voffB); PG8_STAGE(PG8_SA(0, 0), cA, voffA); PG8_STAGE(PG8_SA(0, 1), cA + hstep, voffA);
        if (wr == 1) PG8_BAR;
        PG8_WAIT_V(2); PG8_BAR;
        PG8_STAGE(PG8_SB(1, 0), cB + kstep, voffB); PG8_STAGE(PG8_SA(1, 0), cA + kstep, voffA); PG8_STAGE(PG8_SB(1, 1), cB + hstep + kstep, voffB);
        PG8_WAIT_V(6); PG8_BAR;
    } else {
        PG8_STAGE(PG8_SB(0, 0), cB, voffB); PG8_STAGE(PG8_SA(0, 0), cA, voffA); PG8_STAGE(PG8_SB(0, 1), cB + hstep, voffB); PG8_STAGE(PG8_SA(0, 1), cA + hstep, voffA);
        if (wr == 1) PG8_BAR;
        PG8_WAIT_V(4); PG8_BAR;
        PG8_STAGE(PG8_SB(1, 0), cB + kstep, voffB); PG8_STAGE(PG8_SA(1, 0), cA + kstep, voffA); PG8_STAGE(PG8_SB(1, 1), cB + hstep + kstep, voffB);
        PG8_WAIT_V(6); PG8_BAR;
    }
    for (;;) {
        const bool has_next = S.next(ui + 1, nxt);
        const char* nA = has_next ? (const char*)g.A + (size_t)nxt.pm * tstep : cA; const char* nB = has_next ? (const char*)g.Bt + (size_t)nxt.pn * tstep : cB;
        for (int t = 0; t < nt; t += 2) {
            const bool last = (t == nt - 2);
            const char* a1 = cA + (size_t)(t + 1) * kstep;
            const char* a2 = last ? nA : cA + (size_t)(t + 2) * kstep; const char* b2 = last ? nB : cB + (size_t)(t + 2) * kstep;
            const char* a3 = a2 + kstep; const char* b3 = b2 + kstep;
            if (last && has_next) S.a_ready(nxt);
            if constexpr (SP2) {
            PG8_LDB(B0, 0, 0); PG8_LDB(B1, 0, 1); PG8_SCHED; PG8_LDA(At, 0, 0); PG8_STAGE(PG8_SA(1, 1), a1 + hstep, voffA);
            PG8_WAIT_V(8); PG8_WAIT_L(0); PG8_BAR; PG8_MMA(0, 0, At, B0); PG8_MMA(0, 1, At, B1); PG8_BAR; PG8_SCHED;
            PG8_LDA(At, 0, 1); PG8_STAGE(PG8_SB(0, 0), b2, voffB); PG8_STAGE(PG8_SB(0, 1), b2 + hstep, voffB); PG8_STAGE(PG8_SA(0, 0), a2, voffA);
            PG8_WAIT_V(8); PG8_WAIT_L(0); PG8_BAR; PG8_MMA(1, 0, At, B0); PG8_MMA(1, 1, At, B1); PG8_BAR; PG8_SCHED;
            PG8_LDB(B0, 1, 0); PG8_LDB(B1, 1, 1); PG8_SCHED; PG8_LDA(At, 1, 0); PG8_STAGE(PG8_SA(0, 1), a2 + hstep, voffA);
            PG8_WAIT_V(8); PG8_WAIT_L(0); PG8_BAR; PG8_MMA(0, 0, At, B0); PG8_MMA(0, 1, At, B1); PG8_BAR; PG8_SCHED;
            PG8_LDA(At, 1, 1); PG8_STAGE(PG8_SB(1, 0), b3, voffB); PG8_STAGE(PG8_SB(1, 1), b3 + hstep, voffB); PG8_STAGE(PG8_SA(1, 0), a3, voffA);
            PG8_WAIT_V(8); PG8_WAIT_L(0); PG8_BAR; PG8_MMA(1, 0, At, B0); PG8_MMA(1, 1, At, B1); PG8_BAR; PG8_SCHED;
            } else {
            PG8_LDB(B0, 0, 0); PG8_SCHED; PG8_LDA(At, 0, 0); PG8_STAGE(PG8_SA(1, 1), a1 + hstep, voffA);
            PG8_WAIT_L(8); PG8_BAR; PG8_WAIT_L(0); PG8_MMA(0, 0, At, B0); PG8_BAR; PG8_SCHED;
            PG8_LDB(B1, 0, 1); PG8_STAGE(PG8_SB(0, 0), b2, voffB);
            PG8_BAR; PG8_WAIT_L(0); PG8_MMA(0, 1, At, B1); PG8_BAR;
            PG8_LDA(At, 0, 1); PG8_STAGE(PG8_SA(0, 0), a2, voffA);
            PG8_BAR; PG8_WAIT_L(0); PG8_MMA(1, 0, At, B0); PG8_BAR; PG8_SCHED;
            PG8_STAGE(PG8_SB(0, 1), b2 + hstep, voffB);
            PG8_WAIT_V(6); PG8_BAR; PG8_MMA(1, 1, At, B1); PG8_BAR;
            PG8_LDB(B0, 1, 0); PG8_SCHED; PG8_LDA(At, 1, 0); PG8_STAGE(PG8_SA(0, 1), a2 + hstep, voffA);
            PG8_WAIT_L(8); PG8_BAR; PG8_WAIT_L(0); PG8_MMA(0, 0, At, B0); PG8_BAR; PG8_SCHED;
            PG8_LDB(B1, 1, 1); PG8_STAGE(PG8_SB(1, 0), b3, voffB);
            PG8_BAR; PG8_WAIT_L(0); PG8_MMA(0, 1, At, B1); PG8_BAR;
            PG8_LDA(At, 1, 1); PG8_STAGE(PG8_SA(1, 0), a3, voffA);
            PG8_BAR; PG8_WAIT_L(0); PG8_MMA(1, 0, At, B0); PG8_BAR; PG8_SCHED;
            PG8_STAGE(PG8_SB(1, 1), b3 + hstep, voffB);
            PG8_WAIT_V(6); PG8_BAR; PG8_MMA(1, 1, At, B1); PG8_BAR;
            }
        }
        if constexpr (ALIGN_EPI) { if (wr == 0) PG8_BAR; }
        if constexpr (!Epi::AFTER_DRAIN) { E(acc, cur, wr, wc, fr, fq); S.done(cur); }
        if (!has_next) break;
#pragma unroll
        for (int a = 0; a < 2; ++a)
#pragma unroll
            for (int b = 0; b < 2; ++b)
#pragma unroll
                for (int m = 0; m < 4; ++m)
#pragma unroll
                    for (int n = 0; n < 2; ++n) acc[a][b][m][n] = (f32x4){0.f, 0.f, 0.f, 0.f};
        cur = nxt; cA = nA; cB = nB; ++ui;
        if constexpr (ALIGN_EPI) { if (wr == 1) PG8_BAR; }
    }
    PG8_WAIT_V(0);
    if constexpr (!ALIGN_EPI) { if (wr == 0) PG8_BAR; }
    PG8_BAR;
    if constexpr (Epi::AFTER_DRAIN) { E.fused(acc, cur, wr, wc, fr, fq, lds, wid, lane); S.done(cur); }
#undef PG8_SA
#undef PG8_SB
#undef PG8_STAGE
#undef PG8_LDA
#undef PG8_LDB
#undef PG8_MMA
#undef PG8_WAIT_V
#undef PG8_WAIT_L
#undef PG8_BAR
#undef PG8_SCHED
}
}

#ifndef PG8_SP2
#define PG8_SP2 true
#endif
#ifndef PG8_ALIGN
#define PG8_ALIGN true
#endif
namespace pg8 {
__device__ __forceinline__ float silu_f(float x) { return x * __builtin_amdgcn_rcpf(1.0f + __expf(-x)); }
struct EpiSwiGLU {
    static constexpr bool PERM = true, AFTER_DRAIN = false;
    bf16_t* O; int ldc;
    __device__ __forceinline__ void operator()(const f32x4 (&acc)[2][2][4][2], const Unit& u, int wr, int wc, int fr, int fq) const {
        const int row0 = u.pm * BM + wr * 64 + fr, col0 = u.pn * HALF + wc * 32 + 8 * fq;
#pragma unroll
        for (int ai = 0; ai < 2; ++ai)
#pragma unroll
            for (int m = 0; m < 4; ++m) {
                bf16_t* rowp = O + (size_t)(row0 + ai * HALF + m * 16) * ldc + col0;
                const f32x4 g0 = acc[ai][0][m][0], g1 = acc[ai][0][m][1], u0 = acc[ai][1][m][0], u1 = acc[ai][1][m][1];
                u32x4 w;
                w.x = cvt_pk_bf16(silu_f(g0[0]) * u0[0], silu_f(g0[1]) * u0[1]); w.y = cvt_pk_bf16(silu_f(g0[2]) * u0[2], silu_f(g0[3]) * u0[3]);
                w.z = cvt_pk_bf16(silu_f(g1[0]) * u1[0], silu_f(g1[1]) * u1[1]); w.w = cvt_pk_bf16(silu_f(g1[2]) * u1[2], silu_f(g1[3]) * u1[3]);
                *(u32x4*)rowp = w;
            }
    }
};
struct EpiF32 {
    static constexpr bool PERM = false, AFTER_DRAIN = false;
    float* O; int ldc;
    __device__ __forceinline__ void operator()(const f32x4 (&acc)[2][2][4][2], const Unit& u, int wr, int wc, int fr, int fq) const {
        const int row0 = u.pm * BM + wr * 64 + fr, col0 = u.pn * BM + wc * 32 + 4 * fq;
#pragma unroll
        for (int ai = 0; ai < 2; ++ai)
#pragma unroll
            for (int m = 0; m < 4; ++m) {
                float* rowp = O + (size_t)(row0 + ai * HALF + m * 16) * ldc + col0;
#pragma unroll
                for (int bj = 0; bj < 2; ++bj)
#pragma unroll
                    for (int n = 0; n < 2; ++n) *(f32x4*)(rowp + bj * HALF + n * 16) = acc[ai][bj][m][n];
            }
    }
};
}
#define GAS __attribute__((address_space(1)))
#define LAS __attribute__((address_space(3)))
typedef unsigned short bf16;
typedef unsigned v4u __attribute__((ext_vector_type(4)));
typedef float f32x4 __attribute__((ext_vector_type(4)));
typedef short bf16x8 __attribute__((ext_vector_type(8)));
typedef GAS unsigned gu32;
typedef GAS unsigned long long gu64;
#define RLX_AGENT __ATOMIC_RELAXED, __HIP_MEMORY_SCOPE_AGENT
#define LDS_WAIT() asm volatile("s_waitcnt lgkmcnt(0)" ::: "memory")
#define VM_WAIT() asm volatile("s_waitcnt vmcnt(0)" ::: "memory")
__device__ __forceinline__ unsigned long long rt() { return __builtin_amdgcn_s_memrealtime(); }
__device__ __forceinline__ unsigned f2bf(float f) { unsigned u = __builtin_bit_cast(unsigned, f); return (u + 0x7fffu + ((u >> 16) & 1u)) >> 16; }
__device__ __forceinline__ unsigned pk2(float lo, float hi) { return f2bf(lo) | (f2bf(hi) << 16); }

#define XB_TMO      128
#define XB_XCNT(j)  (256  + 64 * (j))
#define XB_XSUB(j)  (1280 + 64 * (j))
#define XB_XGEN(j)  (2304 + 64 * (j))
#define XB_TOP      3328
#define XB_TOPGEN   3392
#define XCD_BAR_WORDS 3456
#define XB_SPIN_CAP (1u << 18)

__device__ __forceinline__ unsigned xb_ld(unsigned* p)              { return __hip_atomic_load(p, __ATOMIC_RELAXED, __HIP_MEMORY_SCOPE_AGENT); }
__device__ __forceinline__ unsigned xb_add(unsigned* p, unsigned v) { return __hip_atomic_fetch_add(p, v, __ATOMIC_RELAXED, __HIP_MEMORY_SCOPE_AGENT); }
__device__ __forceinline__ unsigned xb_xcc_id() { return (unsigned)__builtin_amdgcn_s_getreg((3 << 11) | 20) & 0xFu; }
#define XB_SPIN(cond, bar) do { unsigned _sp = 0; while (cond) { __builtin_amdgcn_s_sleep(1); \
    if ((++_sp & 255u) == 0u) { if (xb_ld(&(bar)[XB_TMO])) break; if (_sp > XB_SPIN_CAP) { atomicAdd(&(bar)[XB_TMO], 1u); break; } } } } while (0)

struct XcdBarrier {
    unsigned* bar; unsigned x;
    volatile LAS unsigned* st;
};

__device__ __forceinline__ XcdBarrier xcd_barrier_post(unsigned* bar, volatile LAS unsigned* st) {
    XcdBarrier b; b.bar = bar; b.x = xb_xcc_id(); b.st = st;
    if (threadIdx.x == 0) (void)xb_add(&bar[XB_XCNT(b.x)], 1u);
    return b;
}
__device__ __forceinline__ void xcd_barrier_complete(unsigned* bar, unsigned x, unsigned& nloc, unsigned& nx) {
    const unsigned G = gridDim.x * gridDim.y * gridDim.z;
    unsigned sum, cnt, mine, sp = 0u;
    for (;;) {
        sum = 0u; cnt = 0u; mine = 0u;
#pragma unroll
        for (unsigned j = 0; j < 16; ++j) { const unsigned c = xb_ld(&bar[XB_XCNT(j)]); sum += c; cnt += (c > 0u) ? 1u : 0u; mine = (j == x) ? c : mine; }
        if (sum == G) break;
        __builtin_amdgcn_s_sleep(1);
        if ((++sp & 255u) == 0u) { if (xb_ld(&bar[XB_TMO])) break; if (sp > XB_SPIN_CAP) { atomicAdd(&bar[XB_TMO], 1u); break; } }
    }
    nloc = mine > 0u ? mine : 1u; nx = cnt > 0u ? cnt : 1u;
}

__device__ __forceinline__ void xcd_barrier(const XcdBarrier& b) {
    asm volatile("s_waitcnt vmcnt(0)" ::: "memory");
    __syncthreads();
    if (threadIdx.x == 0) {
        unsigned* bar = b.bar;
        __builtin_amdgcn_s_waitcnt(0);
        unsigned nloc = b.st[0], nx = b.st[1];
        if (nloc == 0u) { xcd_barrier_complete(bar, b.x, nloc, nx); b.st[0] = nloc; b.st[1] = nx; }
        const unsigned old = xb_add(&bar[XB_XSUB(b.x)], 1u);
        const unsigned gen = old / nloc;
        if (old + 1u == (gen + 1u) * nloc) {
            __builtin_amdgcn_fence(__ATOMIC_RELEASE, "agent");
            asm volatile("s_waitcnt vmcnt(0)" ::: "memory");
            const unsigned og = xb_add(&bar[XB_TOP], 1u);
            const unsigned tg = og / nx;
            if (og + 1u == (tg + 1u) * nx) xb_add(&bar[XB_TOPGEN], 1u);
            else XB_SPIN(xb_ld(&bar[XB_TOPGEN]) == tg, bar);
            __builtin_amdgcn_fence(__ATOMIC_ACQUIRE, "agent");
            xb_add(&bar[XB_XGEN(b.x)], 1u);
            asm volatile("s_waitcnt vmcnt(0)" ::: "memory");
        } else {
            XB_SPIN(xb_ld(&bar[XB_XGEN(b.x)]) == gen, bar);
            __builtin_amdgcn_fence(__ATOMIC_ACQUIRE, "agent");
            asm volatile("s_waitcnt vmcnt(0)" ::: "memory");
        }
    }
    __syncthreads();
}

constexpr int NWAVES = 8;
constexpr int BATCH = 8, SEQ = 4096, D = 1024, M = BATCH * SEQ;
constexpr int NC_IN = 3592, C_BETA = 2048, C_QB = 2056;
constexpr int NIN = 3584;
constexpr int DFF = 2816, NGU = 2 * DFF;
constexpr float EPS = 1e-6f;
constexpr size_t MiB = 1u << 20;
constexpr size_t WS_CTL = 0, CTL_ZERO_BYTES = 1 * MiB;
constexpr size_t WS_WIN = 1 * MiB, WS_WO = 8 * MiB, WS_WGU = 10 * MiB, WS_WD = 21 * MiB, WS_BG = 27 * MiB;
constexpr size_t WS_XN = 32 * MiB;
constexpr size_t WS_PROJ = 96 * MiB;
constexpr size_t SEG = 32 * MiB;
constexpr size_t WS_ORAW = 96 * MiB;
constexpr size_t WS_Y = 320 * MiB;
constexpr size_t WS_XN2 = 448 * MiB;
constexpr size_t WS_HID = 96 * MiB;
constexpr size_t WS_SO1 = 32 * MiB, WS_SO2 = 64 * MiB, WS_SO3 = 480 * MiB;
constexpr size_t WS_LSE = 28 * MiB;
constexpr size_t WS_MIXO = 224 * MiB;
constexpr size_t WS_GDN = 320 * MiB;
constexpr size_t GDN_BLOB = 73728, GB_W = 0, GB_QD = 16384, GB_KDT = 32768, GB_ATT = 49152, GB_U = 57344, GB_SHARED = 57344;
constexpr size_t WS_GE = 31 * MiB;
constexpr size_t WS_END = 512 * MiB;
constexpr int CW_BAR = 4096;
constexpr int RING_OFF = 0, RING_BYTES = 131072;
constexpr int LDSCTL_OFF = RING_BYTES, MISC_OFF = LDSCTL_OFF + 320;
constexpr int LDS_BYTES = 147456;

__constant__ int c_bkt[3][129] = {
 {0, 1, 2, 3, 4, 5, 6, 7, 8, 9, 10, 11, 12, 13, 14, 15, 16, 16, 16, 16, 16, 16, 17, 17, 17, 17, 17, 17, 17, 17, 18, 18, 18, 18, 18, 18, 18, 18, 18, 18, 19, 19, 19, 19, 19, 19, 19, 19, 19, 19, 19, 19, 19, 19, 20, 20, 20, 20, 20, 20, 20, 20, 20, 20, 20, 20, 20, 20, 20, 20, 20, 20, 20, 21, 21, 21, 21, 21, 21, 21, 21, 21, 21, 21, 21, 21, 21, 21, 21, 21, 21, 21, 21, 21, 21, 21, 21, 21, 21, 22, 22, 22, 22, 22, 22, 22, 22, 22, 22, 22, 22, 22, 22, 22, 22, 22, 22, 22, 22, 22, 22, 22, 22, 22, 22, 22, 22, 22, 22},
 {0, 4, 8, 12, 16, 16, 17, 17, 18, 18, 19, 19, 19, 19, 20, 20, 20, 20, 20, 21, 21, 21, 21, 21, 21, 22, 22, 22, 22, 22, 22, 22, 22, 22, 23, 23, 23, 23, 23, 23, 23, 23, 23, 23, 23, 23, 24, 24, 24, 24, 24, 24, 24, 24, 24, 24, 24, 24, 24, 24, 24, 24, 25, 25, 25, 25, 25, 25, 25, 25, 25, 25, 25, 25, 25, 25, 25, 25, 25, 25, 25, 25, 25, 26, 26, 26, 26, 26, 26, 26, 26, 26, 26, 26, 26, 26, 26, 26, 26, 26, 26, 26, 26, 26, 26, 26, 26, 26, 26, 26, 26, 26, 26, 27, 27, 27, 27, 27, 27, 27, 27, 27, 27, 27, 27, 27, 27, 27, 27},
 {0, 16, 18, 19, 20, 21, 21, 22, 22, 23, 23, 23, 24, 24, 24, 24, 25, 25, 25, 25, 25, 26, 26, 26, 26, 26, 26, 26, 26, 27, 27, 27, 27, 27, 27, 27, 27, 27, 27, 28, 28, 28, 28, 28, 28, 28, 28, 28, 28, 28, 28, 28, 29, 29, 29, 29, 29, 29, 29, 29, 29, 29, 29, 29, 29, 29, 29, 29, 29, 29, 30, 30, 30, 30, 30, 30, 30, 30, 30, 30, 30, 30, 30, 30, 30, 30, 30, 30, 30, 30, 30, 30, 30, 30, 30, 31, 31, 31, 31, 31, 31, 31, 31, 31, 31, 31, 31, 31, 31, 31, 31, 31, 31, 31, 31, 31, 31, 31, 31, 31, 31, 31, 31, 31, 31, 31, 31, 31, 31}};

struct Frame {
    LAS unsigned char* lds;
    volatile LAS unsigned* MISC;
    gu32* ctl;
    int tid, lane, wave, vcu, G;
    unsigned char* ws;
};
struct Args { const float* in[15]; float* out; unsigned char* ws; int ph_lo, ph_hi; };
#define A_x          (A.in[0])
#define A_w_in       (A.in[1])
#define A_conv_w     (A.in[2])
#define A_a_log      (A.in[3])
#define A_dt_bias    (A.in[4])
#define A_onorm_g    (A.in[5])
#define A_rel_bias   (A.in[6])
#define A_w_out      (A.in[7])
#define A_g_mix_pre  (A.in[8])
#define A_g_mix_post (A.in[9])
#define A_w_gate     (A.in[10])
#define A_w_up       (A.in[11])
#define A_w_down     (A.in[12])
#define A_g_ffn_pre  (A.in[13])
#define A_g_ffn_post (A.in[14])
#define W_WIN  ((bf16*)(F.ws + WS_WIN))
#define W_WO   ((bf16*)(F.ws + WS_WO))
#define W_WGU  ((bf16*)(F.ws + WS_WGU))
#define W_WD   ((bf16*)(F.ws + WS_WD))
#define W_BG   ((float*)(F.ws + WS_BG))
#define W_XN   ((bf16*)(F.ws + WS_XN))
#define W_PROJ ((bf16*)(F.ws + WS_PROJ))
#define W_MIXO ((bf16*)(F.ws + WS_MIXO))
#define W_XN2  ((bf16*)(F.ws + WS_XN2))
#define W_HID  ((bf16*)(F.ws + WS_HID))
#define W_ORAW ((float*)(F.ws + WS_ORAW))
#define W_Y    ((float*)(F.ws + WS_Y))
__device__ __forceinline__ float wave_sum(float v) {
#pragma unroll
    for (int o = 1; o < 64; o <<= 1) v += __shfl_xor(v, o);
    return v;
}
__device__ __forceinline__ float bf2f(bf16 b) { return __builtin_bit_cast(float, (unsigned)b << 16); }
__device__ __forceinline__ float siluf(float x) { return x * __builtin_amdgcn_rcpf(1.f + __expf(-x)); }
typedef float f32x2_t __attribute__((ext_vector_type(2))); typedef __bf16 bf16x2_t __attribute__((ext_vector_type(2)));
__device__ __forceinline__ unsigned pkbf(float lo, float hi) { f32x2_t v = {lo, hi}; bf16x2_t b = __builtin_convertvector(v, bf16x2_t); return __builtin_bit_cast(unsigned, b); }

__device__ __forceinline__ void p0_transpose_item(const float* W, int ldw, int col0, int K, bf16* WT, int dst_row0, int k0, LAS float* scr, int lane) {
#pragma unroll 8
    for (int i = 0; i < 32; ++i) { const int kk = 2 * i + (lane >> 5); scr[kk * 33 + (lane & 31)] = W[(size_t)(k0 + kk) * ldw + col0 + (lane & 31)]; }
    LDS_WAIT(); asm volatile("" ::: "memory");
    const int c = lane & 7;
#pragma unroll
    for (int j = 0; j < 4; ++j) { const int n = (lane >> 3) + 8 * j; const LAS float* s = scr + (8 * c) * 33 + n;
        v4u o; o.x = pkbf(s[0 * 33], s[1 * 33]); o.y = pkbf(s[2 * 33], s[3 * 33]); o.z = pkbf(s[4 * 33], s[5 * 33]); o.w = pkbf(s[6 * 33], s[7 * 33]);
        *(GAS v4u*)(WT + (size_t)(dst_row0 + n) * K + k0 + 8 * c) = o; }
    LDS_WAIT(); asm volatile("" ::: "memory");
}

__device__ __forceinline__ void ph_prologue(Frame& F, const Args& A) {
    LAS float* scr = (LAS float*)(F.lds + RING_OFF + F.wave * 16384);
    const int gw = F.vcu * NWAVES + F.wave, NGW = F.G * NWAVES;
    constexpr int I_A = 16 * 64, I_B = 16 * 48, I_O = 16 * 32, I_G = 16 * 88, I_D = 44 * 32;
    constexpr int NITEMS = I_A + I_B + I_O + 2 * I_G + I_D;
    for (int it = gw; it < NITEMS; it += NGW) {
        int r = it;
        if (r < I_A) { const int kb = r / 64, nb = r % 64; p0_transpose_item(A_w_in, NC_IN, 32 * nb, D, W_WIN, 32 * nb, 64 * kb, scr, F.lane); continue; } r -= I_A;
        if (r < I_B) { const int kb = r / 48, nb = r % 48; p0_transpose_item(A_w_in, NC_IN, C_QB + 32 * nb, D, W_WIN, 2048 + 32 * nb, 64 * kb, scr, F.lane); continue; } r -= I_B;
        if (r < I_O) { const int kb = r / 32, nb = r % 32; p0_transpose_item(A_w_out, D, 32 * nb, D, W_WO, 32 * nb, 64 * kb, scr, F.lane); continue; } r -= I_O;
        if (r < I_G) { const int kb = r / 88, nb = r % 88, n0 = 32 * nb; p0_transpose_item(A_w_gate, DFF, n0, D, W_WGU, 256 * (n0 >> 7) + (n0 & 127), 64 * kb, scr, F.lane); continue; } r -= I_G;
        if (r < I_G) { const int kb = r / 88, nb = r % 88, n0 = 32 * nb; p0_transpose_item(A_w_up, DFF, n0, D, W_WGU, 256 * (n0 >> 7) + 128 + (n0 & 127), 64 * kb, scr, F.lane); continue; } r -= I_G;
        { const int kb = r / 32, nb = r % 32; p0_transpose_item(A_w_down, D, 32 * nb, DFF, W_WD, 32 * nb, 64 * kb, scr, F.lane); }
    }
    __syncthreads();
    LAS float* wba = (LAS float*)(F.lds + RING_OFF);
    for (int e = F.tid; e < 8 * D; e += NWAVES * 64) { const int k = e >> 3, c = e & 7; wba[c * D + k] = A_w_in[(size_t)k * NC_IN + C_BETA + c]; }
    __syncthreads();
    for (int m = gw; m < M; m += NGW) {
        const GAS f32x4* xr = (const GAS f32x4*)(A_x + (size_t)m * D) + F.lane;
        const GAS f32x4* gr = (const GAS f32x4*)A_g_mix_pre + F.lane;
        f32x4 v[4]; float s = 0.f;
#pragma unroll
        for (int j = 0; j < 4; ++j) { v[j] = xr[64 * j]; s += (v[j].x * v[j].x + v[j].y * v[j].y) + (v[j].z * v[j].z + v[j].w * v[j].w); }
        const float rstd = rsqrtf(wave_sum(s) * (1.f / D) + EPS);
        GAS unsigned long long* o8 = (GAS unsigned long long*)(W_XN + (size_t)m * D) + F.lane;
        float acc[8];
#pragma unroll
        for (int c = 0; c < 8; ++c) acc[c] = 0.f;
#pragma unroll
        for (int j = 0; j < 4; ++j) {
            const f32x4 g = gr[64 * j]; v[j] = v[j] * rstd * g;
            o8[64 * j] = (unsigned long long)pkbf(v[j].x, v[j].y) | ((unsigned long long)pkbf(v[j].z, v[j].w) << 32);
#pragma unroll
            for (int c = 0; c < 8; ++c) { const f32x4 w = *((const LAS f32x4*)(wba + c * D) + F.lane + 64 * j); acc[c] += (v[j].x * w.x + v[j].y * w.y) + (v[j].z * w.z + v[j].w * w.w); }
        }
#pragma unroll
        for (int c = 0; c < 8; ++c) acc[c] = wave_sum(acc[c]);
        if (F.lane < 4) {
            const int h = F.lane;
            const float bl = h == 0 ? acc[0] : h == 1 ? acc[1] : h == 2 ? acc[2] : acc[3];
            const float al = h == 0 ? acc[4] : h == 1 ? acc[5] : h == 2 ? acc[6] : acc[7];
            const float beta = 1.f / (1.f + expf(-bl));
            const float xx = al + A_dt_bias[h];
            const float sp = fmaxf(xx, 0.f) + log1pf(expf(-fabsf(xx)));
            W_BG[(size_t)m * 8 + h] = beta;
            W_BG[(size_t)m * 8 + 4 + h] = -expf(A_a_log[h]) * sp;
        }
    }
}


typedef short s16x4_t __attribute__((ext_vector_type(4)));
constexpr int GA_QI = 0, GA_KI = 17408, GA_VI = 34816, GA_AM = 52224, GA_TP = 69632, GA_TPP = 78848, GA_WI = 88064, GA_ATI = 105472, GA_TAB = 114688;
constexpr int GA_RS = 272, GA_TS = 144;
__device__ __forceinline__ s16x4_t lds_tr16p(LAS unsigned char* p) { return __builtin_bit_cast(s16x4_t, __builtin_amdgcn_ds_read_tr16_b64_v4i16((LAS s16x4_t*)p)); }
__device__ __forceinline__ unsigned mul_pk(unsigned w, float s0, float s1) {
    return pkbf(__builtin_bit_cast(float, w << 16) * s0, __builtin_bit_cast(float, w & 0xffff0000u) * s1);
}
constexpr int GA_CW = 115712;
constexpr int GA_RAW = 52224, GA_RAWS = 784;
__device__ __forceinline__ void gdn_raw_load(Frame& F, int cu, int tid, v4u (&pre)[7]) {
    const int bh = cu >> 6, c = cu & 63, b = bh >> 2, h = bh & 3;
    const long rowm3 = (long)b * SEQ + (long)c * 64 - 3;
#pragma unroll
    for (int k = 0; k < 7; ++k) {
        const int e = tid + 512 * k, row = e / 48, pc = e % 48, sgm = pc >> 4, c16 = pc & 15;
        pre[k] = (v4u){0u, 0u, 0u, 0u};
        if (e < 67 * 48 && (c * 64 - 3 + row) >= 0)
            pre[k] = *(const GAS v4u*)(W_PROJ + (size_t)sgm * M * 512 + (size_t)(rowm3 + row) * 512 + h * 128 + c16 * 8);
    }
}
__device__ __forceinline__ void gdn_prep_chunk(Frame& F, const Args& A, int cu, int cu_next, v4u (&pre)[7]) {
    const int bh = cu >> 6, c = cu & 63, b = bh >> 2, h = bh & 3;
    const size_t row0 = (size_t)b * SEQ + (size_t)c * 64;
    LAS unsigned char* lds = F.lds + RING_OFF;
    LAS float* tab = (LAS float*)(lds + GA_TAB);
    unsigned char* blob = F.ws + WS_GDN + (size_t)cu * GDN_BLOB;
    int tid = F.tid; asm volatile("" : "+v"(tid));
    const int lane = tid & 63, x = lane & 15, g = lane >> 4;
#pragma unroll
    for (int k = 0; k < 7; ++k) {
        const int e = tid + 512 * k, row = e / 48, pc = e % 48;
        if (e < 67 * 48) *(LAS v4u*)(lds + GA_RAW + row * GA_RAWS + pc * 16) = pre[k];
    }
    __syncthreads();
    if (cu_next < 2048) gdn_raw_load(F, cu_next, tid, pre);
    {
        const int i = tid >> 3, cc = tid & 7;
#pragma unroll
        for (int sgm = 0; sgm < 3; ++sgm) {
            float a[16];
#pragma unroll
            for (int e = 0; e < 16; ++e) a[e] = 0.f;
#pragma unroll
            for (int tap = 0; tap < 4; ++tap) {
                const LAS unsigned char* rp = lds + GA_RAW + (i + tap) * GA_RAWS + sgm * 256 + cc * 32;
                const v4u r0 = *(const LAS v4u*)rp, r1 = *(const LAS v4u*)(rp + 16);
                const LAS f32x4* cw = (const LAS f32x4*)(lds + GA_CW + ((sgm * 4 + tap) * 128 + cc * 16) * 4);
                const f32x4 c0 = cw[0], c1 = cw[1], c2 = cw[2], c3 = cw[3];
                a[0] += c0[0] * __builtin_bit_cast(float, r0.x << 16); a[1] += c0[1] * __builtin_bit_cast(float, r0.x & 0xffff0000u);
                a[2] += c0[2] * __builtin_bit_cast(float, r0.y << 16); a[3] += c0[3] * __builtin_bit_cast(float, r0.y & 0xffff0000u);
                a[4] += c1[0] * __builtin_bit_cast(float, r0.z << 16); a[5] += c1[1] * __builtin_bit_cast(float, r0.z & 0xffff0000u);
                a[6] += c1[2] * __builtin_bit_cast(float, r0.w << 16); a[7] += c1[3] * __builtin_bit_cast(float, r0.w & 0xffff0000u);
                a[8] += c2[0] * __builtin_bit_cast(float, r1.x << 16); a[9] += c2[1] * __builtin_bit_cast(float, r1.x & 0xffff0000u);
                a[10] += c2[2] * __builtin_bit_cast(float, r1.y << 16); a[11] += c2[3] * __builtin_bit_cast(float, r1.y & 0xffff0000u);
                a[12] += c3[0] * __builtin_bit_cast(float, r1.z << 16); a[13] += c3[1] * __builtin_bit_cast(float, r1.z & 0xffff0000u);
                a[14] += c3[2] * __builtin_bit_cast(float, r1.w << 16); a[15] += c3[3] * __builtin_bit_cast(float, r1.w & 0xffff0000u);
            }
            float ss = 0.f;
#pragma unroll
            for (int e = 0; e < 16; ++e) { a[e] = siluf(a[e]); ss += a[e] * a[e]; }
            float scale = 1.f;
            if (sgm < 2) { ss += __shfl_xor(ss, 1); ss += __shfl_xor(ss, 2); ss += __shfl_xor(ss, 4); scale = rsqrtf(ss + 1e-6f) * (sgm == 0 ? 0.08838834764831845f : 1.f); }
            v4u w0, w1;
            w0.x = pkbf(a[0] * scale, a[1] * scale); w0.y = pkbf(a[2] * scale, a[3] * scale); w0.z = pkbf(a[4] * scale, a[5] * scale); w0.w = pkbf(a[6] * scale, a[7] * scale);
            w1.x = pkbf(a[8] * scale, a[9] * scale); w1.y = pkbf(a[10] * scale, a[11] * scale); w1.z = pkbf(a[12] * scale, a[13] * scale); w1.w = pkbf(a[14] * scale, a[15] * scale);
            LAS unsigned char* img = lds + (sgm == 0 ? GA_QI : (sgm == 1 ? GA_KI : GA_VI)) + i * GA_RS + cc * 32;
            *(LAS v4u*)img = w0; *(LAS v4u*)(img + 16) = w1;
        }
        if (F.wave == 0) {
            const float beta = W_BG[(row0 + lane) * 8 + h]; float gcs = W_BG[(row0 + lane) * 8 + 4 + h];
#pragma unroll
            for (int o = 1; o < 64; o <<= 1) { const float up = __shfl_up(gcs, o); if (lane >= o) gcs += up; }
            const float gl = __shfl(gcs, 63);
            tab[lane] = gcs; tab[64 + lane] = __expf(gcs); tab[128 + lane] = __expf(gl - gcs); tab[192 + lane] = beta;
            if (lane == 0) ((float*)(F.ws + WS_GE))[cu] = __expf(gl);
        }
    }
    __syncthreads();
    {
        const int mi = F.wave >> 1;
        bf16x8 ak[4], aq[4];
#pragma unroll
        for (int s4 = 0; s4 < 4; ++s4) {
            ak[s4] = *(const LAS bf16x8*)(lds + GA_KI + (16 * mi + x) * GA_RS + (32 * s4 + 8 * g) * 2);
            aq[s4] = *(const LAS bf16x8*)(lds + GA_QI + (16 * mi + x) * GA_RS + (32 * s4 + 8 * g) * 2);
        }
#pragma unroll
        for (int t2 = 0; t2 < 2; ++t2) {
            const int nj = 2 * (F.wave & 1) + t2;
            f32x4 kk = {0.f, 0.f, 0.f, 0.f}, qk = {0.f, 0.f, 0.f, 0.f};
#pragma unroll
            for (int s4 = 0; s4 < 4; ++s4) {
                const bf16x8 bk = *(const LAS bf16x8*)(lds + GA_KI + (16 * nj + x) * GA_RS + (32 * s4 + 8 * g) * 2);
                kk = __builtin_amdgcn_mfma_f32_16x16x32_bf16(ak[s4], bk, kk, 0, 0, 0);
                qk = __builtin_amdgcn_mfma_f32_16x16x32_bf16(aq[s4], bk, qk, 0, 0, 0);
            }
            const int j = 16 * nj + x; const float gcj = tab[j];
#pragma unroll
            for (int e = 0; e < 4; ++e) {
                const int i = 16 * mi + 4 * g + e;
                const float dec = (i >= j) ? __expf(tab[i] - gcj) : 0.f;
                ((LAS float*)(lds + GA_AM))[j * 68 + (i & 7) * 8 + (i >> 3)] = (i > j) ? tab[192 + i] * kk[e] * dec : 0.f;
                ((LAS bf16*)(lds + GA_ATI))[i * 72 + j] = (bf16)f2bf(qk[e] * dec);
            }
        }
    }
    __syncthreads();
    {
        const int cl = lane >> 3, rg = lane & 7, col = 8 * F.wave + cl;
        const LAS float* am = (const LAS float*)(lds + GA_AM) + rg * 8;
        float t[8];
#pragma unroll
        for (int k = 0; k < 8; ++k) t[k] = (rg + 8 * k == col) ? 1.f : 0.f;
        const int jstart = 8 * F.wave;
#pragma unroll
        for (int j = 0; j < 63; ++j) {
            if (j >= jstart) {
                const float tj = __shfl(t[j >> 3], (lane & 56) | (j & 7));
                const f32x4 a0 = *(const LAS f32x4*)(am + j * 68), a1 = *(const LAS f32x4*)(am + j * 68 + 4);
#pragma unroll
                for (int k = 0; k < 8; ++k) if (8 * k + 7 > j) t[k] -= (k < 4 ? a0[k & 3] : a1[k & 3]) * tj;
            }
        }
        const float bc = tab[192 + col], bec = bc * tab[64 + col];
#pragma unroll
        for (int k = 0; k < 8; ++k) {
            ((LAS bf16*)(lds + GA_TP))[(rg + 8 * k) * 72 + col] = (bf16)f2bf(t[k] * bc);
            ((LAS bf16*)(lds + GA_TPP))[(rg + 8 * k) * 72 + col] = (bf16)f2bf(t[k] * bec);
        }
        for (int f = F.wave; f < 40; f += 8) {
            if (f < 16) {
                const int s4 = f & 3, i = 16 * (f >> 2) + x; const float sc = tab[64 + i];
                const LAS unsigned char* rp = lds + GA_QI + i * GA_RS + (32 * s4 + 4 * g) * 2;
                const unsigned long long lo = *(const LAS unsigned long long*)rp, hi = *(const LAS unsigned long long*)(rp + 32);
                v4u w; w.x = mul_pk((unsigned)lo, sc, sc); w.y = mul_pk((unsigned)(lo >> 32), sc, sc); w.z = mul_pk((unsigned)hi, sc, sc); w.w = mul_pk((unsigned)(hi >> 32), sc, sc);
                *(GAS v4u*)(blob + GB_QD + (size_t)(f * 64 + lane) * 16) = w;
            } else if (f < 32) {
                const int ff = f - 16, m = ff >> 1, s2 = ff & 1;
                const int r0 = 32 * s2 + 4 * g;
                LAS unsigned char* ap = lds + GA_KI + (r0 + (x >> 2)) * GA_RS + (16 * m + 4 * (x & 3)) * 2;
                const s16x4_t lo = lds_tr16p(ap), hi = lds_tr16p(ap + 16 * GA_RS);
                const f32x4 s_lo = *(const LAS f32x4*)(tab + 128 + r0), s_hi = *(const LAS f32x4*)(tab + 128 + r0 + 16);
                v4u w;
                w.x = pkbf(bf2f((bf16)lo[0]) * s_lo[0], bf2f((bf16)lo[1]) * s_lo[1]); w.y = pkbf(bf2f((bf16)lo[2]) * s_lo[2], bf2f((bf16)lo[3]) * s_lo[3]);
                w.z = pkbf(bf2f((bf16)hi[0]) * s_hi[0], bf2f((bf16)hi[1]) * s_hi[1]); w.w = pkbf(bf2f((bf16)hi[2]) * s_hi[2], bf2f((bf16)hi[3]) * s_hi[3]);
                *(GAS v4u*)(blob + GB_KDT + (size_t)(ff * 64 + lane) * 16) = w;
            } else {
                const int ff = f - 32, s2 = ff & 1, i = 16 * (ff >> 1) + x;
                const LAS unsigned char* rp = lds + GA_ATI + i * GA_TS + (32 * s2 + 4 * g) * 2;
                const unsigned long long lo = *(const LAS unsigned long long*)rp, hi = *(const LAS unsigned long long*)(rp + 32);
                v4u w; w.x = (unsigned)lo; w.y = (unsigned)(lo >> 32); w.z = (unsigned)hi; w.w = (unsigned)(hi >> 32);
                *(GAS v4u*)(blob + GB_ATT + (size_t)(ff * 64 + lane) * 16) = w;
            }
        }
    }
    __syncthreads();
    {
        const int n = F.wave;
#pragma unroll
        for (int which = 0; which < 2; ++which) {
            const int timg = which == 0 ? GA_TP : GA_TPP, bimg = which == 0 ? GA_VI : GA_KI;
            bf16x8 bfr[2];
#pragma unroll
            for (int s2 = 0; s2 < 2; ++s2) {
                LAS unsigned char* ap = lds + bimg + (32 * s2 + 8 * g + (x >> 2)) * GA_RS + (16 * n + 4 * (x & 3)) * 2;
                const s16x4_t lo = lds_tr16p(ap), hi = lds_tr16p(ap + 4 * GA_RS);
                bfr[s2] = (bf16x8){lo[0], lo[1], lo[2], lo[3], hi[0], hi[1], hi[2], hi[3]};
            }
#pragma unroll
            for (int m = 0; m < 4; ++m) {
                f32x4 acc = {0.f, 0.f, 0.f, 0.f};
#pragma unroll
                for (int s2 = 0; s2 < 2; ++s2) {
                    const bf16x8 af = *(const LAS bf16x8*)(lds + timg + (16 * m + x) * GA_TS + (32 * s2 + 8 * g) * 2);
                    acc = __builtin_amdgcn_mfma_f32_16x16x32_bf16(af, bfr[s2], acc, 0, 0, 0);
                }
                if (which == 0) {
                    const unsigned long long w = (unsigned long long)pkbf(acc[0], acc[1]) | ((unsigned long long)pkbf(acc[2], acc[3]) << 32);
                    *(GAS unsigned long long*)(blob + GB_U + (size_t)((n * 4 + m) * 64 + lane) * 8) = w;
                } else {
#pragma unroll
                    for (int e = 0; e < 4; ++e) ((LAS bf16*)(lds + GA_WI))[(16 * m + 4 * g + e) * 136 + 16 * n + x] = (bf16)f2bf(acc[e]);
                }
            }
        }
    }
    __syncthreads();
#pragma unroll
    for (int q2 = 0; q2 < 2; ++q2) {
        const int f = F.wave * 2 + q2, s4 = f & 3, i = 16 * (f >> 2) + x;
        const LAS unsigned char* rp = lds + GA_WI + i * GA_RS + (32 * s4 + 4 * g) * 2;
        const unsigned long long lo = *(const LAS unsigned long long*)rp, hi = *(const LAS unsigned long long*)(rp + 32);
        v4u w; w.x = (unsigned)lo; w.y = (unsigned)(lo >> 32); w.z = (unsigned)hi; w.w = (unsigned)(hi >> 32);
        *(GAS v4u*)(blob + GB_W + (size_t)(f * 64 + lane) * 16) = w;
    }
}
__device__ __forceinline__ void ph_gdn_prep(Frame& F, const Args& A) {
    int hl = -1; v4u pre[7];
    int cu = (int)blockIdx.x;
    if (cu < 2048) gdn_raw_load(F, cu, F.tid, pre);
    for (; cu < 2048; cu += F.G) {
        const int h = (cu >> 6) & 3;
        if (h != hl) {
            for (int e = F.tid; e < 1536; e += NWAVES * 64) { const int sgm = e >> 9, tap = (e >> 7) & 3, ch = e & 127; ((LAS float*)(F.lds + RING_OFF + GA_CW))[e] = A_conv_w[tap * 1536 + sgm * 512 + h * 128 + ch]; }
            hl = h;
        }
        gdn_prep_chunk(F, A, cu, cu + F.G, pre);
        __syncthreads();
    }
}
__device__ __forceinline__ void ph_gdn_scan(Frame& F, const Args& A, int bh) {
    const int b = bh >> 2, h = bh & 3, lane = F.lane, x = lane & 15, g = lane >> 4, n = F.wave;
    LAS unsigned char* lds = F.lds + RING_OFF;
    const unsigned char* blob0 = F.ws + WS_GDN + (size_t)(bh * 64) * GDN_BLOB;
    const float* GE = (const float*)(F.ws + WS_GE) + bh * 64;
    f32x4 Sacc[8];
#pragma unroll
    for (int t = 0; t < 8; ++t) Sacc[t] = (f32x4){0.f, 0.f, 0.f, 0.f};
    v4u stA[7], stB[7]; unsigned long long uA[4], uB[4], uc[4]; float geA, geB, ge;
#define SCAN_LOAD(ST, UU, GG, cc) do { const unsigned char* bl_ = blob0 + (size_t)(cc) * GDN_BLOB; \
        _Pragma("unroll") for (int i = 0; i < 7; ++i) ST[i] = *(const GAS v4u*)(bl_ + (size_t)(n * 7 + i) * 1024 + lane * 16); \
        _Pragma("unroll") for (int m = 0; m < 4; ++m) UU[m] = *(const GAS unsigned long long*)(bl_ + GB_U + (size_t)((n * 4 + m) * 64 + lane) * 8); \
        GG = GE[cc]; } while (0)
#define SCAN_STORE(ST, buf) do { _Pragma("unroll") for (int i = 0; i < 7; ++i) *(LAS v4u*)((buf) + (n * 7 + i) * 1024 + lane * 16) = ST[i]; } while (0)
    SCAN_LOAD(stA, uA, geA, 0);
    SCAN_LOAD(stB, uB, geB, 1);
    SCAN_STORE(stA, lds);
#pragma unroll
    for (int m = 0; m < 4; ++m) uc[m] = uA[m];
    ge = geA;
    __syncthreads();
#define SCAN_STEP(c, ST_N, U_N, GE_N, ST_L, U_L, GE_L) do { \
        LAS unsigned char* cur = lds + ((c) & 1) * GB_SHARED; LAS unsigned char* nxt = lds + (((c) + 1) & 1) * GB_SHARED; \
        if ((c) + 2 < 64) SCAN_LOAD(ST_L, U_L, GE_L, (c) + 2); \
        bf16x8 Sb[4]; \
        _Pragma("unroll") for (int s4 = 0; s4 < 4; ++s4) { v4u w; w.x = pkbf(Sacc[2 * s4][0], Sacc[2 * s4][1]); w.y = pkbf(Sacc[2 * s4][2], Sacc[2 * s4][3]); w.z = pkbf(Sacc[2 * s4 + 1][0], Sacc[2 * s4 + 1][1]); w.w = pkbf(Sacc[2 * s4 + 1][2], Sacc[2 * s4 + 1][3]); Sb[s4] = __builtin_bit_cast(bf16x8, w); } \
        f32x4 vn[4], o[4]; \
        _Pragma("unroll") for (int m = 0; m < 4; ++m) { \
            f32x4 ws = {0.f, 0.f, 0.f, 0.f}, qs = {0.f, 0.f, 0.f, 0.f}; \
            _Pragma("unroll") for (int s4 = 0; s4 < 4; ++s4) { \
                const bf16x8 wf = *(const LAS bf16x8*)(cur + GB_W + ((m * 4 + s4) * 64 + lane) * 16); \
                const bf16x8 qf = *(const LAS bf16x8*)(cur + GB_QD + ((m * 4 + s4) * 64 + lane) * 16); \
                ws = __builtin_amdgcn_mfma_f32_16x16x32_bf16(wf, Sb[s4], ws, 0, 0, 0); \
                qs = __builtin_amdgcn_mfma_f32_16x16x32_bf16(qf, Sb[s4], qs, 0, 0, 0); } \
            const unsigned ulo = (unsigned)uc[m], uhi = (unsigned)(uc[m] >> 32); \
            vn[m][0] = __builtin_bit_cast(float, ulo << 16) - ws[0]; vn[m][1] = __builtin_bit_cast(float, ulo & 0xffff0000u) - ws[1]; \
            vn[m][2] = __builtin_bit_cast(float, uhi << 16) - ws[2]; vn[m][3] = __builtin_bit_cast(float, uhi & 0xffff0000u) - ws[3]; \
            o[m] = qs; } \
        bf16x8 Vb[2]; \
        _Pragma("unroll") for (int s2 = 0; s2 < 2; ++s2) { v4u w; w.x = pkbf(vn[2 * s2][0], vn[2 * s2][1]); w.y = pkbf(vn[2 * s2][2], vn[2 * s2][3]); w.z = pkbf(vn[2 * s2 + 1][0], vn[2 * s2 + 1][1]); w.w = pkbf(vn[2 * s2 + 1][2], vn[2 * s2 + 1][3]); Vb[s2] = __builtin_bit_cast(bf16x8, w); } \
        const size_t orow = (size_t)b * SEQ + (size_t)(c) * 64; \
        _Pragma("unroll") for (int m = 0; m < 4; ++m) { \
            _Pragma("unroll") for (int s2 = 0; s2 < 2; ++s2) { const bf16x8 af = *(const LAS bf16x8*)(cur + GB_ATT + ((m * 2 + s2) * 64 + lane) * 16); o[m] = __builtin_amdgcn_mfma_f32_16x16x32_bf16(af, Vb[s2], o[m], 0, 0, 0); } \
            _Pragma("unroll") for (int e = 0; e < 4; ++e) W_ORAW[(orow + 16 * m + 4 * g + e) * 512 + h * 128 + 16 * n + x] = o[m][e]; } \
        _Pragma("unroll") for (int t = 0; t < 8; ++t) { \
            f32x4 acc = Sacc[t] * ge; \
            _Pragma("unroll") for (int s2 = 0; s2 < 2; ++s2) { const bf16x8 kf = *(const LAS bf16x8*)(cur + GB_KDT + ((t * 2 + s2) * 64 + lane) * 16); acc = __builtin_amdgcn_mfma_f32_16x16x32_bf16(kf, Vb[s2], acc, 0, 0, 0); } \
            Sacc[t] = acc; } \
        if ((c) + 1 < 64) { SCAN_STORE(ST_N, nxt); _Pragma("unroll") for (int m = 0; m < 4; ++m) uc[m] = U_N[m]; ge = GE_N; } \
        __syncthreads(); } while (0)
    for (int c = 0; c < 64; c += 2) {
        SCAN_STEP(c, stB, uB, geB, stA, uA, geA);
        SCAN_STEP(c + 1, stA, uA, geA, stB, uB, geB);
    }
#undef SCAN_LOAD
#undef SCAN_STORE
#undef SCAN_STEP
}

__device__ __forceinline__ void ph_gdn_out(Frame& F, const Args& A) {
    const int gw = F.vcu * NWAVES + F.wave, NGW = F.G * NWAVES, lane = F.lane;
    const bf16* GA = W_PROJ + (size_t)3 * M * 512;
    const f32x4 og0 = *(const GAS f32x4*)(A_onorm_g + (lane & 15) * 8), og1 = *(const GAS f32x4*)(A_onorm_g + (lane & 15) * 8 + 4);
    constexpr int ROWS = 4;
    for (int m0 = gw * ROWS; m0 < M; m0 += NGW * ROWS) {
        f32x4 a[ROWS], b[ROWS]; v4u gt[ROWS];
#pragma unroll
        for (int r = 0; r < ROWS; ++r) {
            const size_t o = (size_t)(m0 + r) * 512 + lane * 8;
            a[r] = *(const GAS f32x4*)(W_ORAW + o); b[r] = *(const GAS f32x4*)(W_ORAW + o + 4); gt[r] = *(const GAS v4u*)(GA + o);
        }
#pragma unroll
        for (int r = 0; r < ROWS; ++r) {
            float ss = (a[r][0] * a[r][0] + a[r][1] * a[r][1]) + (a[r][2] * a[r][2] + a[r][3] * a[r][3]) + (b[r][0] * b[r][0] + b[r][1] * b[r][1]) + (b[r][2] * b[r][2] + b[r][3] * b[r][3]);
            ss += __shfl_xor(ss, 1); ss += __shfl_xor(ss, 2); ss += __shfl_xor(ss, 4); ss += __shfl_xor(ss, 8);
            const float rs = rsqrtf(ss * (1.f / 128.f) + EPS);
            const unsigned gw_[4] = {gt[r].x, gt[r].y, gt[r].z, gt[r].w};
            float v[8];
#pragma unroll
            for (int e = 0; e < 4; ++e) {
                v[e] = a[r][e] * rs * og0[e]; v[4 + e] = b[r][e] * rs * og1[e];
            }
#pragma unroll
            for (int e = 0; e < 4; ++e) {
                v[2 * e] *= siluf(__builtin_bit_cast(float, gw_[e] << 16)); v[2 * e + 1] *= siluf(__builtin_bit_cast(float, gw_[e] & 0xffff0000u));
            }
            v4u w; w.x = pkbf(v[0], v[1]); w.y = pkbf(v[2], v[3]); w.z = pkbf(v[4], v[5]); w.w = pkbf(v[6], v[7]);
            *(GAS v4u*)(W_MIXO + (size_t)(m0 + r) * D + lane * 8) = w;
        }
    }
}
typedef short s16x4 __attribute__((ext_vector_type(4)));
constexpr int SWA_TASKS = 64 * 48;
constexpr int SWA_KOFF = 0, SWA_VOFF = 49152, SWA_TB = 98304;
__device__ __forceinline__ s16x4 lds_tr16(unsigned addr) { return __builtin_bit_cast(s16x4, __builtin_amdgcn_ds_read_tr16_b64_v4i16((LAS s16x4*)(uintptr_t)addr)); }
__device__ __forceinline__ void swa_task(Frame& F, const Args& A, int tk) {
    const int bh = tk / 48, rem = tk % 48, p = rem >> 4, idx = rem & 15;
    const int b = bh >> 3, h = bh & 7;
    const int dil = p == 0 ? 1 : (p == 1 ? 4 : 16), nblk = 16 / dil, r = idx / nblk, m0 = 256 * (idx % nblk);
    const bf16* QB = W_PROJ + (size_t)4 * M * 512; const bf16* KB = W_PROJ + (size_t)5 * M * 512; const bf16* VB = W_PROJ + (size_t)6 * M * 512;
    bf16* OP = (bf16*)(F.ws + (p == 0 ? WS_SO1 : (p == 1 ? WS_SO2 : WS_SO3)));
    float* LSE = (float*)(F.ws + WS_LSE) + (size_t)p * M * 8;
    const size_t rowb = (size_t)b * SEQ;
    LAS unsigned char* lds = F.lds + RING_OFF;
    {
        v4u tmp[12];
#pragma unroll
        for (int i = 0; i < 12; ++i) {
            const int e = F.tid + 512 * i, which = e / 3072, rm = e % 3072, row = rm >> 3, c = rm & 7;
            int sp = m0 - 128 + row; sp = sp < 0 ? 0 : sp;
            const bf16* src = (which ? VB : KB) + (rowb + (size_t)sp * dil + r) * 512 + h * 64 + c * 8;
            tmp[i] = *(const GAS v4u*)src;
        }
#pragma unroll
        for (int i = 0; i < 12; ++i) {
            const int e = F.tid + 512 * i, which = e / 3072, rm = e % 3072, row = rm >> 3, c = rm & 7;
            *(LAS v4u*)(lds + which * SWA_VOFF + row * 128 + ((c ^ (row & 7)) << 4)) = tmp[i];
        }
        if (F.tid < 129) ((LAS float*)(lds + SWA_TB))[F.tid] = A_rel_bias[c_bkt[p][F.tid] * 8 + h];
    }
    __syncthreads();
    const int lane = F.lane, q = lane & 15, g = lane >> 4;
    const LAS float* tb = (const LAS float*)(lds + SWA_TB);
#pragma unroll 1
    for (int qi = 0; qi < 2; ++qi) {
        const int qt = F.wave * 2 + qi;
        const size_t qtok = rowb + (size_t)(m0 + 16 * qt + q) * dil + r;
        const bf16x8 qf0 = *(const GAS bf16x8*)(QB + qtok * 512 + h * 64 + 8 * g);
        const bf16x8 qf1 = *(const GAS bf16x8*)(QB + qtok * 512 + h * 64 + 32 + 8 * g);
        float sc[9][4];
        float mx = -INFINITY;
#pragma unroll
        for (int jt = 0; jt < 9; ++jt) {
            const int kt = qt + jt, krow = 16 * kt + q;
            const bf16x8 kf0 = *(const LAS bf16x8*)(lds + SWA_KOFF + krow * 128 + (((g) ^ (krow & 7)) << 4));
            const bf16x8 kf1 = *(const LAS bf16x8*)(lds + SWA_KOFF + krow * 128 + (((g + 4) ^ (krow & 7)) << 4));
            f32x4 acc = {0.f, 0.f, 0.f, 0.f};
            acc = __builtin_amdgcn_mfma_f32_16x16x32_bf16(kf0, qf0, acc, 0, 0, 0);
            acc = __builtin_amdgcn_mfma_f32_16x16x32_bf16(kf1, qf1, acc, 0, 0, 0);
#pragma unroll
            for (int e = 0; e < 4; ++e) {
                const int kx = 4 * g + e, rel = 128 - 16 * jt + q - kx, spk = m0 - 128 + 16 * kt + kx;
                const bool valid = (rel >= 0) && (rel <= 128) && (spk >= 0);
                const int relc = rel < 0 ? 0 : (rel > 128 ? 128 : rel);
                const float v = acc[e] * 0.125f + tb[relc];
                sc[jt][e] = valid ? v : -INFINITY;
                mx = fmaxf(mx, sc[jt][e]);
            }
        }
        mx = fmaxf(mx, __shfl_xor(mx, 16)); mx = fmaxf(mx, __shfl_xor(mx, 32));
        float l = 0.f;
#pragma unroll
        for (int jt = 0; jt < 9; ++jt)
#pragma unroll
            for (int e = 0; e < 4; ++e) { sc[jt][e] = __expf(sc[jt][e] - mx); l += sc[jt][e]; }
        l += __shfl_xor(l, 16); l += __shfl_xor(l, 32);
        bf16x8 pf[5];
#pragma unroll
        for (int s2 = 0; s2 < 5; ++s2) {
            v4u w;
            w.x = pkbf(sc[2 * s2][0], sc[2 * s2][1]); w.y = pkbf(sc[2 * s2][2], sc[2 * s2][3]);
            if (s2 < 4) { w.z = pkbf(sc[2 * s2 + 1][0], sc[2 * s2 + 1][1]); w.w = pkbf(sc[2 * s2 + 1][2], sc[2 * s2 + 1][3]); } else { w.z = 0u; w.w = 0u; }
            pf[s2] = __builtin_bit_cast(bf16x8, w);
        }
        const float rl = 1.0f / l;
        const unsigned vbase = (unsigned)(uintptr_t)(lds + SWA_VOFF);
#pragma unroll
        for (int mt = 0; mt < 4; ++mt) {
            f32x4 o = {0.f, 0.f, 0.f, 0.f};
#pragma unroll
            for (int s2 = 0; s2 < 5; ++s2) {
                const int row0 = 16 * (qt + 2 * s2) + 4 * g + (q >> 2), c = 2 * mt + ((q & 3) >> 1);
                const s16x4 lo = lds_tr16(vbase + row0 * 128 + ((c ^ (row0 & 7)) << 4) + 8 * (q & 1));
                s16x4 hi = {0, 0, 0, 0};
                if (s2 < 4) { const int row1 = row0 + 16; hi = lds_tr16(vbase + row1 * 128 + ((c ^ (row1 & 7)) << 4) + 8 * (q & 1)); }
                const bf16x8 vf = {lo[0], lo[1], lo[2], lo[3], hi[0], hi[1], hi[2], hi[3]};
                o = __builtin_amdgcn_mfma_f32_16x16x32_bf16(vf, pf[s2], o, 0, 0, 0);
            }
            unsigned long long w = (unsigned long long)pkbf(o[0] * rl, o[1] * rl) | ((unsigned long long)pkbf(o[2] * rl, o[3] * rl) << 32);
            *(GAS unsigned long long*)(OP + qtok * 512 + h * 64 + 16 * mt + 4 * g) = w;
        }
        if (g == 0) LSE[qtok * 8 + h] = mx + __logf(l);
    }
    __syncthreads();
}
__device__ __forceinline__ void ph_swa(Frame& F, const Args& A, int widx, int nw) {
    const int lo = (int)(((long)widx * SWA_TASKS) / nw), hi = (int)(((long)(widx + 1) * SWA_TASKS) / nw);
    for (int tk = lo; tk < hi; ++tk) swa_task(F, A, tk);
}
__device__ __forceinline__ void ph_swa_merge(Frame& F) {
    const int gw = F.vcu * NWAVES + F.wave, NGW = F.G * NWAVES, lane = F.lane, h = lane >> 3;
    const float* LSE = (const float*)(F.ws + WS_LSE);
    const bf16* O1 = (const bf16*)(F.ws + WS_SO1); const bf16* O2 = (const bf16*)(F.ws + WS_SO2); const bf16* O3 = (const bf16*)(F.ws + WS_SO3);
    constexpr int ROWS = 4;
    for (int m0 = gw * ROWS; m0 < M; m0 += NGW * ROWS) {
        v4u o1[ROWS], o2[ROWS], o3[ROWS]; float l1[ROWS], l2[ROWS], l3[ROWS];
#pragma unroll
        for (int r = 0; r < ROWS; ++r) {
            const size_t o = (size_t)(m0 + r) * 512 + lane * 8, lo = (size_t)(m0 + r) * 8 + h;
            o1[r] = *(const GAS v4u*)(O1 + o); o2[r] = *(const GAS v4u*)(O2 + o); o3[r] = *(const GAS v4u*)(O3 + o);
            l1[r] = LSE[lo]; l2[r] = LSE[(size_t)M * 8 + lo]; l3[r] = LSE[(size_t)2 * M * 8 + lo];
        }
#pragma unroll
        for (int r = 0; r < ROWS; ++r) {
            const float mx = fmaxf(l1[r], fmaxf(l2[r], l3[r]));
            float w1 = __expf(l1[r] - mx), w2 = __expf(l2[r] - mx), w3 = __expf(l3[r] - mx);
            const float inv = __builtin_amdgcn_rcpf(w1 + w2 + w3); w1 *= inv; w2 *= inv; w3 *= inv;
            const unsigned a1[4] = {o1[r].x, o1[r].y, o1[r].z, o1[r].w}, a2[4] = {o2[r].x, o2[r].y, o2[r].z, o2[r].w}, a3[4] = {o3[r].x, o3[r].y, o3[r].z, o3[r].w};
            unsigned wv[4];
#pragma unroll
            for (int e = 0; e < 4; ++e) {
                const float lo = w1 * __builtin_bit_cast(float, a1[e] << 16) + w2 * __builtin_bit_cast(float, a2[e] << 16) + w3 * __builtin_bit_cast(float, a3[e] << 16);
                const float hi = w1 * __builtin_bit_cast(float, a1[e] & 0xffff0000u) + w2 * __builtin_bit_cast(float, a2[e] & 0xffff0000u) + w3 * __builtin_bit_cast(float, a3[e] & 0xffff0000u);
                wv[e] = pkbf(lo, hi);
            }
            *(GAS v4u*)(W_MIXO + (size_t)(m0 + r) * D + 512 + lane * 8) = (v4u){wv[0], wv[1], wv[2], wv[3]};
        }
    }
}
__device__ __forceinline__ void ph_norm_res(Frame& F, const float* y, const float* g1, const float* base, float* out, const float* g2, bf16* hn) {
    const int gw = F.vcu * NWAVES + F.wave, NGW = F.G * NWAVES;
    for (int m = gw; m < M; m += NGW) {
        const GAS f32x4* yr = (const GAS f32x4*)(y + (size_t)m * D) + F.lane;
        const GAS f32x4* br = (const GAS f32x4*)(base + (size_t)m * D) + F.lane;
        GAS f32x4* orow = (GAS f32x4*)(out + (size_t)m * D) + F.lane;
        f32x4 v[4]; float s = 0.f;
#pragma unroll
        for (int j = 0; j < 4; ++j) { v[j] = yr[64 * j]; s += (v[j].x * v[j].x + v[j].y * v[j].y) + (v[j].z * v[j].z + v[j].w * v[j].w); }
        const float r = rsqrtf(wave_sum(s) * (1.f / D) + EPS);
        float s2 = 0.f;
#pragma unroll
        for (int j = 0; j < 4; ++j) { const f32x4 g = ((const GAS f32x4*)g1)[F.lane + 64 * j]; v[j] = br[64 * j] + v[j] * r * g; orow[64 * j] = v[j];
            s2 += (v[j].x * v[j].x + v[j].y * v[j].y) + (v[j].z * v[j].z + v[j].w * v[j].w); }
        if (hn) {
            const float r2 = rsqrtf(wave_sum(s2) * (1.f / D) + EPS);
            GAS unsigned long long* o8 = (GAS unsigned long long*)(hn + (size_t)m * D) + F.lane;
#pragma unroll
            for (int j = 0; j < 4; ++j) { const f32x4 g = ((const GAS f32x4*)g2)[F.lane + 64 * j]; const f32x4 w = v[j] * r2 * g;
                o8[64 * j] = (unsigned long long)pkbf(w.x, w.y) | ((unsigned long long)pkbf(w.z, w.w) << 32); }
        }
    }
}

constexpr int N_PHASES = 10;
#ifndef MK_PER_PHASE
#define MK_PER_PHASE 0
#endif
__global__ void __launch_bounds__(NWAVES * 64, 2) mk_fwd(Args args) {
    extern __shared__ __attribute__((aligned(16))) unsigned char lds[];
    Frame F;
    F.lds = (LAS unsigned char*)lds;
    F.MISC = (volatile LAS unsigned*)(F.lds + MISC_OFF);
    F.tid = threadIdx.x; F.lane = F.tid & 63; F.wave = __builtin_amdgcn_readfirstlane(F.tid >> 6);
    F.G = gridDim.x; { const int bx = blockIdx.x; F.vcu = (F.G % 8 == 0) ? (bx % 8) * (F.G / 8) + bx / 8 : bx; }
    unsigned char* ws = args.ws;
    F.ctl = (gu32*)(ws + WS_CTL);
    F.ws = ws; const Args& A = args;
    for (int u = F.tid; u < (LDS_BYTES - LDSCTL_OFF) / 4; u += NWAVES * 64) ((LAS unsigned*)(F.lds + LDSCTL_OFF))[u] = 0u;
    __syncthreads();
    XcdBarrier bar; bar.bar = (unsigned*)(F.ctl + CW_BAR); bar.x = 0; bar.st = nullptr;
    if (!MK_PER_PHASE) bar = xcd_barrier_post((unsigned*)(F.ctl + CW_BAR), F.MISC + 8);
    const int lo = args.ph_lo, hi = args.ph_hi;
#ifndef PHMASK
#define PHMASK 0xFFFF
#endif
#define IN(k) (((PHMASK >> (k)) & 1) && lo <= (k) && (k) < hi)
#define SEAM(k) do { if (IN(k) && IN((k) + 1)) xcd_barrier(bar); } while (0)
#ifndef REPMASK
#define REPMASK 0
#endif
#define REP(k) for (int rep_ = 0; rep_ < 1 + ((REPMASK >> (k)) & 1); ++rep_, (rep_ < 1 + ((REPMASK >> (k)) & 1)) ? xcd_barrier(bar) : (void)0)

    if (IN(0)) REP(0) { ph_prologue(F, args); } SEAM(0);
    if (IN(1)) REP(1) {
        pg8::Gemm g{W_XN, W_WIN, M, NIN, D}; pg8::StaticOrder S; S.init(M, NIN, F.G, (int)blockIdx.x);
        pg8::EpiBf16<0> E{W_PROJ, 512, nullptr, 512, (size_t)M * 512, 1.f};
        pg8::gemm_phase<pg8::EpiBf16<0>, pg8::StaticOrder, true, true>(F.lds + RING_OFF, g, S, E);
    } SEAM(1);
    if (IN(2)) REP(2) { ph_gdn_prep(F, args); } SEAM(2);
    if (IN(3)) REP(3) {
        if (blockIdx.x < 32) ph_gdn_scan(F, args, (int)blockIdx.x);
        else ph_swa(F, args, (int)blockIdx.x - 32, F.G - 32);
    } SEAM(3);
    if (IN(4)) REP(4) { ph_gdn_out(F, args); ph_swa_merge(F); } SEAM(4);
    if (IN(5)) REP(5) {
        pg8::Gemm g{W_MIXO, W_WO, M, D, D}; pg8::StaticOrder S; S.init(M, D, F.G, (int)blockIdx.x);
        pg8::EpiF32 E{W_Y, D};
        pg8::gemm_phase<pg8::EpiF32, pg8::StaticOrder, true, true>(F.lds + RING_OFF, g, S, E);
    } SEAM(5);
    if (IN(6)) REP(6) { ph_norm_res(F, W_Y, A_g_mix_post, A_x, A.out, A_g_ffn_pre, W_XN2); } SEAM(6);
    if (IN(7)) REP(7) {
        pg8::Gemm g{W_XN2, W_WGU, M, NGU, D}; pg8::StaticOrder S; S.init(M, NGU, F.G, (int)blockIdx.x);
        pg8::EpiSwiGLU E{W_HID, DFF};
        pg8::gemm_phase<pg8::EpiSwiGLU, pg8::StaticOrder, true, true>(F.lds + RING_OFF, g, S, E);
    } SEAM(7);
    if (IN(8)) REP(8) {
        pg8::Gemm g{W_HID, W_WD, M, D, DFF}; pg8::StaticOrder S; S.init(M, D, F.G, (int)blockIdx.x);
        pg8::EpiF32 E{W_Y, D};
        pg8::gemm_phase<pg8::EpiF32, pg8::StaticOrder, true, true>(F.lds + RING_OFF, g, S, E);
    } SEAM(8);
    if (IN(9)) REP(9) { ph_norm_res(F, W_Y, A_g_ffn_post, A.out, A.out, nullptr, nullptr); }
#undef IN
#undef SEAM
}

extern "C" void kernel_launch(void* const* d_in, const int* in_sizes, int n_in, void* d_out, int out_size, void* d_ws, size_t ws_size, hipStream_t stream) {
    static int grid = 0;
    if (grid == 0) {
        if (n_in != 15 || in_sizes[0] != M * D || out_size != M * D || ws_size < WS_END) {
            fprintf(stderr, "kernel_launch: unexpected shapes/workspace: n_in %d in0 %d out %d ws %zu (need %zu); nothing launched\n", n_in, n_in > 0 ? in_sizes[0] : -1, out_size, ws_size, (size_t)WS_END); grid = -1; return; }
        int dev = 0, cus = 0, per_cu = 0;
        if (hipGetDevice(&dev) != hipSuccess || hipDeviceGetAttribute(&cus, hipDeviceAttributeMultiprocessorCount, dev) != hipSuccess) { fprintf(stderr, "kernel_launch: device query failed\n"); grid = -1; return; }
        if (hipFuncSetAttribute((const void*)mk_fwd, hipFuncAttributeMaxDynamicSharedMemorySize, LDS_BYTES) != hipSuccess) { fprintf(stderr, "kernel_launch: hipFuncSetAttribute failed\n"); grid = -1; return; }
        if (hipOccupancyMaxActiveBlocksPerMultiprocessor(&per_cu, (const void*)mk_fwd, NWAVES * 64, LDS_BYTES) != hipSuccess || per_cu < 1) {
            fprintf(stderr, "kernel_launch: occupancy query reports %d workgroups per CU; nothing launched\n", per_cu); (void)hipGetLastError(); grid = -1; return; }
        (void)hipGetLastError();
        grid = cus;
    }
    if (grid < 0) return;
    if (hipMemsetAsync((char*)d_ws + WS_CTL, 0, CTL_ZERO_BYTES, stream) != hipSuccess) { fprintf(stderr, "kernel_launch: memset failed\n"); return; }
    Args a{};
    for (int i = 0; i < 15; ++i) a.in[i] = (const float*)d_in[i];
    a.out = (float*)d_out; a.ws = (unsigned char*)d_ws;
#if MK_PER_PHASE
    for (int p = 0; p < N_PHASES; ++p) { a.ph_lo = p; a.ph_hi = p + 1; hipLaunchKernelGGL(mk_fwd, dim3(grid), dim3(NWAVES * 64), LDS_BYTES, stream, a); }
#else
    a.ph_lo = 0; a.ph_hi = N_PHASES;
    hipLaunchKernelGGL(mk_fwd, dim3(grid), dim3(NWAVES * 64), LDS_BYTES, stream, a);
#endif
    const hipError_t le = hipPeekAtLastError();
    if (le != hipSuccess) fprintf(stderr, "kernel_launch: launch failed: %s\n", hipGetErrorName(le));
}
```
